# Optimizing an MI355X kernel written in HIP

```python
import jax, jax.numpy as jnp
from jax import lax
import numpy as np

D_MODEL = 2048
BATCH = 2
SEQ = 16384
DEPTH = 2

HEAD_DIM = 64
MOBA_HEADS = 8
NSA_HEADS = 8
NSA_KV_HEADS = 2
FOX_HEADS = 12
MEM_HEADS = 4
N_MEM = 256
MIX_WIDTH = (MOBA_HEADS + NSA_HEADS + FOX_HEADS + MEM_HEADS) * HEAD_DIM

Q_BLOCK = 128
MOBA_BLOCK = 256
MOBA_TOPK = 3
NSA_CMP_LEN = 32
NSA_CMP_STRIDE = 16
NSA_CMP_HIDDEN = 128
NSA_SEL_BLOCK = 64
NSA_TOPK = 16
NSA_WINDOW = 512
NSA_FORCE_SCORE = 1.0e4
D_FF = 5632
CONV_WIDTH = 3
LN_EPS = 1e-5
DEEPNORM_ALPHA = (2 * DEPTH) ** 0.25
DEEPNORM_BETA = (8 * DEPTH) ** -0.25

N_MOBA_QKV = 3 * MOBA_HEADS * HEAD_DIM
N_NSA_Q = NSA_HEADS * HEAD_DIM
N_NSA_KV = 6 * NSA_KV_HEADS * HEAD_DIM
N_NSA_GATE = 3 * NSA_HEADS
N_FOX_QKV = 3 * FOX_HEADS * HEAD_DIM
N_FOX_F = FOX_HEADS
N_MEM_Q = MEM_HEADS * HEAD_DIM
IN_SIZES = (N_MOBA_QKV, N_NSA_Q, N_NSA_KV, N_NSA_GATE, N_FOX_QKV, N_FOX_F, N_MEM_Q)
N_IN = N_MOBA_QKV + N_NSA_Q + N_NSA_KV + N_NSA_GATE + N_FOX_QKV + N_FOX_F + N_MEM_Q

kernel_name = "hybrid_moba_nsa_fox_deepnorm"

F32 = jnp.float32


def layer_norm(x, g, b):
    xf = x.astype(F32)
    mu = jnp.mean(xf, axis=-1, keepdims=True)
    var = jnp.mean(jnp.square(xf - mu), axis=-1, keepdims=True)
    y = (xf - mu) * lax.rsqrt(var + LN_EPS)
    return (y * g.astype(F32) + b.astype(F32)).astype(x.dtype)


def alibi_slopes(n):
    return jnp.exp2(-8.0 * jnp.arange(1, n + 1, dtype=F32) / n)


def masked_softmax(s, mask):
    s = jnp.where(mask, s, -jnp.inf)
    m = jnp.max(s, axis=-1, keepdims=True)
    m = jnp.where(jnp.isfinite(m), m, 0.0)
    e = jnp.where(mask, jnp.exp(s - m), 0.0)
    return e / jnp.maximum(jnp.sum(e, axis=-1, keepdims=True), 1e-30)


def moba_attention(q, k, v, slopes):
    B, H, S, Dh = q.shape
    scale = Dh ** -0.5
    s_pad = -(-S // MOBA_BLOCK) * MOBA_BLOCK
    nb = s_pad // MOBA_BLOCK
    n_sel = min(MOBA_TOPK, nb)
    pad = ((0, 0), (0, 0), (0, s_pad - S), (0, 0))
    k_p = jnp.pad(k, pad)
    v_p = jnp.pad(v, pad)
    k_blk = k_p.reshape(B, H, nb, MOBA_BLOCK, Dh)
    v_blk = v_p.reshape(B, H, nb, MOBA_BLOCK, Dh)
    k_mean = jnp.mean(k_blk.astype(F32), axis=3)
    bi = jnp.arange(B)[:, None, None, None]
    hi = jnp.arange(H)[None, :, None, None]
    blk_ids = jnp.arange(nb)
    off = jnp.arange(MOBA_BLOCK)

    def chunk(ci):
        c0 = ci * Q_BLOCK
        t = c0 + jnp.arange(Q_BLOCK)
        own = c0 // MOBA_BLOCK
        qc = lax.dynamic_slice_in_dim(q, c0, Q_BLOCK, axis=2)
        gate = jnp.einsum('bhqd,bhnd->bhqn', qc, k_mean, preferred_element_type=F32)
        gate = jnp.where(blk_ids < own, gate, -jnp.inf)
        _, sel = lax.top_k(gate, n_sel)
        sel_valid = sel < own
        k_sel = k_blk[bi, hi, sel]
        v_sel = v_blk[bi, hi, sel]
        pos_sel = sel[..., None] * MOBA_BLOCK + off
        s_sel = jnp.einsum('bhqd,bhqnld->bhqnl', qc, k_sel, preferred_element_type=F32) * scale
        s_sel = s_sel - slopes[:, None, None, None] * (t[:, None, None] - pos_sel).astype(F32)
        m_sel = jnp.broadcast_to(sel_valid[..., None], s_sel.shape)
        k_own = lax.dynamic_slice_in_dim(k_p, own * MOBA_BLOCK, MOBA_BLOCK, axis=2)
        v_own = lax.dynamic_slice_in_dim(v_p, own * MOBA_BLOCK, MOBA_BLOCK, axis=2)
        pos_own = own * MOBA_BLOCK + off
        d_own = t[:, None] - pos_own[None, :]
        s_own = jnp.einsum('bhqd,bhld->bhql', qc, k_own, preferred_element_type=F32) * scale
        s_own = s_own - slopes[:, None, None] * d_own.astype(F32)
        m_own = jnp.broadcast_to(d_own >= 0, s_own.shape)
        s_all = jnp.concatenate([s_own, s_sel.reshape(B, H, Q_BLOCK, -1)], axis=-1)
        m_all = jnp.concatenate([m_own, m_sel.reshape(B, H, Q_BLOCK, -1)], axis=-1)
        p = masked_softmax(s_all, m_all)
        p_own = p[..., :MOBA_BLOCK]
        p_sel = p[..., MOBA_BLOCK:].reshape(B, H, Q_BLOCK, n_sel, MOBA_BLOCK)
        o = (jnp.einsum('bhql,bhld->bhqd', p_own, v_own)
             + jnp.einsum('bhqnl,bhqnld->bhqd', p_sel, v_sel))
        return o.astype(q.dtype)

    out = lax.map(chunk, jnp.arange(S // Q_BLOCK))
    return out.transpose(1, 2, 0, 3, 4).reshape(B, H, S, Dh)


def nsa_compress(x, pe, w1, w2):
    B, S, G, Dh = x.shape
    xs = x.reshape(B, S // NSA_CMP_STRIDE, NSA_CMP_STRIDE, G, Dh)
    blk = jnp.concatenate([xs[:, :-1], xs[:, 1:]], axis=2)
    h = jax.nn.gelu(jnp.einsum('bnlgd,lde->bnge', blk + pe[None, None, :, None, :], w1))
    return jnp.einsum('bnge,ed->bgnd', h, w2)


def nsa_attention(q, k_cmp, v_cmp, k_slc, v_slc, k_win, v_win, gates, slopes):
    B, Hq, S, Dh = q.shape
    G = k_slc.shape[1]
    Hg = Hq // G
    nc = k_cmp.shape[2]
    nsb = S // NSA_SEL_BLOCK
    n_sel = min(NSA_TOPK, nsb)
    scale = Dh ** -0.5
    slopes_g = slopes.reshape(G, Hg)
    cmp_end = jnp.arange(nc) * NSA_CMP_STRIDE + NSA_CMP_LEN - 1
    ratio = NSA_SEL_BLOCK // NSA_CMP_STRIDE
    front = NSA_CMP_LEN // NSA_CMP_STRIDE - 1
    n_int = ratio + front
    back = ratio * (nsb - 1) + n_int - front - nc
    blk = jnp.arange(nsb)
    off = jnp.arange(NSA_SEL_BLOCK)
    k_sb = k_slc.reshape(B, G, nsb, NSA_SEL_BLOCK, Dh)
    v_sb = v_slc.reshape(B, G, nsb, NSA_SEL_BLOCK, Dh)
    wpad = ((0, 0), (0, 0), (NSA_WINDOW, 0), (0, 0))
    kw = jnp.pad(k_win, wpad)
    vw = jnp.pad(v_win, wpad)
    bi = jnp.arange(B)[:, None, None, None]
    gi = jnp.arange(G)[None, :, None, None]
    q_all = q.reshape(B, G, Hg, S, Dh)
    g_all = gates.reshape(B, G, Hg, S, 3)

    def chunk(ci):
        c0 = ci * Q_BLOCK
        t = c0 + jnp.arange(Q_BLOCK)
        qg = lax.dynamic_slice_in_dim(q_all, c0, Q_BLOCK, axis=3)
        gc = lax.dynamic_slice_in_dim(g_all, c0, Q_BLOCK, axis=3)
        d_c = t[:, None] - cmp_end[None, :]
        s_c = jnp.einsum('bghqd,bgnd->bghqn', qg, k_cmp, preferred_element_type=F32) * scale
        s_c = s_c - slopes_g[:, :, None, None] * d_c.astype(F32)
        p_c = masked_softmax(s_c, d_c >= 0)
        o_c = jnp.einsum('bghqn,bgnd->bghqd', p_c, v_cmp)
        imp_c = jnp.pad(jnp.sum(p_c, axis=2), ((0, 0), (0, 0), (0, 0), (front, back)))
        imp = imp_c[..., 0:ratio * (nsb - 1) + 1:ratio]
        for o in range(1, n_int):
            imp = imp + imp_c[..., o:o + ratio * (nsb - 1) + 1:ratio]
        jt = (t // NSA_SEL_BLOCK)[:, None]
        forced = (blk == 0) | (blk == jt) | (blk == jt - 1)
        imp = jnp.where(forced, NSA_FORCE_SCORE, imp)
        imp = jnp.where(blk * NSA_SEL_BLOCK <= t[:, None], imp, -jnp.inf)
        _, sel = lax.top_k(imp, n_sel)
        k_g = k_sb[bi, gi, sel]
        v_g = v_sb[bi, gi, sel]
        d_s = t[:, None, None] - (sel[..., None] * NSA_SEL_BLOCK + off)
        s_s = jnp.einsum('bghqd,bgqnld->bghqnl', qg, k_g, preferred_element_type=F32) * scale
        s_s = s_s - slopes_g[:, :, None, None, None] * d_s[:, :, None].astype(F32)
        shp = s_s.shape
        m_s = jnp.broadcast_to((d_s >= 0)[:, :, None], shp)
        p_s = masked_softmax(s_s.reshape(shp[:4] + (-1,)), m_s.reshape(shp[:4] + (-1,))).reshape(shp)
        o_s = jnp.einsum('bghqnl,bgqnld->bghqd', p_s, v_g)
        kwc = lax.dynamic_slice_in_dim(kw, c0, Q_BLOCK + NSA_WINDOW, axis=2)
        vwc = lax.dynamic_slice_in_dim(vw, c0, Q_BLOCK + NSA_WINDOW, axis=2)
        pos_w = c0 - NSA_WINDOW + jnp.arange(Q_BLOCK + NSA_WINDOW)
        d_w = t[:, None] - pos_w[None, :]
        m_w = (d_w >= 0) & (d_w < NSA_WINDOW) & (pos_w[None, :] >= 0)
        s_w = jnp.einsum('bghqd,bgkd->bghqk', qg, kwc, preferred_element_type=F32) * scale
        s_w = s_w - slopes_g[:, :, None, None] * d_w.astype(F32)
        p_w = masked_softmax(s_w, m_w)
        o_w = jnp.einsum('bghqk,bgkd->bghqd', p_w, vwc)
        o = gc[..., 0:1] * o_c + gc[..., 1:2] * o_s + gc[..., 2:3] * o_w
        return o.reshape(B, Hq, Q_BLOCK, Dh).astype(q.dtype)

    out = lax.map(chunk, jnp.arange(S // Q_BLOCK))
    return out.transpose(1, 2, 0, 3, 4).reshape(B, Hq, S, Dh)


def forgetting_attention(q, k, v, log_f):
    B, H, S, Dh = q.shape
    scale = Dh ** -0.5
    c = lax.cumsum(log_f, axis=2)
    s_pos = jnp.arange(S)

    def chunk(ci):
        c0 = ci * Q_BLOCK
        t = c0 + jnp.arange(Q_BLOCK)
        qc = lax.dynamic_slice_in_dim(q, c0, Q_BLOCK, axis=2)
        cq = lax.dynamic_slice_in_dim(c, c0, Q_BLOCK, axis=2)
        s = jnp.einsum('bhqd,bhkd->bhqk', qc, k, preferred_element_type=F32) * scale
        s = s + (cq[..., :, None] - c[:, :, None, :])
        p = masked_softmax(s, s_pos[None, :] <= t[:, None])
        return jnp.einsum('bhqk,bhkd->bhqd', p, v).astype(q.dtype)

    out = lax.map(chunk, jnp.arange(S // Q_BLOCK))
    return out.transpose(1, 2, 0, 3, 4).reshape(B, H, S, Dh)


def memory_attention(q, mem_k, mem_v):
    s = jnp.einsum('bhqd,bhmd->bhqm', q, mem_k, preferred_element_type=F32) * (q.shape[-1] ** -0.5)
    p = jax.nn.softmax(s, axis=-1)
    return jnp.einsum('bhqm,bhmd->bhqd', p, mem_v).astype(q.dtype)


def hybrid_mixer(x, mem, w_in, b_forget, w_mem_kv, cmp_pe, cmp_w1, cmp_w2, w_out):
    B, S, _ = x.shape
    Dh = HEAD_DIM
    proj = x @ w_in
    split_at = []
    acc = 0
    for n in IN_SIZES[:-1]:
        acc += n
        split_at.append(acc)
    moba_qkv, nsa_q, nsa_kv, nsa_g, fox_qkv, fox_f, mem_q = jnp.split(proj, split_at, axis=-1)

    mq, mk, mv = moba_qkv.reshape(B, S, 3, MOBA_HEADS, Dh).transpose(2, 0, 3, 1, 4)
    o_moba = moba_attention(mq, mk, mv, alibi_slopes(MOBA_HEADS))

    nq = nsa_q.reshape(B, S, NSA_HEADS, Dh).transpose(0, 2, 1, 3)
    kv = nsa_kv.reshape(B, S, 6, NSA_KV_HEADS, Dh)
    k_cmp = nsa_compress(kv[:, :, 0], cmp_pe[0], cmp_w1[0], cmp_w2[0])
    v_cmp = nsa_compress(kv[:, :, 1], cmp_pe[1], cmp_w1[1], cmp_w2[1])
    k_slc, v_slc, k_win, v_win = [kv[:, :, i].transpose(0, 2, 1, 3) for i in range(2, 6)]
    gates = jax.nn.sigmoid(nsa_g.reshape(B, S, NSA_HEADS, 3)).transpose(0, 2, 1, 3)
    o_nsa = nsa_attention(nq, k_cmp, v_cmp, k_slc, v_slc, k_win, v_win, gates,
                          alibi_slopes(NSA_HEADS))

    fq, fk, fv = fox_qkv.reshape(B, S, 3, FOX_HEADS, Dh).transpose(2, 0, 3, 1, 4)
    log_f = jax.nn.log_sigmoid((fox_f + b_forget).astype(F32)).transpose(0, 2, 1)
    o_fox = forgetting_attention(fq, fk, fv, log_f)

    eq = mem_q.reshape(B, S, MEM_HEADS, Dh).transpose(0, 2, 1, 3)
    ek, ev = (mem @ w_mem_kv).reshape(B, mem.shape[1], 2, MEM_HEADS, Dh).transpose(2, 0, 3, 1, 4)
    o_mem = memory_attention(eq, ek, ev)

    o = jnp.concatenate([o_moba, o_nsa, o_fox, o_mem], axis=1)
    o = o.transpose(0, 2, 1, 3).reshape(B, S, MIX_WIDTH)
    return o @ w_out


def conv_ffn(x, w_up, conv_w, conv_b, w_down):
    S = x.shape[1]
    u, g = jnp.split(x @ w_up, 2, axis=-1)
    gp = jnp.pad(g, ((0, 0), (CONV_WIDTH - 1, 0), (0, 0)))
    gc = conv_b
    for tap in range(CONV_WIDTH):
        gc = gc + conv_w[tap] * gp[:, tap:tap + S]
    return (jax.nn.gelu(gc) * u) @ w_down


def setup_inputs(seed: int = 0) -> dict:
    key = jax.random.key(seed)
    ks = jax.random.split(key, 20)

    def nrm(k, shape, scale):
        return jax.random.normal(k, shape, F32) * scale

    return {
        "x": nrm(ks[0], (BATCH, SEQ, D_MODEL), 1.0),
        "mem": nrm(ks[1], (BATCH, N_MEM, D_MODEL), 1.0),
        "emb_ln_g": 1.0 + nrm(ks[2], (D_MODEL,), 0.02),
        "emb_ln_b": nrm(ks[3], (D_MODEL,), 0.02),
        "w_in": nrm(ks[4], (DEPTH, D_MODEL, N_IN), D_MODEL ** -0.5),
        "b_forget": 3.0 + nrm(ks[5], (DEPTH, FOX_HEADS), 1.5),
        "w_mem_kv": nrm(ks[6], (DEPTH, D_MODEL, 2 * MEM_HEADS * HEAD_DIM), D_MODEL ** -0.5),
        "nsa_cmp_pe": nrm(ks[7], (DEPTH, 2, NSA_CMP_LEN, HEAD_DIM), 0.02),
        "nsa_cmp_w1": nrm(ks[8], (DEPTH, 2, NSA_CMP_LEN, HEAD_DIM, NSA_CMP_HIDDEN),
                          (NSA_CMP_LEN * HEAD_DIM) ** -0.5),
        "nsa_cmp_w2": nrm(ks[9], (DEPTH, 2, NSA_CMP_HIDDEN, HEAD_DIM), NSA_CMP_HIDDEN ** -0.5),
        "w_out": nrm(ks[10], (DEPTH, MIX_WIDTH, D_MODEL), MIX_WIDTH ** -0.5 * DEEPNORM_BETA),
        "ln1_g": 1.0 + nrm(ks[11], (DEPTH, D_MODEL), 0.02),
        "ln1_b": nrm(ks[12], (DEPTH, D_MODEL), 0.02),
        "ffn_w_up": nrm(ks[13], (DEPTH, D_MODEL, 2 * D_FF), D_MODEL ** -0.5),
        "ffn_conv_w": nrm(ks[14], (DEPTH, CONV_WIDTH, D_FF), CONV_WIDTH ** -0.5),
        "ffn_conv_b": nrm(ks[15], (DEPTH, D_FF), 0.02),
        "ffn_w_down": nrm(ks[16], (DEPTH, D_FF, D_MODEL), D_FF ** -0.5 * DEEPNORM_BETA),
        "ln2_g": 1.0 + nrm(ks[17], (DEPTH, D_MODEL), 0.02),
        "ln2_b": nrm(ks[18], (DEPTH, D_MODEL), 0.02),
    }


def reference(x, mem, emb_ln_g, emb_ln_b, w_in, b_forget, w_mem_kv, nsa_cmp_pe, nsa_cmp_w1,
              nsa_cmp_w2, w_out, ln1_g, ln1_b, ffn_w_up, ffn_conv_w, ffn_conv_b, ffn_w_down,
              ln2_g, ln2_b):
    h = layer_norm(x, emb_ln_g, emb_ln_b)
    for l in range(DEPTH):
        mix = hybrid_mixer(h, mem, w_in[l], b_forget[l], w_mem_kv[l], nsa_cmp_pe[l],
                           nsa_cmp_w1[l], nsa_cmp_w2[l], w_out[l])
        h = layer_norm(DEEPNORM_ALPHA * h + mix, ln1_g[l], ln1_b[l])
        ffn = conv_ffn(h, ffn_w_up[l], ffn_conv_w[l], ffn_conv_b[l], ffn_w_down[l])
        h = layer_norm(DEEPNORM_ALPHA * h + ffn, ln2_g[l], ln2_b[l])
    return h
```

```cpp
#include <hip/hip_runtime.h>
#include <cstdio>
#include <cstdint>
namespace pg8 {
#define PG8_LAS __attribute__((address_space(3)))
typedef unsigned short bf16_t;
typedef short bf16x8 __attribute__((ext_vector_type(8)));
typedef float f32x4 __attribute__((ext_vector_type(4)));
typedef unsigned u32x4 __attribute__((ext_vector_type(4)));
constexpr int BM = 256, BK = 64, HALF = 128, HTB = HALF * BK * 2  , STAGE_BYTES = 8 * HTB, NXCD = 8, WGM = 8;

__host__ __device__ __forceinline__ int lds_byte(int r, int c) { const int st = (r >> 4) * 2 + (c >> 5), rr = r & 15, cc = c & 31, ob = rr * 64 + cc * 2; return st * 1024 + (ob ^ (((ob >> 9) & 1) << 5)); }
__host__ __device__ __forceinline__ void stage_rc(int b, int& R, int& C) { const int st = b / 1024, sb = b % 1024, swz = sb ^ (((sb >> 9) & 1) << 5); R = (st >> 1) * 16 + swz / 64; C = (st & 1) * 32 + (swz % 64) / 2; }
__host__ __device__ __forceinline__ int perm32(int rho) { const int n = rho >> 4, i = rho & 15; return 8 * (i >> 2) + 4 * n + (i & 3); }

struct Unit { int pm, pn; };
struct Gemm { const bf16_t* A; const bf16_t* Bt; int M, N, K; };

struct StaticOrder {
    int nM, nN, nwg, G, c;
    __host__ __device__ void init(int M, int N, int G_, int c_) { nM = M / BM; nN = N / BM; nwg = nM * nN; G = G_; c = c_; }
    __host__ __device__ bool next(int i, Unit& u) const {
        const long L = (long)i * G + c; if (L >= nwg) return false;
        int wgid = (int)L; { const int q = nwg / NXCD, r = nwg % NXCD, xcd = wgid % NXCD, off = wgid / NXCD; wgid = (xcd < r ? xcd * (q + 1) : r * (q + 1) + (xcd - r) * q) + off; }
        const int nig = WGM * nN, gid = wgid / nig, fm = gid * WGM, gsz = (nM - fm) < WGM ? (nM - fm) : WGM;
        u.pm = fm + ((wgid % nig) % gsz); u.pn = (wgid % nig) / gsz; return true;
    }
    __device__ __forceinline__ void a_ready(const Unit&) const {}
    __device__ __forceinline__ void done(const Unit&) const {}
};

__device__ __forceinline__ unsigned cvt_pk_bf16(float lo, float hi) { unsigned r; asm volatile("v_cvt_pk_bf16_f32 %0, %1, %2" : "=v"(r) : "v"(lo), "v"(hi)); return r; }
typedef float f32x2 __attribute__((ext_vector_type(2)));
__device__ __forceinline__ f32x2 gelu_pk(f32x2 v) {
    const f32x2 av = __builtin_elementwise_abs(v), d = av * 0.2316418882f + 1.0f;
    f32x2 t; t.x = __builtin_amdgcn_rcpf(d.x); t.y = __builtin_amdgcn_rcpf(d.y);
    f32x2 q = t * 0.5307027145f + (-0.7265760135f); q = q * t + 0.7107068705f; q = q * t + (-0.142248368f); q = q * t + 0.127414796f; q = q * t;
    const f32x2 s = (v * v) * (-0.72134752044f);
    f32x2 e; e.x = __builtin_amdgcn_exp2f(s.x); e.y = __builtin_amdgcn_exp2f(s.y);
    const f32x2 m = v * (q * e), r = v - m;
    f32x2 o; o.x = v.x < 0.f ? m.x : r.x; o.y = v.y < 0.f ? m.y : r.y; return o;
}

template <int ACT  > struct EpiBf16 {
    static constexpr bool PERM = true, AFTER_DRAIN = false; static_assert(ACT == 0 || ACT == 1, "EpiBf16: ACT is 0 (none) or 1 (gelu_pk)");
    bf16_t* O; int ldc; const float* bias; int split_cols; size_t split_stride; float scale0;
    __device__ __forceinline__ void operator()(const f32x4 (&acc)[2][2][4][2], const Unit& u, int wr, int wc, int fr, int fq) const {
        const int row0 = u.pm * BM + wr * 64 + fr; int colt = u.pn * BM; bf16_t* base = O;
        float sc = 1.f; if (split_cols) { const int t = colt / split_cols; base += (size_t)t * split_stride; colt -= t * split_cols; if (t == 0) sc = scale0; }
        const int col0 = colt + wc * 32 + 8 * fq, bcol0 = u.pn * BM + wc * 32 + 8 * fq;
        f32x4 bv[2][2];
#pragma unroll
        for (int bj = 0; bj < 2; ++bj)
#pragma unroll
            for (int n = 0; n < 2; ++n) bv[bj][n] = bias ? *(const f32x4*)(bias + bcol0 + bj * HALF + 4 * n) : (f32x4){0.f, 0.f, 0.f, 0.f};
#pragma unroll
        for (int ai = 0; ai < 2; ++ai)
#pragma unroll
            for (int m = 0; m < 4; ++m) { bf16_t* rowp = base + (size_t)(row0 + ai * HALF + m * 16) * ldc + col0;
#pragma unroll
                for (int bj = 0; bj < 2; ++bj) { f32x4 v0 = acc[ai][bj][m][0] + bv[bj][0], v1 = acc[ai][bj][m][1] + bv[bj][1];
                    if (ACT == 1) { f32x2 a = gelu_pk((f32x2){v0[0], v0[1]}), b = gelu_pk((f32x2){v0[2], v0[3]}), c = gelu_pk((f32x2){v1[0], v1[1]}), d = gelu_pk((f32x2){v1[2], v1[3]});
                        v0 = (f32x4){a.x, a.y, b.x, b.y}; v1 = (f32x4){c.x, c.y, d.x, d.y}; }
                    v0 = v0 * sc; v1 = v1 * sc; u32x4 w; w.x = cvt_pk_bf16(v0[0], v0[1]); w.y = cvt_pk_bf16(v0[2], v0[3]); w.z = cvt_pk_bf16(v1[0], v1[1]); w.w = cvt_pk_bf16(v1[2], v1[3]);
                    *(u32x4*)(rowp + bj * HALF) = w; } }
    }
};


struct EpiResF32 {
    static constexpr bool PERM = false, AFTER_DRAIN = false;
    float* out; int ldc; float alpha;
    __device__ __forceinline__ void operator()(const f32x4 (&acc)[2][2][4][2], const Unit& u, int wr, int wc, int fr, int fq) const {
        const int col0 = u.pn * BM + wc * 32 + 4 * fq;
#pragma unroll
        for (int ai = 0; ai < 2; ++ai)
#pragma unroll
            for (int m = 0; m < 4; ++m) { float* rowp = out + (size_t)(u.pm * BM + ai * HALF + wr * 64 + m * 16 + fr) * ldc + col0;
#pragma unroll
                for (int bj = 0; bj < 2; ++bj)
#pragma unroll
                    for (int n = 0; n < 2; ++n) { f32x4* p = (f32x4*)(rowp + bj * HALF + n * 16); const f32x4 b = *p; *p = b * alpha + acc[ai][bj][m][n]; }
                asm volatile("" ::: "memory"); }
    }
};
template <class Epi, class Sched, bool ALIGN_EPI = false, bool SP2 = false>
__device__ __forceinline__ void gemm_phase(PG8_LAS unsigned char* lds, const Gemm g, const Sched& S, const Epi& E) {
    int tid_ = threadIdx.x; asm volatile("" : "+v"(tid_));
    const int tid = tid_, wid = __builtin_amdgcn_readfirstlane(tid >> 6), lane = tid & 63, wr = wid >> 2, wc = wid & 3, fr = lane & 15, fq = lane >> 4;
    const int K = g.K, nt = K / BK;
    unsigned voffA[2], voffB[2];
#pragma unroll
    for (int i = 0; i < 2; ++i) { int R, C; stage_rc(tid * 16 + i * 8192, R, C); const int Rb = Epi::PERM ? ((R & ~31) + perm32(R & 31)) : R;
        voffA[i] = (unsigned)(R * K + C) * 2u; voffB[i] = (unsigned)(Rb * K + C) * 2u; }
    const size_t kstep = (size_t)(BK * 2);
    const size_t hstep = (size_t)HALF * K * 2;
    const size_t tstep = 2 * hstep;
    const unsigned ldsw = (unsigned)wid * 1024u;
    const int aoff = lds_byte(wr * 64 + fr, fq * 8), boff = lds_byte(wc * 32 + fr, fq * 8);
#define PG8_SA(b, h) (((b) * 2 + (h)) * HTB)
#define PG8_SB(b, h) ((4 + (b) * 2 + (h)) * HTB)
#define PG8_STAGE(bufoff, gbase, voff) do { _Pragma("unroll") for (int _i = 0; _i < 2; ++_i) \
        __builtin_amdgcn_global_load_lds((const unsigned*)((const char*)(gbase) + (voff)[_i]), (PG8_LAS unsigned*)(lds + (bufoff) + ldsw + _i * 8192), 16, 0, 0); } while (0)
#define PG8_LDA(dst, b, h) do { _Pragma("unroll") for (int m = 0; m < 4; ++m) _Pragma("unroll") for (int k = 0; k < 2; ++k) dst[m][k] = *(const PG8_LAS bf16x8*)(lds + PG8_SA(b, h) + aoff + m * 2048 + k * 1024); } while (0)
#define PG8_LDB(dst, b, h) do { _Pragma("unroll") for (int n = 0; n < 2; ++n) _Pragma("unroll") for (int k = 0; k < 2; ++k) dst[n][k] = *(const PG8_LAS bf16x8*)(lds + PG8_SB(b, h) + boff + n * 2048 + k * 1024); } while (0)
#define PG8_MMA(ai, bj, At, Bt) do { __builtin_amdgcn_s_setprio(1); _Pragma("unroll") for (int m = 0; m < 4; ++m) _Pragma("unroll") for (int n = 0; n < 2; ++n) _Pragma("unroll") for (int k = 0; k < 2; ++k) \
        acc[ai][bj][m][n] = __builtin_amdgcn_mfma_f32_16x16x32_bf16(Bt[n][k], At[m][k], acc[ai][bj][m][n], 0, 0, 0); __builtin_amdgcn_s_setprio(0); } while (0)
#define PG8_WAIT_V(n) asm volatile("s_waitcnt vmcnt(" #n ")" ::: "memory")
#define PG8_WAIT_L(n) asm volatile("s_waitcnt lgkmcnt(" #n ")" ::: "memory")
#define PG8_BAR __builtin_amdgcn_s_barrier()
#define PG8_SCHED __builtin_amdgcn_sched_barrier(0)
    Unit cur, nxt; int ui = 0;
    if (!S.next(0, cur)) return;
    f32x4 acc[2][2][4][2];
#pragma unroll
    for (int a = 0; a < 2; ++a)
#pragma unroll
        for (int b = 0; b < 2; ++b)
#pragma unroll
            for (int m = 0; m < 4; ++m)
#pragma unroll
                for (int n = 0; n < 2; ++n) acc[a][b][m][n] = (f32x4){0.f, 0.f, 0.f, 0.f};
    bf16x8 At[4][2], B0[2][2], B1[2][2];
    const char* cA = (const char*)g.A + (size_t)cur.pm * tstep; const char* cB = (const char*)g.Bt + (size_t)cur.pn * tstep;
    S.a_ready(cur);
    if constexpr (SP2) {
        PG8_STAGE(PG8_SB(0, 0), cB, voffB); PG8_STAGE(PG8_SB(0, 1), cB + hstep, voffB); PG8_STAGE(PG8_SA(0, 0), cA, voffA); PG8_STAGE(PG8_SA(0, 1), cA + hstep, voffA);
        if (wr == 1) PG8_BAR;
        PG8_WAIT_V(2); PG8_BAR;
        PG8_STAGE(PG8_SB(1, 0), cB + kstep, voffB); PG8_STAGE(PG8_SA(1, 0), cA + kstep, voffA); PG8_STAGE(PG8_SB(1, 1), cB + hstep + kstep, voffB);
        PG8_WAIT_V(6); PG8_BAR;
    } else {
        PG8_STAGE(PG8_SB(0, 0), cB, voffB); PG8_STAGE(PG8_SA(0, 0), cA, voffA); PG8_STAGE(PG8_SB(0, 1), cB + hstep, voffB); PG8_STAGE(PG8_SA(0, 1), cA + hstep, voffA);
        if (wr == 1) PG8_BAR;
        PG8_WAIT_V(4); PG8_BAR;
        PG8_STAGE(PG8_SB(1, 0), cB + kstep, voffB); PG8_STAGE(PG8_SA(1, 0), cA + kstep, voffA); PG8_STAGE(PG8_SB(1, 1), cB + hstep + kstep, voffB);
        PG8_WAIT_V(6); PG8_BAR;
    }
    for (;;) {
        const bool has_next = S.next(ui + 1, nxt);
        const char* nA = has_next ? (const char*)g.A + (size_t)nxt.pm * tstep : cA; const char* nB = has_next ? (const char*)g.Bt + (size_t)nxt.pn * tstep : cB;
        for (int t = 0; t < nt; t += 2) {
            const bool last = (t == nt - 2);
            const char* a1 = cA + (size_t)(t + 1) * kstep;
            const char* a2 = last ? nA : cA + (size_t)(t + 2) * kstep; const char* b2 = last ? nB : cB + (size_t)(t + 2) * kstep;
            const char* a3 = a2 + kstep; const char* b3 = b2 + kstep;
            if (last && has_next) S.a_ready(nxt);
            if constexpr (SP2) {
            PG8_LDB(B0, 0, 0); PG8_LDB(B1, 0, 1); PG8_SCHED; PG8_LDA(At, 0, 0); PG8_STAGE(PG8_SA(1, 1), a1 + hstep, voffA);
            PG8_WAIT_V(8); PG8_WAIT_L(0); PG8_BAR; PG8_MMA(0, 0, At, B0); PG8_MMA(0, 1, At, B1); PG8_BAR; PG8_SCHED;
            PG8_LDA(At, 0, 1); PG8_STAGE(PG8_SB(0, 0), b2, voffB); PG8_STAGE(PG8_SB(0, 1), b2 + hstep, voffB); PG8_STAGE(PG8_SA(0, 0), a2, voffA);
            PG8_WAIT_V(8); PG8_WAIT_L(0); PG8_BAR; PG8_MMA(1, 0, At, B0); PG8_MMA(1, 1, At, B1); PG8_BAR; PG8_SCHED;
            PG8_LDB(B0, 1, 0); PG8_LDB(B1, 1, 1); PG8_SCHED; PG8_LDA(At, 1, 0); PG8_STAGE(PG8_SA(0, 1), a2 + hstep, voffA);
            PG8_WAIT_V(8); PG8_WAIT_L(0); PG8_BAR; PG8_MMA(0, 0, At, B0); PG8_MMA(0, 1, At, B1); PG8_BAR; PG8_SCHED;
            PG8_LDA(At, 1, 1); PG8_STAGE(PG8_SB(1, 0), b3, voffB); PG8_STAGE(PG8_SB(1, 1), b3 + hstep, voffB); PG8_STAGE(PG8_SA(1, 0), a3, voffA);
            PG8_WAIT_V(8); PG8_WAIT_L(0); PG8_BAR; PG8_MMA(1, 0, At, B0); PG8_MMA(1, 1, At, B1); PG8_BAR; PG8_SCHED;
            } else {
            PG8_LDB(B0, 0, 0); PG8_SCHED; PG8_LDA(At, 0, 0); PG8_STAGE(PG8_SA(1, 1), a1 + hstep, voffA);
            PG8_WAIT_L(8); PG8_BAR; PG8_WAIT_L(0); PG8_MMA(0, 0, At, B0); PG8_BAR; PG8_SCHED;
            PG8_LDB(B1, 0, 1); PG8_STAGE(PG8_SB(0, 0), b2, voffB);
            PG8_BAR; PG8_WAIT_L(0); PG8_MMA(0, 1, At, B1); PG8_BAR;
            PG8_LDA(At, 0, 1); PG8_STAGE(PG8_SA(0, 0), a2, voffA);
            PG8_BAR; PG8_WAIT_L(0); PG8_MMA(1, 0, At, B0); PG8_BAR; PG8_SCHED;
            PG8_STAGE(PG8_SB(0, 1), b2 + hstep, voffB);
            PG8_WAIT_V(6); PG8_BAR; PG8_MMA(1, 1, At, B1); PG8_BAR;
            PG8_LDB(B0, 1, 0); PG8_SCHED; PG8_LDA(At, 1, 0); PG8_STAGE(PG8_SA(0, 1), a2 + hstep, voffA);
            PG8_WAIT_L(8); PG8_BAR; PG8_WAIT_L(0); PG8_MMA(0, 0, At, B0); PG8_BAR; PG8_SCHED;
            PG8_LDB(B1, 1, 1); PG8_STAGE(PG8_SB(1, 0), b3, voffB);
            PG8_BAR; PG8_WAIT_L(0); PG8_MMA(0, 1, At, B1); PG8_BAR;
            PG8_LDA(At, 1, 1); PG8_STAGE(PG8_SA(1, 0), a3, voffA);
            PG8_BAR; PG8_WAIT_L(0); PG8_MMA(1, 0, At, B0); PG8_BAR; PG8_SCHED;
            PG8_STAGE(PG8_SB(1, 1), b3 + hstep, voffB);
            PG8_WAIT_V(6); PG8_BAR; PG8_MMA(1, 1, At, B1); PG8_BAR;
            }
        }
        if constexpr (ALIGN_EPI) { if (wr == 0) PG8_BAR; }
        if constexpr (!Epi::AFTER_DRAIN) { E(acc, cur, wr, wc, fr, fq); S.done(cur); }
        if (!has_next) break;
#pragma unroll
        for (int a = 0; a < 2; ++a)
#pragma unroll
            for (int b = 0; b < 2; ++b)
#pragma unroll
                for (int m = 0; m < 4; ++m)
#pragma unroll
                    for (int n = 0; n < 2; ++n) acc[a][b][m][n] = (f32x4){0.f, 0.f, 0.f, 0.f};
        cur = nxt; cA = nA; cB = nB; ++ui;
        if constexpr (ALIGN_EPI) { if (wr == 1) PG8_BAR; }
    }
    PG8_WAIT_V(0);
    if constexpr (!ALIGN_EPI) { if (wr == 0) PG8_BAR; }
    PG8_BAR;
    if constexpr (Epi::AFTER_DRAIN) { E.fused(acc, cur, wr, wc, fr, fq, lds, wid, lane); S.done(cur); }
#undef PG8_SA
#undef PG8_SB
#undef PG8_STAGE
#undef PG8_LDA
#undef PG8_LDB
#undef PG8_MMA
#undef PG8_WAIT_V
#undef PG8_WAIT_L
#undef PG8_BAR
#undef PG8_SCHED
}
}

#ifndef PG8_SP2
#define PG8_SP2 true
#endif
#ifndef PG8_ALIGN
#define PG8_ALIGN true
#endif
#ifndef MK_ONE_LAUNCH
#define MK_ONE_LAUNCH 0
#endif

constexpr int NWAVES = 8, NTHR = NWAVES * 64;
constexpr int NB = 2, S = 16384, D = 2048, M = NB * S, NLAYER = 2;
constexpr int NPROJ = 5632, NIN = 5412;
constexpr int DFF = 5632, NUP = 2 * DFF;
constexpr int MH = S;
constexpr int C_MQ = 0, C_MK = 512, C_MV = 1024, C_NQ = 1536, C_NKV = 2048, C_FQ = 2816, C_FK = 3584, C_FV = 4352, C_EQ = 5120, C_GATE = 5376, C_FF = 5400;
constexpr float LN_EPS = 1e-5f;
constexpr float ALPHA = 1.41421356237309515f;
constexpr float LOG2E = 1.4426950408889634f;
constexpr float C2 = 0.125f * LOG2E;
constexpr int NCMP = 1023, NCMP_PAD = 1024;

constexpr size_t MiB = 1u << 20;
constexpr size_t WS_CTL = 0, CTL_ZERO_BYTES = 1 * MiB;
constexpr size_t WS_WIN = 1 * MiB, WS_WOUT = 45 * MiB, WS_WUP = 61 * MiB, WS_WDN = 149 * MiB;
constexpr size_t WS_HB = 193 * MiB;
constexpr size_t WS_R = 321 * MiB;
constexpr size_t WS_PROJ = WS_R, WS_O = WS_R + 352 * MiB, WS_UG = WS_R, WS_ACT = WS_R + 352 * MiB;
constexpr size_t WS_KCMP = 849 * MiB;
constexpr size_t WS_MEMKV = 851 * MiB;
constexpr size_t WS_KMEAN = 853 * MiB;
constexpr size_t WS_FOXC = 854 * MiB;
constexpr size_t WS_END = 860 * MiB;
constexpr int CW_TMO = 0, CW_CODE = 1, CW_BAR = 4096, CW_Q = 8192;

constexpr int RING_OFF = 0, RING_BYTES = 131072;
constexpr int LDSCTL_OFF = RING_BYTES, MISC_OFF = LDSCTL_OFF + 320;
constexpr int SEL_OFF = RING_BYTES + 1024;
constexpr int LDS_BYTES = 147456;

#define GAS __attribute__((address_space(1)))
#define LAS __attribute__((address_space(3)))
typedef unsigned short bf16;
typedef unsigned v4u __attribute__((ext_vector_type(4)));
typedef float f32x4 __attribute__((ext_vector_type(4)));
typedef GAS unsigned gu32;
#define RLX_AGENT __ATOMIC_RELAXED, __HIP_MEMORY_SCOPE_AGENT
#define LDS_WAIT() asm volatile("s_waitcnt lgkmcnt(0)" ::: "memory")
__device__ __forceinline__ unsigned f2bf(float f) { unsigned u = __builtin_bit_cast(unsigned, f); return (u + 0x7fffu + ((u >> 16) & 1u)) >> 16; }
__device__ __forceinline__ unsigned pk2(float lo, float hi) { return f2bf(lo) | (f2bf(hi) << 16); }
__device__ __forceinline__ float blo(unsigned u) { return __uint_as_float(u << 16); }
__device__ __forceinline__ float bhi(unsigned u) { return __uint_as_float(u & 0xffff0000u); }
__device__ __forceinline__ float bf2f(bf16 v) { return __uint_as_float((unsigned)v << 16); }
__device__ __forceinline__ float ex2(float x) { return __builtin_amdgcn_exp2f(x); }
__device__ __forceinline__ float gelu_tanh(float x) {
    const float y = 0.7978845608028654f * (x + 0.044715f * x * x * x);
    const float e = __expf(2.0f * y);
    const float th = 1.0f - 2.0f / (e + 1.0f);
    return 0.5f * x * (1.0f + th);
}
#define XB_TMO      128
#define XB_XCNT(j)  (256  + 64 * (j))
#define XB_XSUB(j)  (1280 + 64 * (j))
#define XB_XGEN(j)  (2304 + 64 * (j))
#define XB_TOP      3328
#define XB_TOPGEN   3392
#define XCD_BAR_WORDS 3456
#define XB_SPIN_CAP (1u << 18)

__device__ __forceinline__ unsigned xb_ld(unsigned* p)              { return __hip_atomic_load(p, __ATOMIC_RELAXED, __HIP_MEMORY_SCOPE_AGENT); }
__device__ __forceinline__ unsigned xb_add(unsigned* p, unsigned v) { return __hip_atomic_fetch_add(p, v, __ATOMIC_RELAXED, __HIP_MEMORY_SCOPE_AGENT); }
__device__ __forceinline__ unsigned xb_xcc_id() { return (unsigned)__builtin_amdgcn_s_getreg((3 << 11) | 20) & 0xFu; }
#define XB_SPIN(cond, bar) do { unsigned _sp = 0; while (cond) { __builtin_amdgcn_s_sleep(1); \
    if ((++_sp & 255u) == 0u) { if (xb_ld(&(bar)[XB_TMO])) break; if (_sp > XB_SPIN_CAP) { atomicAdd(&(bar)[XB_TMO], 1u); break; } } } } while (0)

struct XcdBarrier {
    unsigned* bar; unsigned x;
    volatile LAS unsigned* st;
};

__device__ __forceinline__ XcdBarrier xcd_barrier_post(unsigned* bar, volatile LAS unsigned* st) {
    XcdBarrier b; b.bar = bar; b.x = xb_xcc_id(); b.st = st;
    if (threadIdx.x == 0) (void)xb_add(&bar[XB_XCNT(b.x)], 1u);
    return b;
}
__device__ __forceinline__ void xcd_barrier_complete(unsigned* bar, unsigned x, unsigned& nloc, unsigned& nx) {
    const unsigned G = gridDim.x * gridDim.y * gridDim.z;
    unsigned sum, cnt, mine, sp = 0u;
    for (;;) {
        sum = 0u; cnt = 0u; mine = 0u;
#pragma unroll
        for (unsigned j = 0; j < 16; ++j) { const unsigned c = xb_ld(&bar[XB_XCNT(j)]); sum += c; cnt += (c > 0u) ? 1u : 0u; mine = (j == x) ? c : mine; }
        if (sum == G) break;
        __builtin_amdgcn_s_sleep(1);
        if ((++sp & 255u) == 0u) { if (xb_ld(&bar[XB_TMO])) break; if (sp > XB_SPIN_CAP) { atomicAdd(&bar[XB_TMO], 1u); break; } }
    }
    nloc = mine > 0u ? mine : 1u; nx = cnt > 0u ? cnt : 1u;
}

__device__ __forceinline__ void xcd_barrier(const XcdBarrier& b) {
    asm volatile("s_waitcnt vmcnt(0)" ::: "memory");
    __syncthreads();
    if (threadIdx.x == 0) {
        unsigned* bar = b.bar;
        __builtin_amdgcn_s_waitcnt(0);
        unsigned nloc = b.st[0], nx = b.st[1];
        if (nloc == 0u) { xcd_barrier_complete(bar, b.x, nloc, nx); b.st[0] = nloc; b.st[1] = nx; }
        const unsigned old = xb_add(&bar[XB_XSUB(b.x)], 1u);
        const unsigned gen = old / nloc;
        if (old + 1u == (gen + 1u) * nloc) {
            __builtin_amdgcn_fence(__ATOMIC_RELEASE, "agent");
            asm volatile("s_waitcnt vmcnt(0)" ::: "memory");
            const unsigned og = xb_add(&bar[XB_TOP], 1u);
            const unsigned tg = og / nx;
            if (og + 1u == (tg + 1u) * nx) xb_add(&bar[XB_TOPGEN], 1u);
            else XB_SPIN(xb_ld(&bar[XB_TOPGEN]) == tg, bar);
            __builtin_amdgcn_fence(__ATOMIC_ACQUIRE, "agent");
            xb_add(&bar[XB_XGEN(b.x)], 1u);
            asm volatile("s_waitcnt vmcnt(0)" ::: "memory");
        } else {
            XB_SPIN(xb_ld(&bar[XB_XGEN(b.x)]) == gen, bar);
            __builtin_amdgcn_fence(__ATOMIC_ACQUIRE, "agent");
            asm volatile("s_waitcnt vmcnt(0)" ::: "memory");
        }
    }
    __syncthreads();
}

struct Args { const float* in[19]; float* out; unsigned char* ws; int ph_lo, ph_hi; };
struct Frame {
    LAS unsigned char* lds;
    volatile LAS unsigned* MISC;
    gu32* ctl;
    int G;
    const Args* A;
};
#define PHASE_IDS int tid_ = threadIdx.x; asm volatile("" : "+v"(tid_)); const int tid = tid_, lane = tid & 63, wave = __builtin_amdgcn_readfirstlane(tid >> 6); (void)lane; (void)wave; unsigned char* ws_ = F.A->ws; asm volatile("" : "+s"(ws_))
#define F_IN(i) (F.A->in[i])
#define F_HR (F.A->out)
#define F_WIN ((bf16*)(ws_ + WS_WIN))
#define F_WOUT ((bf16*)(ws_ + WS_WOUT))
#define F_WUP ((bf16*)(ws_ + WS_WUP))
#define F_WDN ((bf16*)(ws_ + WS_WDN))
#define F_HB ((bf16*)(ws_ + WS_HB))
#define F_PROJ ((bf16*)(ws_ + WS_PROJ))
#define F_O ((bf16*)(ws_ + WS_O))
#define F_UG ((bf16*)(ws_ + WS_UG))
#define F_ACT ((bf16*)(ws_ + WS_ACT))
#define F_KCMP ((float*)(ws_ + WS_KCMP))
#define F_MEMKV ((float*)(ws_ + WS_MEMKV))
#define F_KMEAN ((float*)(ws_ + WS_KMEAN))
#define F_FOXC ((double*)(ws_ + WS_FOXC))
__device__ __forceinline__ float wave_sum(float v) {
#pragma unroll
    for (int o = 1; o < 64; o <<= 1) v += __shfl_xor(v, o);
    return v;
}
__device__ __forceinline__ void p0_transpose_item(const float* W, int K, int N, bf16* WT, LAS float* scr, int item, int lane) {
    const int nblk = N / 32, kb = item / nblk, nb = item % nblk, k0 = 64 * kb, n0 = 32 * nb;
#pragma unroll 8
    for (int i = 0; i < 32; ++i) { const int kk = 2 * i + (lane >> 5); scr[kk * 33 + (lane & 31)] = W[(size_t)(k0 + kk) * N + n0 + (lane & 31)]; }
    LDS_WAIT(); asm volatile("" ::: "memory");
    const int c = lane & 7;
#pragma unroll
    for (int j = 0; j < 4; ++j) { const int n = (lane >> 3) + 8 * j; const LAS float* s = scr + (8 * c) * 33 + n;
        v4u o; o.x = pk2(s[0 * 33], s[1 * 33]); o.y = pk2(s[2 * 33], s[3 * 33]); o.z = pk2(s[4 * 33], s[5 * 33]); o.w = pk2(s[6 * 33], s[7 * 33]);
        *(GAS v4u*)(WT + (size_t)(n0 + n) * K + k0 + 8 * c) = o; }
    LDS_WAIT(); asm volatile("" ::: "memory");
}
__device__ __forceinline__ int in_src(int n) { return n < 2816 ? n : n < 5120 ? n + 24 : n < 5376 ? n + 36 : n < 5400 ? n - 5376 + 2816 : n < 5412 ? n - 5400 + 5144 : -1; }
__device__ __forceinline__ float in_scale(int n) { return (n < 512 || (n >= 1536 && n < 2048) || (n >= 2816 && n < 3584) || (n >= 5120 && n < 5376)) ? C2 : 1.0f; }
__device__ __forceinline__ void p0_transpose_in(const float* W, bf16* WT, LAS float* scr, int item, int lane) {
    constexpr int K = D, nblk = NPROJ / 32; const int kb = item / nblk, nb = item % nblk, k0 = 64 * kb, n0 = 32 * nb;
    const int sc = in_src(n0 + (lane & 31)); const float fs = in_scale(n0 + (lane & 31));
#pragma unroll 8
    for (int i = 0; i < 32; ++i) { const int kk = 2 * i + (lane >> 5); scr[kk * 33 + (lane & 31)] = sc >= 0 ? W[(size_t)(k0 + kk) * NIN + sc] * fs : 0.0f; }
    LDS_WAIT(); asm volatile("" ::: "memory");
    const int c = lane & 7;
#pragma unroll
    for (int j = 0; j < 4; ++j) { const int n = (lane >> 3) + 8 * j; const LAS float* s = scr + (8 * c) * 33 + n;
        v4u o; o.x = pk2(s[0 * 33], s[1 * 33]); o.y = pk2(s[2 * 33], s[3 * 33]); o.z = pk2(s[4 * 33], s[5 * 33]); o.w = pk2(s[6 * 33], s[7 * 33]);
        *(GAS v4u*)(WT + (size_t)(n0 + n) * K + k0 + 8 * c) = o; }
    LDS_WAIT(); asm volatile("" ::: "memory");
}
__device__ __forceinline__ void ln_row(const float* src, const float* g, const float* bt, float* dstf, bf16* dstb, int lane) {
    const f32x4* xr = (const f32x4*)src + lane;
    f32x4 v[8]; float s = 0.f;
#pragma unroll
    for (int j = 0; j < 8; ++j) { v[j] = xr[64 * j]; s += (v[j].x + v[j].y) + (v[j].z + v[j].w); }
    const float mean = wave_sum(s) * (1.f / D); float s2 = 0.f;
#pragma unroll
    for (int j = 0; j < 8; ++j) { v[j] = v[j] - mean; s2 += (v[j].x * v[j].x + v[j].y * v[j].y) + (v[j].z * v[j].z + v[j].w * v[j].w); }
    const float rstd = 1.f / sqrtf(wave_sum(s2) * (1.f / D) + LN_EPS);
    f32x4* of = (f32x4*)dstf + lane; uint2* ob = (uint2*)dstb + lane;
#pragma unroll
    for (int j = 0; j < 8; ++j) { const f32x4 gg = ((const f32x4*)g)[lane + 64 * j], bb = ((const f32x4*)bt)[lane + 64 * j]; const f32x4 y = v[j] * rstd * gg + bb;
        of[64 * j] = y; ob[64 * j] = make_uint2(pk2(y.x, y.y), pk2(y.z, y.w)); }
}
__device__ __forceinline__ void ln_phase(Frame& F, const float* src, const float* g, const float* bt) {
    PHASE_IDS;
    const int gw = blockIdx.x * NWAVES + wave, NGW = F.G * NWAVES;
    for (int m = gw; m < M; m += NGW) ln_row(src + (size_t)m * D, g, bt, F_HR + (size_t)m * D, F_HB + (size_t)m * D, lane);
}
__device__ __forceinline__ void p0_prologue(Frame& F) {
    PHASE_IDS;
    LAS float* scr = (LAS float*)(F.lds + RING_OFF + wave * 16384);
    const int gw = blockIdx.x * NWAVES + wave, NGW = F.G * NWAVES;
    constexpr int I_IN = (D / 64) * (NPROJ / 32), I_OUT = (D / 64) * (D / 32), I_UP = (D / 64) * (NUP / 32), I_DN = (DFF / 64) * (D / 32), I_L = I_IN + I_OUT + I_UP + I_DN;
    for (int it = gw; it < NLAYER * I_L; it += NGW) {
        const int l = it / I_L; int r = it % I_L;
        if (r < I_IN) { p0_transpose_in(F_IN(4) + (size_t)l * D * NIN, F_WIN + (size_t)l * NPROJ * D, scr, r, lane); continue; } r -= I_IN;
        if (r < I_OUT) { p0_transpose_item(F_IN(10) + (size_t)l * D * D, D, D, F_WOUT + (size_t)l * D * D, scr, r, lane); continue; } r -= I_OUT;
        if (r < I_UP) { p0_transpose_item(F_IN(13) + (size_t)l * D * NUP, D, NUP, F_WUP + (size_t)l * NUP * D, scr, r, lane); continue; } r -= I_UP;
        p0_transpose_item(F_IN(16) + (size_t)l * DFF * D, DFF, D, F_WDN + (size_t)l * D * DFF, scr, r, lane);
    }
    ln_phase(F, F_IN(0), F_IN(2), F_IN(3));
    for (int o = blockIdx.x * NTHR + tid; o < NLAYER * 512 * 512; o += F.G * NTHR) {
        const int c = o & 511, r = (o >> 9) & 511, l = o >> 18;
        const float* mr = F_IN(1) + (size_t)r * D; const float* w = F_IN(6) + (size_t)l * D * 512 + c; float a = 0.f;
        for (int k = 0; k < D; ++k) a += mr[k] * w[(size_t)k * 512];
        F_MEMKV[o] = a;
    }
}

__device__ __forceinline__ void load_q64(unsigned (&q)[32], const bf16* p) {
    const uint4* p4 = (const uint4*)p;
#pragma unroll
    for (int c = 0; c < 8; ++c) { const uint4 w = p4[c]; q[4 * c] = w.x; q[4 * c + 1] = w.y; q[4 * c + 2] = w.z; q[4 * c + 3] = w.w; }
}
__device__ __forceinline__ float dot64(const unsigned (&q)[32], const bf16* kp) {
    const uint4* p = (const uint4*)kp; float s0 = 0.f, s1 = 0.f;
#pragma unroll
    for (int c = 0; c < 8; ++c) { const uint4 w = p[c];
        s0 += blo(q[4 * c]) * blo(w.x) + blo(q[4 * c + 1]) * blo(w.y) + blo(q[4 * c + 2]) * blo(w.z) + blo(q[4 * c + 3]) * blo(w.w);
        s1 += bhi(q[4 * c]) * bhi(w.x) + bhi(q[4 * c + 1]) * bhi(w.y) + bhi(q[4 * c + 2]) * bhi(w.z) + bhi(q[4 * c + 3]) * bhi(w.w); if ((c & 3) == 3) asm volatile("" ::: "memory"); }
    return s0 + s1;
}
__device__ __forceinline__ float dot64f(const unsigned (&q)[32], const float* kp) {
    const f32x4* p = (const f32x4*)kp; float s0 = 0.f, s1 = 0.f;
#pragma unroll
    for (int c = 0; c < 16; ++c) { const f32x4 w = p[c]; s0 += blo(q[2 * c]) * w.x + blo(q[2 * c + 1]) * w.z; s1 += bhi(q[2 * c]) * w.y + bhi(q[2 * c + 1]) * w.w; if ((c & 3) == 3) asm volatile("" ::: "memory"); }
    return s0 + s1;
}
__device__ __forceinline__ void axpy64(float (&o)[64], float f, float p, const bf16* vp) {
    const uint4* p4 = (const uint4*)vp;
#pragma unroll
    for (int c = 0; c < 8; ++c) { const uint4 w = p4[c];
        o[8 * c] = o[8 * c] * f + p * blo(w.x); o[8 * c + 1] = o[8 * c + 1] * f + p * bhi(w.x); o[8 * c + 2] = o[8 * c + 2] * f + p * blo(w.y); o[8 * c + 3] = o[8 * c + 3] * f + p * bhi(w.y);
        o[8 * c + 4] = o[8 * c + 4] * f + p * blo(w.z); o[8 * c + 5] = o[8 * c + 5] * f + p * bhi(w.z); o[8 * c + 6] = o[8 * c + 6] * f + p * blo(w.w); o[8 * c + 7] = o[8 * c + 7] * f + p * bhi(w.w); if ((c & 3) == 3) asm volatile("" ::: "memory"); }
}
__device__ __forceinline__ void axpy64f(float (&o)[64], float f, float p, const float* vp) {
    const f32x4* p4 = (const f32x4*)vp;
#pragma unroll
    for (int c = 0; c < 16; ++c) { const f32x4 w = p4[c]; o[4 * c] = o[4 * c] * f + p * w.x; o[4 * c + 1] = o[4 * c + 1] * f + p * w.y; o[4 * c + 2] = o[4 * c + 2] * f + p * w.z; o[4 * c + 3] = o[4 * c + 3] * f + p * w.w; if ((c & 3) == 3) asm volatile("" ::: "memory"); }
}
#define KEY_STEP(sv, vptr) do { const float mn_ = fmaxf(m, (sv)); const float f_ = ex2(m - mn_), p_ = ex2((sv) - mn_); l = l * f_ + p_; axpy64(o, f_, p_, (vptr)); m = mn_; } while (0)
#define KEY_STEPF(sv, vptr) do { const float mn_ = fmaxf(m, (sv)); const float f_ = ex2(m - mn_), p_ = ex2((sv) - mn_); l = l * f_ + p_; axpy64f(o, f_, p_, (vptr)); m = mn_; } while (0)
__device__ __forceinline__ void store_o64(bf16* op, const float (&o)[64], float sc) {
    uint4* p4 = (uint4*)op;
#pragma unroll
    for (int c = 0; c < 8; ++c) { uint4 w; w.x = pk2(o[8 * c] * sc, o[8 * c + 1] * sc); w.y = pk2(o[8 * c + 2] * sc, o[8 * c + 3] * sc); w.z = pk2(o[8 * c + 4] * sc, o[8 * c + 5] * sc); w.w = pk2(o[8 * c + 6] * sc, o[8 * c + 7] * sc); p4[c] = w; }
}
#define UNI(x) __builtin_amdgcn_readfirstlane(x)

__device__ __forceinline__ void fox_item_naive(Frame& F, int b, int h, int qblk) {
    PHASE_IDS;
    const int t = qblk * 512 + tid; const size_t row = (size_t)b * S + t;
    unsigned q[32]; load_q64(q, F_PROJ + row * NPROJ + C_FQ + h * 64);
    const double* cc = F_FOXC + (size_t)(b * 12 + h) * S; const double ci = cc[t];
    float m = -INFINITY, l = 0.f; float o[64];
#pragma unroll
    for (int d = 0; d < 64; ++d) o[d] = 0.f;
    const int jmax = UNI(qblk * 512 + wave * 64 + 63);
    const bf16* kb = F_PROJ + (size_t)b * S * NPROJ + C_FK + h * 64; const bf16* vb = F_PROJ + (size_t)b * S * NPROJ + C_FV + h * 64;
    for (int j = 0; j <= jmax; ++j) {
        const float bias = (float)(ci - cc[j]);
        if (j <= t) { const float s = dot64(q, kb + (size_t)j * NPROJ) + bias; KEY_STEP(s, vb + (size_t)j * NPROJ); }
    }
    store_o64(F_O + row * D + (16 + h) * 64, o, 1.0f / l);
}
__device__ __forceinline__ void mem_item_naive(Frame& F, int layer, int b, int h, int qblk) {
    PHASE_IDS;
    const int t = qblk * 512 + tid; const size_t row = (size_t)b * S + t;
    unsigned q[32]; load_q64(q, F_PROJ + row * NPROJ + C_EQ + h * 64);
    float m = -INFINITY, l = 0.f; float o[64];
#pragma unroll
    for (int d = 0; d < 64; ++d) o[d] = 0.f;
    const float* kv = F_MEMKV + (size_t)layer * 512 * 512 + (size_t)b * 256 * 512;
    for (int j = 0; j < 256; ++j) { const float s = dot64f(q, kv + (size_t)j * 512 + h * 64); KEY_STEPF(s, kv + (size_t)j * 512 + 256 + h * 64); }
    store_o64(F_O + row * D + (28 + h) * 64, o, 1.0f / l);
}
__device__ __forceinline__ void moba_item_naive(Frame& F, int b, int h, int qblk) {
    PHASE_IDS;
    const int t = qblk * 512 + tid; const size_t row = (size_t)b * S + t;
    unsigned q[32]; load_q64(q, F_PROJ + row * NPROJ + C_MQ + h * 64);
    const int own = UNI((qblk * 512 + wave * 64) >> 8);
    float g0 = -INFINITY, g1 = -INFINITY, g2 = -INFINITY; int i0 = -1, i1 = -1, i2 = -1;
    const float* km = F_KMEAN + (size_t)(b * 8 + h) * 64 * 64;
    for (int j = 0; j < own; ++j) {
        const float g = dot64f(q, km + j * 64);
        if (g > g0) { g2 = g1; i2 = i1; g1 = g0; i1 = i0; g0 = g; i0 = j; }
        else if (g > g1) { g2 = g1; i2 = i1; g1 = g; i1 = j; }
        else if (g > g2) { g2 = g; i2 = j; }
    }
    const float slope = exp2f(-(float)(h + 1)) * LOG2E;
    float m = -INFINITY, l = 0.f; float o[64];
#pragma unroll
    for (int d = 0; d < 64; ++d) o[d] = 0.f;
    const bf16* kb = F_PROJ + (size_t)b * S * NPROJ + C_MK + h * 64; const bf16* vb = F_PROJ + (size_t)b * S * NPROJ + C_MV + h * 64;
    const int jmax = UNI(qblk * 512 + wave * 64 + 63);
    for (int j = own * 256; j <= jmax; ++j) {
        if (j <= t) { const float s = dot64(q, kb + (size_t)j * NPROJ) - slope * (float)(t - j); KEY_STEP(s, vb + (size_t)j * NPROJ); }
    }
#pragma unroll
    for (int n = 0; n < 3; ++n) {
        const int sb = n == 0 ? i0 : n == 1 ? i1 : i2;
        for (int off = 0; off < 256; ++off) {
            if (sb >= 0) { const int j = sb * 256 + off; const float s = dot64(q, kb + (size_t)j * NPROJ) - slope * (float)(t - j); KEY_STEP(s, vb + (size_t)j * NPROJ); }
        }
    }
    store_o64(F_O + row * D + h * 64, o, 1.0f / l);
}
__device__ __forceinline__ void nsa_item_naive(Frame& F, int b, int g, int qblk) {
    PHASE_IDS;
    const int ql = tid >> 2, hh = tid & 3, h = g * 4 + hh; const int t = qblk * 128 + ql; const size_t row = (size_t)b * S + t;
    LAS float* imp = (LAS float*)(F.lds + RING_OFF) + ql * 256;
    LAS int* selL = (LAS int*)(F.lds + SEL_OFF) + ql * 16;
    LAS float* stash = (LAS float*)(F.lds + RING_OFF) + tid * 64;
    for (int i = tid; i < 128 * 256; i += NTHR) ((LAS float*)(F.lds + RING_OFF))[i] = 0.f;
    __syncthreads();
    unsigned q[32]; load_q64(q, F_PROJ + row * NPROJ + C_NQ + h * 64);
    const float slope = exp2f(-(float)(h + 1)) * LOG2E;
    const float* kc = F_KCMP + (size_t)((0 * 2 + b) * 2 + g) * NCMP_PAD * 64; const float* vc = F_KCMP + (size_t)((1 * 2 + b) * 2 + g) * NCMP_PAD * 64;
    const int tmax = UNI(qblk * 128 + wave * 16 + 15);
    const int ncw = tmax >= 31 ? ((tmax - 31) >> 4) + 1 : 0;
    float m = -INFINITY, l = 0.f;
    for (int n = 0; n < ncw; ++n) {
        const int ce = 16 * n + 31;
        if (ce <= t) { const float s = dot64f(q, kc + n * 64) - slope * (float)(t - ce); const float mn = fmaxf(m, s); l = l * ex2(m - mn) + ex2(s - mn); m = mn; }
    }
    float o[64];
#pragma unroll
    for (int d = 0; d < 64; ++d) o[d] = 0.f;
    const float rl = l > 0.f ? 1.0f / l : 0.f;
    for (int n = 0; n < ncw; ++n) {
        const int ce = 16 * n + 31; float p = 0.f;
        if (ce <= t) { const float s = dot64f(q, kc + n * 64) - slope * (float)(t - ce); p = ex2(s - m) * rl; axpy64f(o, 1.0f, p, vc + n * 64); }
        float p4 = p + __shfl_xor(p, 1); p4 = p4 + __shfl_xor(p4, 2);
        if (hh == 0) { imp[n >> 2] += p4; if ((n & 3) == 3) imp[(n >> 2) + 1] += p4; }
    }
    __syncthreads();
    const int jt = t >> 6;
    if (hh == 0) { imp[0] = 1.0e4f; imp[jt] = 1.0e4f; if (jt >= 1) imp[jt - 1] = 1.0e4f; }
    __syncthreads();
    int nsel = 0;
    for (int i = 0; i < 16; ++i) {
        float best = -1.0f; int bi = -1;
        for (int k = 0; k <= jt; ++k) { const float v = imp[k]; if (v > best) { best = v; bi = k; } }
        if (bi < 0) break;
        __builtin_amdgcn_wave_barrier();
        imp[bi] = -2.0f; selL[i] = bi; nsel = i + 1;
        __builtin_amdgcn_wave_barrier();
    }
    __syncthreads();
    const bf16* gp = F_PROJ + row * NPROJ + C_GATE + h * 3;
    const float ga = 1.0f / (1.0f + __expf(-bf2f(gp[0]))), gb = 1.0f / (1.0f + __expf(-bf2f(gp[1]))), gc = 1.0f / (1.0f + __expf(-bf2f(gp[2])));
#pragma unroll
    for (int d = 0; d < 64; ++d) stash[d] = ga * o[d];
    const bf16* pb = F_PROJ + (size_t)b * S * NPROJ;
    m = -INFINITY; l = 0.f;
#pragma unroll
    for (int d = 0; d < 64; ++d) o[d] = 0.f;
    for (int i = 0; i < 16; ++i) {
        const int blk = i < nsel ? selL[i] : -1;
        for (int off = 0; off < 64; ++off) {
            const int j = blk * 64 + off;
            if (blk >= 0 && j <= t) { const float s = dot64(q, pb + (size_t)j * NPROJ + C_NKV + 2 * 128 + g * 64) - slope * (float)(t - j); KEY_STEP(s, pb + (size_t)j * NPROJ + C_NKV + 3 * 128 + g * 64); }
        }
    }
    { const float sc = l > 0.f ? gb / l : 0.f;
#pragma unroll
      for (int d = 0; d < 64; ++d) stash[d] += sc * o[d]; }
    m = -INFINITY; l = 0.f;
#pragma unroll
    for (int d = 0; d < 64; ++d) o[d] = 0.f;
    const int tmin = UNI(qblk * 128 + wave * 16);
    for (int j = (tmin - 511 > 0 ? tmin - 511 : 0); j <= tmax; ++j) {
        if (j <= t && t - j < 512) { const float s = dot64(q, pb + (size_t)j * NPROJ + C_NKV + 4 * 128 + g * 64) - slope * (float)(t - j); KEY_STEP(s, pb + (size_t)j * NPROJ + C_NKV + 5 * 128 + g * 64); }
    }
    { const float sc = l > 0.f ? gc / l : 0.f;
#pragma unroll
      for (int d = 0; d < 64; ++d) o[d] = stash[d] + sc * o[d]; }
    store_o64(F_O + row * D + (8 + h) * 64, o, 1.0f);
    __syncthreads();
}
__device__ __forceinline__ void cmp_item_naive(Frame& F, int layer, int item) {
    PHASE_IDS;
    const int chunk = item & 127, g = (item >> 7) & 1, b = (item >> 8) & 1, kv = item >> 9; const int n0 = chunk * 8;
    LAS float* X = (LAS float*)(F.lds + RING_OFF);
    LAS float* H = X + 144 * 64;
    const bf16* src = F_PROJ + (size_t)b * S * NPROJ + C_NKV + kv * 128 + g * 64;
    for (int i = tid; i < 144 * 64; i += NTHR) { const int p = 16 * n0 + (i >> 6); X[i] = p < S ? bf2f(src[(size_t)p * NPROJ + (i & 63)]) : 0.f; }
    __syncthreads();
    const int e = tid & 127, sub = tid >> 7;
    const float* w1 = F_IN(8) + (size_t)(layer * 2 + kv) * 32 * 64 * 128; const float* pe = F_IN(7) + (size_t)(layer * 2 + kv) * 32 * 64;
    float a0 = 0.f, a1 = 0.f;
    for (int ld = 0; ld < 2048; ++ld) { const float w = w1[(size_t)ld * 128 + e]; const float pv = pe[ld]; a0 += (X[(2 * sub) * 16 * 64 + ld] + pv) * w; a1 += (X[(2 * sub + 1) * 16 * 64 + ld] + pv) * w; }
    H[(2 * sub) * 128 + e] = gelu_tanh(a0); H[(2 * sub + 1) * 128 + e] = gelu_tanh(a1);
    __syncthreads();
    const int tok = tid >> 6, dd = tid & 63; const float* w2 = F_IN(9) + (size_t)(layer * 2 + kv) * 128 * 64; float a = 0.f;
    for (int k = 0; k < 128; ++k) a += H[tok * 128 + k] * w2[k * 64 + dd];
    if (n0 + tok < NCMP) F_KCMP[((size_t)((kv * 2 + b) * 2 + g) * NCMP_PAD + n0 + tok) * 64 + dd] = a;
    __syncthreads();
}
__device__ __forceinline__ void prep_phase(Frame& F, int layer) {
    PHASE_IDS;
    if (blockIdx.x < 24) {
        const int b = blockIdx.x / 12, h = blockIdx.x % 12; const float bf = F_IN(5)[layer * 12 + h];
        LAS double* part = (LAS double*)(F.lds + RING_OFF);
        const bf16* src = F_PROJ + (size_t)b * S * NPROJ + C_FF + h; float lf[32]; double s = 0.0;
#pragma unroll
        for (int i = 0; i < 32; ++i) { const float x = bf2f(src[(size_t)(tid * 32 + i) * NPROJ]) + bf; lf[i] = (fminf(x, 0.f) - log1pf(__expf(-fabsf(x)))) * LOG2E; s += (double)lf[i]; }
        part[tid] = s; __syncthreads();
        double pre = 0.0; for (int k = 0; k < tid; ++k) pre += part[k];
        double* dst = F_FOXC + (size_t)(b * 12 + h) * S + tid * 32;
#pragma unroll
        for (int i = 0; i < 32; ++i) { pre += (double)lf[i]; dst[i] = pre; }
        __syncthreads();
    }
    for (int it = blockIdx.x; it < 1024; it += F.G) cmp_item_naive(F, layer, it);
    for (int o = blockIdx.x * NTHR + tid; o < 2 * 8 * 64 * 64; o += F.G * NTHR) {
        const int d = o & 63, j = (o >> 6) & 63, h = (o >> 12) & 7, b = o >> 15;
        const bf16* src = F_PROJ + ((size_t)b * S + j * 256) * NPROJ + C_MK + h * 64 + d; float a = 0.f;
        for (int p = 0; p < 256; ++p) a += bf2f(src[(size_t)p * NPROJ]);
        F_KMEAN[o] = a * (1.0f / 256.0f);
    }
}
__device__ __forceinline__ void attn_phase_naive(Frame& F, int layer) {
    PHASE_IDS;
    constexpr int N_FOX = 2 * 12 * 32, N_NSA = 2 * 2 * 128, N_MOBA = 2 * 8 * 32, N_MEM = 2 * 4 * 32, N_ALL = N_FOX + N_NSA + N_MOBA + N_MEM;
    for (;;) {
        if (tid == 0) F.MISC[0] = __hip_atomic_fetch_add(F.ctl + CW_Q + 64 * layer, 1u, RLX_AGENT);
        __syncthreads();
        int it = (int)F.MISC[0];
        __syncthreads();
        if (it >= N_ALL) break;
        if (it < N_FOX) { const int qblk = 31 - it / 24, bh = it % 24; fox_item_naive(F, bh / 12, bh % 12, qblk); continue; } it -= N_FOX;
        if (it < N_NSA) { const int qblk = 127 - it / 4, bg = it % 4; nsa_item_naive(F, bg >> 1, bg & 1, qblk); continue; } it -= N_NSA;
        if (it < N_MOBA) { const int qblk = 31 - it / 16, bh = it % 16; moba_item_naive(F, bh >> 3, bh & 7, qblk); continue; } it -= N_MOBA;
        { const int qblk = it / 8, bh = it % 8; mem_item_naive(F, layer, bh >> 2, bh & 3, qblk); }
    }
}
__device__ __forceinline__ void act_phase(Frame& F, int layer) {
    PHASE_IDS;
    const float* cw = F_IN(14) + (size_t)layer * 3 * DFF; const float* cb = F_IN(15) + (size_t)layer * DFF;
    constexpr int CG = DFF / 8;
    for (size_t i = (size_t)blockIdx.x * NTHR + tid; i < (size_t)MH * CG; i += (size_t)F.G * NTHR) {
        const int cg = (int)(i % CG), t = (int)(i / CG), c0 = cg * 8;
        const bf16* ur = F_UG + (size_t)t * NUP + c0; const bf16* gr = ur + DFF;
        const uint4 uu = *(const uint4*)ur, g2 = *(const uint4*)gr;
        uint4 g1 = make_uint4(0, 0, 0, 0), g0 = make_uint4(0, 0, 0, 0);
        if (t >= 1) g1 = *(const uint4*)(gr - NUP);
        if (t >= 2) g0 = *(const uint4*)(gr - 2 * NUP);
        const unsigned ua[4] = {uu.x, uu.y, uu.z, uu.w}, a2[4] = {g2.x, g2.y, g2.z, g2.w}, a1[4] = {g1.x, g1.y, g1.z, g1.w}, a0[4] = {g0.x, g0.y, g0.z, g0.w};
        unsigned r[4];
#pragma unroll
        for (int k = 0; k < 4; ++k) {
            const int c = c0 + 2 * k;
            const float x0 = cb[c] + cw[c] * blo(a0[k]) + cw[DFF + c] * blo(a1[k]) + cw[2 * DFF + c] * blo(a2[k]);
            const float x1 = cb[c + 1] + cw[c + 1] * bhi(a0[k]) + cw[DFF + c + 1] * bhi(a1[k]) + cw[2 * DFF + c + 1] * bhi(a2[k]);
            r[k] = pk2(gelu_tanh(x0) * blo(ua[k]), gelu_tanh(x1) * bhi(ua[k]));
        }
        *(uint4*)(F_ACT + (size_t)t * DFF + c0) = make_uint4(r[0], r[1], r[2], r[3]);
    }
}

__device__ __forceinline__ bool in_range(int lo, int hi, int k) { asm volatile("" : "+s"(lo), "+s"(hi), "+s"(k)); return lo <= k && k < hi; }
constexpr int N_STEPS = 1 + NLAYER * 12;
template <int PH> __device__ __forceinline__ void run_phase(Frame& F, const Args& args, int l, int half) {
    unsigned char* ws_ = args.ws; asm volatile("" : "+s"(ws_));
    if constexpr (PH == 0) { p0_prologue(F); }
    if constexpr (PH == 1) {
        pg8::Gemm g{F_HB, F_WIN + (size_t)l * NPROJ * D, M, NPROJ, D}; pg8::StaticOrder So; So.init(M, NPROJ, F.G, (int)blockIdx.x);
        pg8::EpiBf16<0> E{F_PROJ, NPROJ, nullptr, 0, 0, 1.f};
        pg8::gemm_phase<pg8::EpiBf16<0>, pg8::StaticOrder, PG8_ALIGN, PG8_SP2>(F.lds + RING_OFF, g, So, E);
    }
    if constexpr (PH == 2) { prep_phase(F, l); }
    if constexpr (PH == 3) { attn_phase_naive(F, l); }
    if constexpr (PH == 4) {
        pg8::Gemm g{F_O, F_WOUT + (size_t)l * D * D, M, D, D}; pg8::StaticOrder So; So.init(M, D, F.G, (int)blockIdx.x);
        pg8::EpiResF32 E{F_HR, D, ALPHA};
        pg8::gemm_phase<pg8::EpiResF32, pg8::StaticOrder, PG8_ALIGN, PG8_SP2>(F.lds + RING_OFF, g, So, E);
    }
    if constexpr (PH == 5) { ln_phase(F, F_HR, F_IN(11) + (size_t)l * D, F_IN(12) + (size_t)l * D); }
    if constexpr (PH == 6) {
        pg8::Gemm g{F_HB + (size_t)half * MH * D, F_WUP + (size_t)l * NUP * D, MH, NUP, D}; pg8::StaticOrder So; So.init(MH, NUP, F.G, (int)blockIdx.x);
        pg8::EpiBf16<0> E{F_UG, NUP, nullptr, 0, 0, 1.f};
        pg8::gemm_phase<pg8::EpiBf16<0>, pg8::StaticOrder, PG8_ALIGN, PG8_SP2>(F.lds + RING_OFF, g, So, E);
    }
    if constexpr (PH == 7) { act_phase(F, l); }
    if constexpr (PH == 8) {
        pg8::Gemm g{F_ACT, F_WDN + (size_t)l * D * DFF, MH, D, DFF}; pg8::StaticOrder So; So.init(MH, D, F.G, (int)blockIdx.x);
        pg8::EpiResF32 E{F_HR + (size_t)half * MH * D, D, ALPHA};
        pg8::gemm_phase<pg8::EpiResF32, pg8::StaticOrder, PG8_ALIGN, PG8_SP2>(F.lds + RING_OFF, g, So, E);
    }
    if constexpr (PH == 9) { ln_phase(F, F_HR, F_IN(17) + (size_t)l * D, F_IN(18) + (size_t)l * D); }
}
template <int PH> __global__ void __launch_bounds__(NTHR, 2) k_phase(Args args, int l, int half) {
    extern __shared__ __attribute__((aligned(16))) unsigned char lds[];
    Frame F;
    F.lds = (LAS unsigned char*)lds;
    F.MISC = (volatile LAS unsigned*)(F.lds + MISC_OFF);
    F.G = gridDim.x;
    F.A = &args;
    F.ctl = (gu32*)(args.ws + WS_CTL);
    for (int u = threadIdx.x; u < (LDS_BYTES - LDSCTL_OFF) / 4; u += NTHR) ((LAS unsigned*)(F.lds + LDSCTL_OFF))[u] = 0u;
    __syncthreads();
    run_phase<PH>(F, args, l, half);
}

template <int PH> static bool set_lds_one() { return hipFuncSetAttribute((const void*)k_phase<PH>, hipFuncAttributeMaxDynamicSharedMemorySize, LDS_BYTES) == hipSuccess; }
static bool set_lds_all() { return set_lds_one<0>() && set_lds_one<1>() && set_lds_one<2>() && set_lds_one<3>() && set_lds_one<4>() && set_lds_one<5>() && set_lds_one<6>() && set_lds_one<7>() && set_lds_one<8>() && set_lds_one<9>(); }
extern "C" void kernel_launch(void* const* d_in, const int* in_sizes, int n_in, void* d_out, int out_size, void* d_ws, size_t ws_size, hipStream_t stream) {
    static int grid = 0;
    if (grid == 0) {
        if (n_in != 19 || in_sizes[0] != M * D || out_size != M * D || ws_size < WS_END) { fprintf(stderr, "kernel_launch: unexpected shapes (n_in %d, in0 %d, out %d, ws %zu)\n", n_in, n_in > 0 ? in_sizes[0] : -1, out_size, ws_size); grid = -1; return; }
        int dev = 0, cus = 0;
        if (hipGetDevice(&dev) != hipSuccess || hipDeviceGetAttribute(&cus, hipDeviceAttributeMultiprocessorCount, dev) != hipSuccess) { grid = -1; return; }
        if (!set_lds_all()) { fprintf(stderr, "kernel_launch: hipFuncSetAttribute failed\n"); grid = -1; return; }
        (void)hipGetLastError();
        grid = cus;
    }
    if (grid < 0) return;
    if (hipMemsetAsync((char*)d_ws + WS_CTL, 0, CTL_ZERO_BYTES, stream) != hipSuccess) return;
    Args a{};
    for (int i = 0; i < 19; ++i) a.in[i] = (const float*)d_in[i];
    a.out = (float*)d_out; a.ws = (unsigned char*)d_ws;
#define LAUNCH(PH, l, h) hipLaunchKernelGGL(k_phase<PH>, dim3(grid), dim3(NTHR), LDS_BYTES, stream, a, (int)(l), (int)(h))
    LAUNCH(0, 0, 0);
    for (int l = 0; l < NLAYER; ++l) {
        LAUNCH(1, l, 0); LAUNCH(2, l, 0); LAUNCH(3, l, 0); LAUNCH(4, l, 0); LAUNCH(5, l, 0);
        for (int h = 0; h < 2; ++h) { LAUNCH(6, l, h); LAUNCH(7, l, h); LAUNCH(8, l, h); }
        LAUNCH(9, l, 0);
    }
#undef LAUNCH
}
```

```cpp
#include <hip/hip_runtime.h>
#include <cstdio>
#include <cstdint>
namespace pg8 {
#define PG8_LAS __attribute__((address_space(3)))
typedef unsigned short bf16_t;
typedef short bf16x8 __attribute__((ext_vector_type(8)));
typedef float f32x4 __attribute__((ext_vector_type(4)));
typedef unsigned u32x4 __attribute__((ext_vector_type(4)));
constexpr int BM = 256, BK = 64, HALF = 128, HTB = HALF * BK * 2  , STAGE_BYTES = 8 * HTB, NXCD = 8, WGM = 8;

__host__ __device__ __forceinline__ int lds_byte(int r, int c) { const int st = (r >> 4) * 2 + (c >> 5), rr = r & 15, cc = c & 31, ob = rr * 64 + cc * 2; return st * 1024 + (ob ^ (((ob >> 9) & 1) << 5)); }
__host__ __device__ __forceinline__ void stage_rc(int b, int& R, int& C) { const int st = b / 1024, sb = b % 1024, swz = sb ^ (((sb >> 9) & 1) << 5); R = (st >> 1) * 16 + swz / 64; C = (st & 1) * 32 + (swz % 64) / 2; }
__host__ __device__ __forceinline__ int perm32(int rho) { const int n = rho >> 4, i = rho & 15; return 8 * (i >> 2) + 4 * n + (i & 3); }

struct Unit { int pm, pn; };
struct Gemm { const bf16_t* A; const bf16_t* Bt; int M, N, K; };

struct StaticOrder {
    int nM, nN, nwg, G, c;
    __host__ __device__ void init(int M, int N, int G_, int c_) { nM = M / BM; nN = N / BM; nwg = nM * nN; G = G_; c = c_; }
    __host__ __device__ bool next(int i, Unit& u) const {
        const long L = (long)i * G + c; if (L >= nwg) return false;
        int wgid = (int)L; { const int q = nwg / NXCD, r = nwg % NXCD, xcd = wgid % NXCD, off = wgid / NXCD; wgid = (xcd < r ? xcd * (q + 1) : r * (q + 1) + (xcd - r) * q) + off; }
        const int nig = WGM * nN, gid = wgid / nig, fm = gid * WGM, gsz = (nM - fm) < WGM ? (nM - fm) : WGM;
        u.pm = fm + ((wgid % nig) % gsz); u.pn = (wgid % nig) / gsz; return true;
    }
    __device__ __forceinline__ void a_ready(const Unit&) const {}
    __device__ __forceinline__ void done(const Unit&) const {}
};

__device__ __forceinline__ unsigned cvt_pk_bf16(float lo, float hi) { unsigned r; asm volatile("v_cvt_pk_bf16_f32 %0, %1, %2" : "=v"(r) : "v"(lo), "v"(hi)); return r; }
typedef float f32x2 __attribute__((ext_vector_type(2)));
__device__ __forceinline__ f32x2 gelu_pk(f32x2 v) {
    const f32x2 av = __builtin_elementwise_abs(v), d = av * 0.2316418882f + 1.0f;
    f32x2 t; t.x = __builtin_amdgcn_rcpf(d.x); t.y = __builtin_amdgcn_rcpf(d.y);
    f32x2 q = t * 0.5307027145f + (-0.7265760135f); q = q * t + 0.7107068705f; q = q * t + (-0.142248368f); q = q * t + 0.127414796f; q = q * t;
    const f32x2 s = (v * v) * (-0.72134752044f);
    f32x2 e; e.x = __builtin_amdgcn_exp2f(s.x); e.y = __builtin_amdgcn_exp2f(s.y);
    const f32x2 m = v * (q * e), r = v - m;
    f32x2 o; o.x = v.x < 0.f ? m.x : r.x; o.y = v.y < 0.f ? m.y : r.y; return o;
}

template <int ACT  > struct EpiBf16 {
    static constexpr bool PERM = true, AFTER_DRAIN = false; static_assert(ACT == 0 || ACT == 1, "EpiBf16: ACT is 0 (none) or 1 (gelu_pk)");
    bf16_t* O; int ldc; const float* bias; int split_cols; size_t split_stride; float scale0;
    __device__ __forceinline__ void operator()(const f32x4 (&acc)[2][2][4][2], const Unit& u, int wr, int wc, int fr, int fq) const {
        const int row0 = u.pm * BM + wr * 64 + fr; int colt = u.pn * BM; bf16_t* base = O;
        float sc = 1.f; if (split_cols) { const int t = colt / split_cols; base += (size_t)t * split_stride; colt -= t * split_cols; if (t == 0) sc = scale0; }
        const int col0 = colt + wc * 32 + 8 * fq, bcol0 = u.pn * BM + wc * 32 + 8 * fq;
        f32x4 bv[2][2];
#pragma unroll
        for (int bj = 0; bj < 2; ++bj)
#pragma unroll
            for (int n = 0; n < 2; ++n) bv[bj][n] = bias ? *(const f32x4*)(bias + bcol0 + bj * HALF + 4 * n) : (f32x4){0.f, 0.f, 0.f, 0.f};
#pragma unroll
        for (int ai = 0; ai < 2; ++ai)
#pragma unroll
            for (int m = 0; m < 4; ++m) { bf16_t* rowp = base + (size_t)(row0 + ai * HALF + m * 16) * ldc + col0;
#pragma unroll
                for (int bj = 0; bj < 2; ++bj) { f32x4 v0 = acc[ai][bj][m][0] + bv[bj][0], v1 = acc[ai][bj][m][1] + bv[bj][1];
                    if (ACT == 1) { f32x2 a = gelu_pk((f32x2){v0[0], v0[1]}), b = gelu_pk((f32x2){v0[2], v0[3]}), c = gelu_pk((f32x2){v1[0], v1[1]}), d = gelu_pk((f32x2){v1[2], v1[3]});
                        v0 = (f32x4){a.x, a.y, b.x, b.y}; v1 = (f32x4){c.x, c.y, d.x, d.y}; }
                    v0 = v0 * sc; v1 = v1 * sc; u32x4 w; w.x = cvt_pk_bf16(v0[0], v0[1]); w.y = cvt_pk_bf16(v0[2], v0[3]); w.z = cvt_pk_bf16(v1[0], v1[1]); w.w = cvt_pk_bf16(v1[2], v1[3]);
                    *(u32x4*)(rowp + bj * HALF) = w; } }
    }
};


struct EpiResF32 {
    static constexpr bool PERM = false, AFTER_DRAIN = false;
    float* out; int ldc; float alpha;
    __device__ __forceinline__ void operator()(const f32x4 (&acc)[2][2][4][2], const Unit& u, int wr, int wc, int fr, int fq) const {
        const int col0 = u.pn * BM + wc * 32 + 4 * fq;
#pragma unroll
        for (int ai = 0; ai < 2; ++ai)
#pragma unroll
            for (int m = 0; m < 4; ++m) { float* rowp = out + (size_t)(u.pm * BM + ai * HALF + wr * 64 + m * 16 + fr) * ldc + col0;
#pragma unroll
                for (int bj = 0; bj < 2; ++bj)
#pragma unroll
                    for (int n = 0; n < 2; ++n) { f32x4* p = (f32x4*)(rowp + bj * HALF + n * 16); const f32x4 b = *p; *p = b * alpha + acc[ai][bj][m][n]; }
                asm volatile("" ::: "memory"); }
    }
};
template <class Epi, class Sched, bool ALIGN_EPI = false, bool SP2 = false>
__device__ __forceinline__ void gemm_phase(PG8_LAS unsigned char* lds, const Gemm g, const Sched& S, const Epi& E) {
    int tid_ = threadIdx.x; asm volatile("" : "+v"(tid_));
    const int tid = tid_, wid = __builtin_amdgcn_readfirstlane(tid >> 6), lane = tid & 63, wr = wid >> 2, wc = wid & 3, fr = lane & 15, fq = lane >> 4;
    const int K = g.K, nt = K / BK;
    unsigned voffA[2], voffB[2];
#pragma unroll
    for (int i = 0; i < 2; ++i) { int R, C; stage_rc(tid * 16 + i * 8192, R, C); const int Rb = Epi::PERM ? ((R & ~31) + perm32(R & 31)) : R;
        voffA[i] = (unsigned)(R * K + C) * 2u; voffB[i] = (unsigned)(Rb * K + C) * 2u; }
    const size_t kstep = (size_t)(BK * 2);
    const size_t hstep = (size_t)HALF * K * 2;
    const size_t tstep = 2 * hstep;
    const unsigned ldsw = (unsigned)wid * 1024u;
    const int aoff = lds_byte(wr * 64 + fr, fq * 8), boff = lds_byte(wc * 32 + fr, fq * 8);
#define PG8_SA(b, h) (((b) * 2 + (h)) * HTB)
#define PG8_SB(b, h) ((4 + (b) * 2 + (h)) * HTB)
#define PG8_STAGE(bufoff, gbase, voff) do { _Pragma("unroll") for (int _i = 0; _i < 2; ++_i) \
        __builtin_amdgcn_global_load_lds((const unsigned*)((const char*)(gbase) + (voff)[_i]), (PG8_LAS unsigned*)(lds + (bufoff) + ldsw + _i * 8192), 16, 0, 0); } while (0)
#define PG8_LDA(dst, b, h) do { _Pragma("unroll") for (int m = 0; m < 4; ++m) _Pragma("unroll") for (int k = 0; k < 2; ++k) dst[m][k] = *(const PG8_LAS bf16x8*)(lds + PG8_SA(b, h) + aoff + m * 2048 + k * 1024); } while (0)
#define PG8_LDB(dst, b, h) do { _Pragma("unroll") for (int n = 0; n < 2; ++n) _Pragma("unroll") for (int k = 0; k < 2; ++k) dst[n][k] = *(const PG8_LAS bf16x8*)(lds + PG8_SB(b, h) + boff + n * 2048 + k * 1024); } while (0)
#define PG8_MMA(ai, bj, At, Bt) do { __builtin_amdgcn_s_setprio(1); _Pragma("unroll") for (int m = 0; m < 4; ++m) _Pragma("unroll") for (int n = 0; n < 2; ++n) _Pragma("unroll") for (int k = 0; k < 2; ++k) \
        acc[ai][bj][m][n] = __builtin_amdgcn_mfma_f32_16x16x32_bf16(Bt[n][k], At[m][k], acc[ai][bj][m][n], 0, 0, 0); __builtin_amdgcn_s_setprio(0); } while (0)
#define PG8_WAIT_V(n) asm volatile("s_waitcnt vmcnt(" #n ")" ::: "memory")
#define PG8_WAIT_L(n) asm volatile("s_waitcnt lgkmcnt(" #n ")" ::: "memory")
#define PG8_BAR __builtin_amdgcn_s_barrier()
#define PG8_SCHED __builtin_amdgcn_sched_barrier(0)
    Unit cur, nxt; int ui = 0;
    if (!S.next(0, cur)) return;
    f32x4 acc[2][2][4][2];
#pragma unroll
    for (int a = 0; a < 2; ++a)
#pragma unroll
        for (int b = 0; b < 2; ++b)
#pragma unroll
            for (int m = 0; m < 4; ++m)
#pragma unroll
                for (int n = 0; n < 2; ++n) acc[a][b][m][n] = (f32x4){0.f, 0.f, 0.f, 0.f};
    bf16x8 At[4][2], B0[2][2], B1[2][2];
    const char* cA = (const char*)g.A + (size_t)cur.pm * tstep; const char* cB = (const char*)g.Bt + (size_t)cur.pn * tstep;
    S.a_ready(cur);
    if constexpr (SP2) {
        PG8_STAGE(PG8_SB(0, 0), cB, voffB); PG8_STAGE(PG8_SB(0, 1), cB + hstep, voffB); PG8_STAGE(PG8_SA(0, 0), cA, voffA); PG8_STAGE(PG8_SA(0, 1), cA + hstep, voffA);
        if (wr == 1) PG8_BAR;
        PG8_WAIT_V(2); PG8_BAR;
        PG8_STAGE(PG8_SB(1, 0), cB + kstep, voffB); PG8_STAGE(PG8_SA(1, 0), cA + kstep, voffA); PG8_STAGE(PG8_SB(1, 1), cB + hstep + kstep, voffB);
        PG8_WAIT_V(6); PG8_BAR;
    } else {
        PG8_STAGE(PG8_SB(0, 0), cB, voffB); PG8_STAGE(PG8_SA(0, 0), cA, voffA); PG8_STAGE(PG8_SB(0, 1), cB + hstep, voffB); PG8_STAGE(PG8_SA(0, 1), cA + hstep, voffA);
        if (wr == 1) PG8_BAR;
        PG8_WAIT_V(4); PG8_BAR;
        PG8_STAGE(PG8_SB(1, 0), cB + kstep, voffB); PG8_STAGE(PG8_SA(1, 0), cA + kstep, voffA); PG8_STAGE(PG8_SB(1, 1), cB + hstep + kstep, voffB);
        PG8_WAIT_V(6); PG8_BAR;
    }
    for (;;) {
        const bool has_next = S.next(ui + 1, nxt);
        const char* nA = has_next ? (const char*)g.A + (size_t)nxt.pm * tstep : cA; const char* nB = has_next ? (const char*)g.Bt + (size_t)nxt.pn * tstep : cB;
        for (int t = 0; t < nt; t += 2) {
            const bool last = (t == nt - 2);
            const char* a1 = cA + (size_t)(t + 1) * kstep;
            const char* a2 = last ? nA : cA + (size_t)(t + 2) * kstep; const char* b2 = last ? nB : cB + (size_t)(t + 2) * kstep;
            const char* a3 = a2 + kstep; const char* b3 = b2 + kstep;
            if (last && has_next) S.a_ready(nxt);
            if constexpr (SP2) {
            PG8_LDB(B0, 0, 0); PG8_LDB(B1, 0, 1); PG8_SCHED; PG8_LDA(At, 0, 0); PG8_STAGE(PG8_SA(1, 1), a1 + hstep, voffA);
            PG8_WAIT_V(8); PG8_WAIT_L(0); PG8_BAR; PG8_MMA(0, 0, At, B0); PG8_MMA(0, 1, At, B1); PG8_BAR; PG8_SCHED;
            PG8_LDA(At, 0, 1); PG8_STAGE(PG8_SB(0, 0), b2, voffB); PG8_STAGE(PG8_SB(0, 1), b2 + hstep, voffB); PG8_STAGE(PG8_SA(0, 0), a2, voffA);
            PG8_WAIT_V(8); PG8_WAIT_L(0); PG8_BAR; PG8_MMA(1, 0, At, B0); PG8_MMA(1, 1, At, B1); PG8_BAR; PG8_SCHED;
            PG8_LDB(B0, 1, 0); PG8_LDB(B1, 1, 1); PG8_SCHED; PG8_LDA(At, 1, 0); PG8_STAGE(PG8_SA(0, 1), a2 + hstep, voffA);
            PG8_WAIT_V(8); PG8_WAIT_L(0); PG8_BAR; PG8_MMA(0, 0, At, B0); PG8_MMA(0, 1, At, B1); PG8_BAR; PG8_SCHED;
            PG8_LDA(At, 1, 1); PG8_STAGE(PG8_SB(1, 0), b3, voffB); PG8_STAGE(PG8_SB(1, 1), b3 + hstep, voffB); PG8_STAGE(PG8_SA(1, 0), a3, voffA);
            PG8_WAIT_V(8); PG8_WAIT_L(0); PG8_BAR; PG8_MMA(1, 0, At, B0); PG8_MMA(1, 1, At, B1); PG8_BAR; PG8_SCHED;
            } else {
            PG8_LDB(B0, 0, 0); PG8_SCHED; PG8_LDA(At, 0, 0); PG8_STAGE(PG8_SA(1, 1), a1 + hstep, voffA);
            PG8_WAIT_L(8); PG8_BAR; PG8_WAIT_L(0); PG8_MMA(0, 0, At, B0); PG8_BAR; PG8_SCHED;
            PG8_LDB(B1, 0, 1); PG8_STAGE(PG8_SB(0, 0), b2, voffB);
            PG8_BAR; PG8_WAIT_L(0); PG8_MMA(0, 1, At, B1); PG8_BAR;
            PG8_LDA(At, 0, 1); PG8_STAGE(PG8_SA(0, 0), a2, voffA);
            PG8_BAR; PG8_WAIT_L(0); PG8_MMA(1, 0, At, B0); PG8_BAR; PG8_SCHED;
            PG8_STAGE(PG8_SB(0, 1), b2 + hstep, voffB);
            PG8_WAIT_V(6); PG8_BAR; PG8_MMA(1, 1, At, B1); PG8_BAR;
            PG8_LDB(B0, 1, 0); PG8_SCHED; PG8_LDA(At, 1, 0); PG8_STAGE(PG8_SA(0, 1), a2 + hstep, voffA);
            PG8_WAIT_L(8); PG8_BAR; PG8_WAIT_L(0); PG8_MMA(0, 0, At, B0); PG8_BAR; PG8_SCHED;
            PG8_LDB(B1, 1, 1); PG8_STAGE(PG8_SB(1, 0), b3, voffB);
            PG8_BAR; PG8_WAIT_L(0); PG8_MMA(0, 1, At, B1); PG8_BAR;
            PG8_LDA(At, 1, 1); PG8_STAGE(PG8_SA(1, 0), a3, voffA);
            PG8_BAR; PG8_WAIT_L(0); PG8_MMA(1, 0, At, B0); PG8_BAR; PG8_SCHED;
            PG8_STAGE(PG8_SB(1, 1), b3 + hstep, voffB);
            PG8_WAIT_V(6); PG8_BAR; PG8_MMA(1, 1, At, B1); PG8_BAR;
            }
        }
        if constexpr (ALIGN_EPI) { if (wr == 0) PG8_BAR; }
        if constexpr (!Epi::AFTER_DRAIN) { E(acc, cur, wr, wc, fr, fq); S.done(cur); }
        if (!has_next) break;
#pragma unroll
        for (int a = 0; a < 2; ++a)
#pragma unroll
            for (int b = 0; b < 2; ++b)
#pragma unroll
                for (int m = 0; m < 4; ++m)
#pragma unroll
                    for (int n = 0; n < 2; ++n) acc[a][b][m][n] = (f32x4){0.f, 0.f, 0.f, 0.f};
        cur = nxt; cA = nA; cB = nB; ++ui;
        if constexpr (ALIGN_EPI) { if (wr == 1) PG8_BAR; }
    }
    PG8_WAIT_V(0);
    if constexpr (!ALIGN_EPI) { if (wr == 0) PG8_BAR; }
    PG8_BAR;
    if constexpr (Epi::AFTER_DRAIN) { E.fused(acc, cur, wr, wc, fr, fq, lds, wid, lane); S.done(cur); }
#undef PG8_SA
#undef PG8_SB
#undef PG8_STAGE
#undef PG8_LDA
#undef PG8_LDB
#undef PG8_MMA
#undef PG8_WAIT_V
#undef PG8_WAIT_L
#undef PG8_BAR
#undef PG8_SCHED
}
}

#ifndef PG8_SP2
#define PG8_SP2 true
#endif
#ifndef PG8_ALIGN
#define PG8_ALIGN true
#endif
#ifndef MK_ONE_LAUNCH
#define MK_ONE_LAUNCH 1
#endif

constexpr int NWAVES = 8, NTHR = NWAVES * 64;
constexpr int NB = 2, S = 16384, D = 2048, M = NB * S, NLAYER = 2;
constexpr int NPROJ = 5632, NIN = 5412;
constexpr int DFF = 5632, NUP = 2 * DFF;
constexpr int MH = S;
constexpr int C_MQ = 0, C_MK = 512, C_MV = 1024, C_NQ = 1536, C_NKV = 2048, C_FQ = 2816, C_FK = 3584, C_FV = 4352, C_EQ = 5120, C_GATE = 5376, C_FF = 5400;
constexpr float LN_EPS = 1e-5f;
constexpr float ALPHA = 1.41421356237309515f;
constexpr float LOG2E = 1.4426950408889634f;
constexpr float C2 = 0.125f * LOG2E;
constexpr int NCMP = 1023, NCMP_PAD = 1024;

constexpr size_t MiB = 1u << 20;
constexpr size_t WS_CTL = 0, CTL_ZERO_BYTES = 1 * MiB;
constexpr size_t WS_WIN = 1 * MiB, WS_WOUT = 45 * MiB, WS_WUP = 61 * MiB, WS_WDN = 149 * MiB;
constexpr size_t WS_HB = 193 * MiB;
constexpr size_t WS_R = 321 * MiB;
constexpr size_t WS_PROJ = WS_R, WS_O = WS_R + 352 * MiB, WS_UG = WS_R, WS_ACT = WS_R + 352 * MiB;
constexpr size_t WS_KCMP = 849 * MiB;
constexpr size_t WS_MEMKV = 851 * MiB;
constexpr size_t WS_KMEAN = 853 * MiB;
constexpr size_t WS_FOXC = 854 * MiB;
constexpr size_t WS_END = 860 * MiB;
constexpr int CW_TMO = 0, CW_CODE = 1, CW_BAR = 4096, CW_Q = 8192;

constexpr int RING_OFF = 0, RING_BYTES = 131072;
constexpr int LDSCTL_OFF = RING_BYTES, MISC_OFF = LDSCTL_OFF + 320;
constexpr int SEL_OFF = RING_BYTES + 1024;
constexpr int LDS_BYTES = 147456;

#define GAS __attribute__((address_space(1)))
#define LAS __attribute__((address_space(3)))
typedef unsigned short bf16;
typedef unsigned v4u __attribute__((ext_vector_type(4)));
typedef float f32x4 __attribute__((ext_vector_type(4)));
typedef GAS unsigned gu32;
#define RLX_AGENT __ATOMIC_RELAXED, __HIP_MEMORY_SCOPE_AGENT
#define LDS_WAIT() asm volatile("s_waitcnt lgkmcnt(0)" ::: "memory")
__device__ __forceinline__ unsigned f2bf(float f) { unsigned u = __builtin_bit_cast(unsigned, f); return (u + 0x7fffu + ((u >> 16) & 1u)) >> 16; }
__device__ __forceinline__ unsigned pk2(float lo, float hi) { return f2bf(lo) | (f2bf(hi) << 16); }
__device__ __forceinline__ float blo(unsigned u) { return __uint_as_float(u << 16); }
__device__ __forceinline__ float bhi(unsigned u) { return __uint_as_float(u & 0xffff0000u); }
__device__ __forceinline__ float bf2f(bf16 v) { return __uint_as_float((unsigned)v << 16); }
__device__ __forceinline__ float ex2(float x) { return __builtin_amdgcn_exp2f(x); }
__device__ __forceinline__ float gelu_tanh(float x) {
    const float y = 0.7978845608028654f * (x + 0.044715f * x * x * x);
    const float e = __expf(2.0f * y);
    const float th = 1.0f - 2.0f / (e + 1.0f);
    return 0.5f * x * (1.0f + th);
}
#define XB_TMO      128
#define XB_XCNT(j)  (256  + 64 * (j))
#define XB_XSUB(j)  (1280 + 64 * (j))
#define XB_XGEN(j)  (2304 + 64 * (j))
#define XB_TOP      3328
#define XB_TOPGEN   3392
#define XCD_BAR_WORDS 3456
#define XB_SPIN_CAP (1u << 18)

__device__ __forceinline__ unsigned xb_ld(unsigned* p)              { return __hip_atomic_load(p, __ATOMIC_RELAXED, __HIP_MEMORY_SCOPE_AGENT); }
__device__ __forceinline__ unsigned xb_add(unsigned* p, unsigned v) { return __hip_atomic_fetch_add(p, v, __ATOMIC_RELAXED, __HIP_MEMORY_SCOPE_AGENT); }
__device__ __forceinline__ unsigned xb_xcc_id() { return (unsigned)__builtin_amdgcn_s_getreg((3 << 11) | 20) & 0xFu; }
#define XB_SPIN(cond, bar) do { unsigned _sp = 0; while (cond) { __builtin_amdgcn_s_sleep(1); \
    if ((++_sp & 255u) == 0u) { if (xb_ld(&(bar)[XB_TMO])) break; if (_sp > XB_SPIN_CAP) { atomicAdd(&(bar)[XB_TMO], 1u); break; } } } } while (0)

struct XcdBarrier {
    unsigned* bar; unsigned x;
    volatile LAS unsigned* st;
};

__device__ __forceinline__ XcdBarrier xcd_barrier_post(unsigned* bar, volatile LAS unsigned* st) {
    XcdBarrier b; b.bar = bar; b.x = xb_xcc_id(); b.st = st;
    if (threadIdx.x == 0) (void)xb_add(&bar[XB_XCNT(b.x)], 1u);
    return b;
}
__device__ __forceinline__ void xcd_barrier_complete(unsigned* bar, unsigned x, unsigned& nloc, unsigned& nx) {
    const unsigned G = gridDim.x * gridDim.y * gridDim.z;
    unsigned sum, cnt, mine, sp = 0u;
    for (;;) {
        sum = 0u; cnt = 0u; mine = 0u;
#pragma unroll
        for (unsigned j = 0; j < 16; ++j) { const unsigned c = xb_ld(&bar[XB_XCNT(j)]); sum += c; cnt += (c > 0u) ? 1u : 0u; mine = (j == x) ? c : mine; }
        if (sum == G) break;
        __builtin_amdgcn_s_sleep(1);
        if ((++sp & 255u) == 0u) { if (xb_ld(&bar[XB_TMO])) break; if (sp > XB_SPIN_CAP) { atomicAdd(&bar[XB_TMO], 1u); break; } }
    }
    nloc = mine > 0u ? mine : 1u; nx = cnt > 0u ? cnt : 1u;
}

__device__ __forceinline__ void xcd_barrier(const XcdBarrier& b) {
    asm volatile("s_waitcnt vmcnt(0)" ::: "memory");
    __syncthreads();
    if (threadIdx.x == 0) {
        unsigned* bar = b.bar;
        __builtin_amdgcn_s_waitcnt(0);
        unsigned nloc = b.st[0], nx = b.st[1];
        if (nloc == 0u) { xcd_barrier_complete(bar, b.x, nloc, nx); b.st[0] = nloc; b.st[1] = nx; }
        const unsigned old = xb_add(&bar[XB_XSUB(b.x)], 1u);
        const unsigned gen = old / nloc;
        if (old + 1u == (gen + 1u) * nloc) {
            __builtin_amdgcn_fence(__ATOMIC_RELEASE, "agent");
            asm volatile("s_waitcnt vmcnt(0)" ::: "memory");
            const unsigned og = xb_add(&bar[XB_TOP], 1u);
            const unsigned tg = og / nx;
            if (og + 1u == (tg + 1u) * nx) xb_add(&bar[XB_TOPGEN], 1u);
            else XB_SPIN(xb_ld(&bar[XB_TOPGEN]) == tg, bar);
            __builtin_amdgcn_fence(__ATOMIC_ACQUIRE, "agent");
            xb_add(&bar[XB_XGEN(b.x)], 1u);
            asm volatile("s_waitcnt vmcnt(0)" ::: "memory");
        } else {
            XB_SPIN(xb_ld(&bar[XB_XGEN(b.x)]) == gen, bar);
            __builtin_amdgcn_fence(__ATOMIC_ACQUIRE, "agent");
            asm volatile("s_waitcnt vmcnt(0)" ::: "memory");
        }
    }
    __syncthreads();
}

struct Args { const float* in[19]; float* out; unsigned char* ws; int ph_lo, ph_hi; };
struct Frame {
    LAS unsigned char* lds;
    volatile LAS unsigned* MISC;
    gu32* ctl;
    int G;
    const Args* A;
};
#define PHASE_IDS int tid_ = threadIdx.x; asm volatile("" : "+v"(tid_)); const int tid = tid_, lane = tid & 63, wave = __builtin_amdgcn_readfirstlane(tid >> 6); (void)lane; (void)wave; unsigned char* ws_ = F.A->ws; asm volatile("" : "+s"(ws_))
#define F_IN(i) (F.A->in[i])
#define F_HR (F.A->out)
#define F_WIN ((bf16*)(ws_ + WS_WIN))
#define F_WOUT ((bf16*)(ws_ + WS_WOUT))
#define F_WUP ((bf16*)(ws_ + WS_WUP))
#define F_WDN ((bf16*)(ws_ + WS_WDN))
#define F_HB ((bf16*)(ws_ + WS_HB))
#define F_PROJ ((bf16*)(ws_ + WS_PROJ))
#define F_O ((bf16*)(ws_ + WS_O))
#define F_UG ((bf16*)(ws_ + WS_UG))
#define F_ACT ((bf16*)(ws_ + WS_ACT))
#define F_KCMP ((float*)(ws_ + WS_KCMP))
#define F_MEMKV ((float*)(ws_ + WS_MEMKV))
#define F_KMEAN ((float*)(ws_ + WS_KMEAN))
#define F_FOXC ((double*)(ws_ + WS_FOXC))
__device__ __forceinline__ float wave_sum(float v) {
#pragma unroll
    for (int o = 1; o < 64; o <<= 1) v += __shfl_xor(v, o);
    return v;
}
__device__ __forceinline__ void p0_transpose_item(const float* W, int K, int N, bf16* WT, LAS float* scr, int item, int lane) {
    const int nblk = N / 32, kb = item / nblk, nb = item % nblk, k0 = 64 * kb, n0 = 32 * nb;
#pragma unroll 8
    for (int i = 0; i < 32; ++i) { const int kk = 2 * i + (lane >> 5); scr[kk * 33 + (lane & 31)] = W[(size_t)(k0 + kk) * N + n0 + (lane & 31)]; }
    LDS_WAIT(); asm volatile("" ::: "memory");
    const int c = lane & 7;
#pragma unroll
    for (int j = 0; j < 4; ++j) { const int n = (lane >> 3) + 8 * j; const LAS float* s = scr + (8 * c) * 33 + n;
        v4u o; o.x = pk2(s[0 * 33], s[1 * 33]); o.y = pk2(s[2 * 33], s[3 * 33]); o.z = pk2(s[4 * 33], s[5 * 33]); o.w = pk2(s[6 * 33], s[7 * 33]);
        *(GAS v4u*)(WT + (size_t)(n0 + n) * K + k0 + 8 * c) = o; }
    LDS_WAIT(); asm volatile("" ::: "memory");
}
__device__ __forceinline__ int in_src(int n) { return n < 2816 ? n : n < 5120 ? n + 24 : n < 5376 ? n + 36 : n < 5400 ? n - 5376 + 2816 : n < 5412 ? n - 5400 + 5144 : -1; }
__device__ __forceinline__ float in_scale(int n) { return (n < 512 || (n >= 1536 && n < 2048) || (n >= 2816 && n < 3584) || (n >= 5120 && n < 5376)) ? C2 : 1.0f; }
__device__ __forceinline__ void p0_transpose_in(const float* W, bf16* WT, LAS float* scr, int item, int lane) {
    constexpr int K = D, nblk = NPROJ / 32; const int kb = item / nblk, nb = item % nblk, k0 = 64 * kb, n0 = 32 * nb;
    const int sc = in_src(n0 + (lane & 31)); const float fs = in_scale(n0 + (lane & 31));
#pragma unroll 8
    for (int i = 0; i < 32; ++i) { const int kk = 2 * i + (lane >> 5); scr[kk * 33 + (lane & 31)] = sc >= 0 ? W[(size_t)(k0 + kk) * NIN + sc] * fs : 0.0f; }
    LDS_WAIT(); asm volatile("" ::: "memory");
    const int c = lane & 7;
#pragma unroll
    for (int j = 0; j < 4; ++j) { const int n = (lane >> 3) + 8 * j; const LAS float* s = scr + (8 * c) * 33 + n;
        v4u o; o.x = pk2(s[0 * 33], s[1 * 33]); o.y = pk2(s[2 * 33], s[3 * 33]); o.z = pk2(s[4 * 33], s[5 * 33]); o.w = pk2(s[6 * 33], s[7 * 33]);
        *(GAS v4u*)(WT + (size_t)(n0 + n) * K + k0 + 8 * c) = o; }
    LDS_WAIT(); asm volatile("" ::: "memory");
}
__device__ __forceinline__ void ln_row(const float* src, const float* g, const float* bt, float* dstf, bf16* dstb, int lane) {
    const f32x4* xr = (const f32x4*)src + lane;
    f32x4 v[8]; float s = 0.f;
#pragma unroll
    for (int j = 0; j < 8; ++j) { v[j] = xr[64 * j]; s += (v[j].x + v[j].y) + (v[j].z + v[j].w); }
    const float mean = wave_sum(s) * (1.f / D); float s2 = 0.f;
#pragma unroll
    for (int j = 0; j < 8; ++j) { v[j] = v[j] - mean; s2 += (v[j].x * v[j].x + v[j].y * v[j].y) + (v[j].z * v[j].z + v[j].w * v[j].w); }
    const float rstd = 1.f / sqrtf(wave_sum(s2) * (1.f / D) + LN_EPS);
    f32x4* of = (f32x4*)dstf + lane; uint2* ob = (uint2*)dstb + lane;
#pragma unroll
    for (int j = 0; j < 8; ++j) { const f32x4 gg = ((const f32x4*)g)[lane + 64 * j], bb = ((const f32x4*)bt)[lane + 64 * j]; const f32x4 y = v[j] * rstd * gg + bb;
        of[64 * j] = y; ob[64 * j] = make_uint2(pk2(y.x, y.y), pk2(y.z, y.w)); }
}
__device__ __forceinline__ void ln_phase(Frame& F, const float* src, const float* g, const float* bt) {
    PHASE_IDS;
    const int gw = blockIdx.x * NWAVES + wave, NGW = F.G * NWAVES;
    for (int m = gw; m < M; m += NGW) ln_row(src + (size_t)m * D, g, bt, F_HR + (size_t)m * D, F_HB + (size_t)m * D, lane);
}
__device__ __forceinline__ void p0_prologue(Frame& F) {
    PHASE_IDS;
    LAS float* scr = (LAS float*)(F.lds + RING_OFF + wave * 16384);
    const int gw = blockIdx.x * NWAVES + wave, NGW = F.G * NWAVES;
    constexpr int I_IN = (D / 64) * (NPROJ / 32), I_OUT = (D / 64) * (D / 32), I_UP = (D / 64) * (NUP / 32), I_DN = (DFF / 64) * (D / 32), I_L = I_IN + I_OUT + I_UP + I_DN;
    for (int it = gw; it < NLAYER * I_L; it += NGW) {
        const int l = it / I_L; int r = it % I_L;
        if (r < I_IN) { p0_transpose_in(F_IN(4) + (size_t)l * D * NIN, F_WIN + (size_t)l * NPROJ * D, scr, r, lane); continue; } r -= I_IN;
        if (r < I_OUT) { p0_transpose_item(F_IN(10) + (size_t)l * D * D, D, D, F_WOUT + (size_t)l * D * D, scr, r, lane); continue; } r -= I_OUT;
        if (r < I_UP) { p0_transpose_item(F_IN(13) + (size_t)l * D * NUP, D, NUP, F_WUP + (size_t)l * NUP * D, scr, r, lane); continue; } r -= I_UP;
        p0_transpose_item(F_IN(16) + (size_t)l * DFF * D, DFF, D, F_WDN + (size_t)l * D * DFF, scr, r, lane);
    }
    ln_phase(F, F_IN(0), F_IN(2), F_IN(3));
    for (int o = blockIdx.x * NTHR + tid; o < NLAYER * 512 * 512; o += F.G * NTHR) {
        const int c = o & 511, r = (o >> 9) & 511, l = o >> 18;
        const float* mr = F_IN(1) + (size_t)r * D; const float* w = F_IN(6) + (size_t)l * D * 512 + c; float a = 0.f;
        for (int k = 0; k < D; ++k) a += mr[k] * w[(size_t)k * 512];
        F_MEMKV[o] = a;
    }
}

__device__ __forceinline__ void load_q64(unsigned (&q)[32], const bf16* p) {
    const uint4* p4 = (const uint4*)p;
#pragma unroll
    for (int c = 0; c < 8; ++c) { const uint4 w = p4[c]; q[4 * c] = w.x; q[4 * c + 1] = w.y; q[4 * c + 2] = w.z; q[4 * c + 3] = w.w; }
}
__device__ __forceinline__ float dot64(const unsigned (&q)[32], const bf16* kp) {
    const uint4* p = (const uint4*)kp; float s0 = 0.f, s1 = 0.f;
#pragma unroll
    for (int c = 0; c < 8; ++c) { const uint4 w = p[c];
        s0 += blo(q[4 * c]) * blo(w.x) + blo(q[4 * c + 1]) * blo(w.y) + blo(q[4 * c + 2]) * blo(w.z) + blo(q[4 * c + 3]) * blo(w.w);
        s1 += bhi(q[4 * c]) * bhi(w.x) + bhi(q[4 * c + 1]) * bhi(w.y) + bhi(q[4 * c + 2]) * bhi(w.z) + bhi(q[4 * c + 3]) * bhi(w.w); if ((c & 3) == 3) asm volatile("" ::: "memory"); }
    return s0 + s1;
}
__device__ __forceinline__ float dot64f(const unsigned (&q)[32], const float* kp) {
    const f32x4* p = (const f32x4*)kp; float s0 = 0.f, s1 = 0.f;
#pragma unroll
    for (int c = 0; c < 16; ++c) { const f32x4 w = p[c]; s0 += blo(q[2 * c]) * w.x + blo(q[2 * c + 1]) * w.z; s1 += bhi(q[2 * c]) * w.y + bhi(q[2 * c + 1]) * w.w; if ((c & 3) == 3) asm volatile("" ::: "memory"); }
    return s0 + s1;
}
__device__ __forceinline__ void axpy64(float (&o)[64], float f, float p, const bf16* vp) {
    const uint4* p4 = (const uint4*)vp;
#pragma unroll
    for (int c = 0; c < 8; ++c) { const uint4 w = p4[c];
        o[8 * c] = o[8 * c] * f + p * blo(w.x); o[8 * c + 1] = o[8 * c + 1] * f + p * bhi(w.x); o[8 * c + 2] = o[8 * c + 2] * f + p * blo(w.y); o[8 * c + 3] = o[8 * c + 3] * f + p * bhi(w.y);
        o[8 * c + 4] = o[8 * c + 4] * f + p * blo(w.z); o[8 * c + 5] = o[8 * c + 5] * f + p * bhi(w.z); o[8 * c + 6] = o[8 * c + 6] * f + p * blo(w.w); o[8 * c + 7] = o[8 * c + 7] * f + p * bhi(w.w); if ((c & 3) == 3) asm volatile("" ::: "memory"); }
}
__device__ __forceinline__ void axpy64f(float (&o)[64], float f, float p, const float* vp) {
    const f32x4* p4 = (const f32x4*)vp;
#pragma unroll
    for (int c = 0; c < 16; ++c) { const f32x4 w = p4[c]; o[4 * c] = o[4 * c] * f + p * w.x; o[4 * c + 1] = o[4 * c + 1] * f + p * w.y; o[4 * c + 2] = o[4 * c + 2] * f + p * w.z; o[4 * c + 3] = o[4 * c + 3] * f + p * w.w; if ((c & 3) == 3) asm volatile("" ::: "memory"); }
}
#define KEY_STEP(sv, vptr) do { const float mn_ = fmaxf(m, (sv)); const float f_ = ex2(m - mn_), p_ = ex2((sv) - mn_); l = l * f_ + p_; axpy64(o, f_, p_, (vptr)); m = mn_; } while (0)
#define KEY_STEPF(sv, vptr) do { const float mn_ = fmaxf(m, (sv)); const float f_ = ex2(m - mn_), p_ = ex2((sv) - mn_); l = l * f_ + p_; axpy64f(o, f_, p_, (vptr)); m = mn_; } while (0)
__device__ __forceinline__ void store_o64(bf16* op, const float (&o)[64], float sc) {
    uint4* p4 = (uint4*)op;
#pragma unroll
    for (int c = 0; c < 8; ++c) { uint4 w; w.x = pk2(o[8 * c] * sc, o[8 * c + 1] * sc); w.y = pk2(o[8 * c + 2] * sc, o[8 * c + 3] * sc); w.z = pk2(o[8 * c + 4] * sc, o[8 * c + 5] * sc); w.w = pk2(o[8 * c + 6] * sc, o[8 * c + 7] * sc); p4[c] = w; }
}
#define UNI(x) __builtin_amdgcn_readfirstlane(x)

__device__ __forceinline__ void fox_item_naive(Frame& F, int b, int h, int qblk) {
    PHASE_IDS;
    const int t = qblk * 512 + tid; const size_t row = (size_t)b * S + t;
    unsigned q[32]; load_q64(q, F_PROJ + row * NPROJ + C_FQ + h * 64);
    const double* cc = F_FOXC + (size_t)(b * 12 + h) * S; const double ci = cc[t];
    float m = -INFINITY, l = 0.f; float o[64];
#pragma unroll
    for (int d = 0; d < 64; ++d) o[d] = 0.f;
    const int jmax = UNI(qblk * 512 + wave * 64 + 63);
    const bf16* kb = F_PROJ + (size_t)b * S * NPROJ + C_FK + h * 64; const bf16* vb = F_PROJ + (size_t)b * S * NPROJ + C_FV + h * 64;
    for (int j = 0; j <= jmax; ++j) {
        const float bias = (float)(ci - cc[j]);
        if (j <= t) { const float s = dot64(q, kb + (size_t)j * NPROJ) + bias; KEY_STEP(s, vb + (size_t)j * NPROJ); }
    }
    store_o64(F_O + row * D + (16 + h) * 64, o, 1.0f / l);
}
__device__ __forceinline__ void mem_item_naive(Frame& F, int layer, int b, int h, int qblk) {
    PHASE_IDS;
    const int t = qblk * 512 + tid; const size_t row = (size_t)b * S + t;
    unsigned q[32]; load_q64(q, F_PROJ + row * NPROJ + C_EQ + h * 64);
    float m = -INFINITY, l = 0.f; float o[64];
#pragma unroll
    for (int d = 0; d < 64; ++d) o[d] = 0.f;
    const float* kv = F_MEMKV + (size_t)layer * 512 * 512 + (size_t)b * 256 * 512;
    for (int j = 0; j < 256; ++j) { const float s = dot64f(q, kv + (size_t)j * 512 + h * 64); KEY_STEPF(s, kv + (size_t)j * 512 + 256 + h * 64); }
    store_o64(F_O + row * D + (28 + h) * 64, o, 1.0f / l);
}
__device__ __forceinline__ void moba_item_naive(Frame& F, int b, int h, int qblk) {
    PHASE_IDS;
    const int t = qblk * 512 + tid; const size_t row = (size_t)b * S + t;
    unsigned q[32]; load_q64(q, F_PROJ + row * NPROJ + C_MQ + h * 64);
    const int own = UNI((qblk * 512 + wave * 64) >> 8);
    float g0 = -INFINITY, g1 = -INFINITY, g2 = -INFINITY; int i0 = -1, i1 = -1, i2 = -1;
    const float* km = F_KMEAN + (size_t)(b * 8 + h) * 64 * 64;
    for (int j = 0; j < own; ++j) {
        const float g = dot64f(q, km + j * 64);
        if (g > g0) { g2 = g1; i2 = i1; g1 = g0; i1 = i0; g0 = g; i0 = j; }
        else if (g > g1) { g2 = g1; i2 = i1; g1 = g; i1 = j; }
        else if (g > g2) { g2 = g; i2 = j; }
    }
    const float slope = exp2f(-(float)(h + 1)) * LOG2E;
    float m = -INFINITY, l = 0.f; float o[64];
#pragma unroll
    for (int d = 0; d < 64; ++d) o[d] = 0.f;
    const bf16* kb = F_PROJ + (size_t)b * S * NPROJ + C_MK + h * 64; const bf16* vb = F_PROJ + (size_t)b * S * NPROJ + C_MV + h * 64;
    const int jmax = UNI(qblk * 512 + wave * 64 + 63);
    for (int j = own * 256; j <= jmax; ++j) {
        if (j <= t) { const float s = dot64(q, kb + (size_t)j * NPROJ) - slope * (float)(t - j); KEY_STEP(s, vb + (size_t)j * NPROJ); }
    }
#pragma unroll
    for (int n = 0; n < 3; ++n) {
        const int sb = n == 0 ? i0 : n == 1 ? i1 : i2;
        for (int off = 0; off < 256; ++off) {
            if (sb >= 0) { const int j = sb * 256 + off; const float s = dot64(q, kb + (size_t)j * NPROJ) - slope * (float)(t - j); KEY_STEP(s, vb + (size_t)j * NPROJ); }
        }
    }
    store_o64(F_O + row * D + h * 64, o, 1.0f / l);
}
__device__ __forceinline__ void nsa_item_naive(Frame& F, int b, int g, int qblk) {
    PHASE_IDS;
    const int ql = tid >> 2, hh = tid & 3, h = g * 4 + hh; const int t = qblk * 128 + ql; const size_t row = (size_t)b * S + t;
    LAS float* imp = (LAS float*)(F.lds + RING_OFF) + ql * 256;
    LAS int* selL = (LAS int*)(F.lds + SEL_OFF) + ql * 16;
    LAS float* stash = (LAS float*)(F.lds + RING_OFF) + tid * 64;
    for (int i = tid; i < 128 * 256; i += NTHR) ((LAS float*)(F.lds + RING_OFF))[i] = 0.f;
    __syncthreads();
    unsigned q[32]; load_q64(q, F_PROJ + row * NPROJ + C_NQ + h * 64);
    const float slope = exp2f(-(float)(h + 1)) * LOG2E;
    const float* kc = F_KCMP + (size_t)((0 * 2 + b) * 2 + g) * NCMP_PAD * 64; const float* vc = F_KCMP + (size_t)((1 * 2 + b) * 2 + g) * NCMP_PAD * 64;
    const int tmax = UNI(qblk * 128 + wave * 16 + 15);
    const int ncw = tmax >= 31 ? ((tmax - 31) >> 4) + 1 : 0;
    float m = -INFINITY, l = 0.f;
    for (int n = 0; n < ncw; ++n) {
        const int ce = 16 * n + 31;
        if (ce <= t) { const float s = dot64f(q, kc + n * 64) - slope * (float)(t - ce); const float mn = fmaxf(m, s); l = l * ex2(m - mn) + ex2(s - mn); m = mn; }
    }
    float o[64];
#pragma unroll
    for (int d = 0; d < 64; ++d) o[d] = 0.f;
    const float rl = l > 0.f ? 1.0f / l : 0.f;
    for (int n = 0; n < ncw; ++n) {
        const int ce = 16 * n + 31; float p = 0.f;
        if (ce <= t) { const float s = dot64f(q, kc + n * 64) - slope * (float)(t - ce); p = ex2(s - m) * rl; axpy64f(o, 1.0f, p, vc + n * 64); }
        float p4 = p + __shfl_xor(p, 1); p4 = p4 + __shfl_xor(p4, 2);
        if (hh == 0) { imp[n >> 2] += p4; if ((n & 3) == 3) imp[(n >> 2) + 1] += p4; }
    }
    __syncthreads();
    const int jt = t >> 6;
    if (hh == 0) { imp[0] = 1.0e4f; imp[jt] = 1.0e4f; if (jt >= 1) imp[jt - 1] = 1.0e4f; }
    __syncthreads();
    int nsel = 0;
    for (int i = 0; i < 16; ++i) {
        float best = -1.0f; int bi = -1;
        for (int k = 0; k <= jt; ++k) { const float v = imp[k]; if (v > best) { best = v; bi = k; } }
        if (bi < 0) break;
        __builtin_amdgcn_wave_barrier();
        imp[bi] = -2.0f; selL[i] = bi; nsel = i + 1;
        __builtin_amdgcn_wave_barrier();
    }
    __syncthreads();
    const bf16* gp = F_PROJ + row * NPROJ + C_GATE + h * 3;
    const float ga = 1.0f / (1.0f + __expf(-bf2f(gp[0]))), gb = 1.0f / (1.0f + __expf(-bf2f(gp[1]))), gc = 1.0f / (1.0f + __expf(-bf2f(gp[2])));
#pragma unroll
    for (int d = 0; d < 64; ++d) stash[d] = ga * o[d];
    const bf16* pb = F_PROJ + (size_t)b * S * NPROJ;
    m = -INFINITY; l = 0.f;
#pragma unroll
    for (int d = 0; d < 64; ++d) o[d] = 0.f;
    for (int i = 0; i < 16; ++i) {
        const int blk = i < nsel ? selL[i] : -1;
        for (int off = 0; off < 64; ++off) {
            const int j = blk * 64 + off;
            if (blk >= 0 && j <= t) { const float s = dot64(q, pb + (size_t)j * NPROJ + C_NKV + 2 * 128 + g * 64) - slope * (float)(t - j); KEY_STEP(s, pb + (size_t)j * NPROJ + C_NKV + 3 * 128 + g * 64); }
        }
    }
    { const float sc = l > 0.f ? gb / l : 0.f;
#pragma unroll
      for (int d = 0; d < 64; ++d) stash[d] += sc * o[d]; }
    m = -INFINITY; l = 0.f;
#pragma unroll
    for (int d = 0; d < 64; ++d) o[d] = 0.f;
    const int tmin = UNI(qblk * 128 + wave * 16);
    for (int j = (tmin - 511 > 0 ? tmin - 511 : 0); j <= tmax; ++j) {
        if (j <= t && t - j < 512) { const float s = dot64(q, pb + (size_t)j * NPROJ + C_NKV + 4 * 128 + g * 64) - slope * (float)(t - j); KEY_STEP(s, pb + (size_t)j * NPROJ + C_NKV + 5 * 128 + g * 64); }
    }
    { const float sc = l > 0.f ? gc / l : 0.f;
#pragma unroll
      for (int d = 0; d < 64; ++d) o[d] = stash[d] + sc * o[d]; }
    store_o64(F_O + row * D + (8 + h) * 64, o, 1.0f);
    __syncthreads();
}
__device__ __forceinline__ void cmp_item_naive(Frame& F, int layer, int item) {
    PHASE_IDS;
    const int chunk = item & 127, g = (item >> 7) & 1, b = (item >> 8) & 1, kv = item >> 9; const int n0 = chunk * 8;
    LAS float* X = (LAS float*)(F.lds + RING_OFF);
    LAS float* H = X + 144 * 64;
    const bf16* src = F_PROJ + (size_t)b * S * NPROJ + C_NKV + kv * 128 + g * 64;
    for (int i = tid; i < 144 * 64; i += NTHR) { const int p = 16 * n0 + (i >> 6); X[i] = p < S ? bf2f(src[(size_t)p * NPROJ + (i & 63)]) : 0.f; }
    __syncthreads();
    const int e = tid & 127, sub = tid >> 7;
    const float* w1 = F_IN(8) + (size_t)(layer * 2 + kv) * 32 * 64 * 128; const float* pe = F_IN(7) + (size_t)(layer * 2 + kv) * 32 * 64;
    float a0 = 0.f, a1 = 0.f;
    for (int ld = 0; ld < 2048; ++ld) { const float w = w1[(size_t)ld * 128 + e]; const float pv = pe[ld]; a0 += (X[(2 * sub) * 16 * 64 + ld] + pv) * w; a1 += (X[(2 * sub + 1) * 16 * 64 + ld] + pv) * w; }
    H[(2 * sub) * 128 + e] = gelu_tanh(a0); H[(2 * sub + 1) * 128 + e] = gelu_tanh(a1);
    __syncthreads();
    const int tok = tid >> 6, dd = tid & 63; const float* w2 = F_IN(9) + (size_t)(layer * 2 + kv) * 128 * 64; float a = 0.f;
    for (int k = 0; k < 128; ++k) a += H[tok * 128 + k] * w2[k * 64 + dd];
    if (n0 + tok < NCMP) F_KCMP[((size_t)((kv * 2 + b) * 2 + g) * NCMP_PAD + n0 + tok) * 64 + dd] = a;
    __syncthreads();
}
__device__ __forceinline__ void prep_phase(Frame& F, int layer) {
    PHASE_IDS;
    if (blockIdx.x < 24) {
        const int b = blockIdx.x / 12, h = blockIdx.x % 12; const float bf = F_IN(5)[layer * 12 + h];
        LAS double* part = (LAS double*)(F.lds + RING_OFF);
        const bf16* src = F_PROJ + (size_t)b * S * NPROJ + C_FF + h; float lf[32]; double s = 0.0;
#pragma unroll
        for (int i = 0; i < 32; ++i) { const float x = bf2f(src[(size_t)(tid * 32 + i) * NPROJ]) + bf; lf[i] = (fminf(x, 0.f) - log1pf(__expf(-fabsf(x)))) * LOG2E; s += (double)lf[i]; }
        part[tid] = s; __syncthreads();
        double pre = 0.0; for (int k = 0; k < tid; ++k) pre += part[k];
        double* dst = F_FOXC + (size_t)(b * 12 + h) * S + tid * 32;
#pragma unroll
        for (int i = 0; i < 32; ++i) { pre += (double)lf[i]; dst[i] = pre; }
        __syncthreads();
    }
    for (int it = blockIdx.x; it < 1024; it += F.G) cmp_item_naive(F, layer, it);
    for (int o = blockIdx.x * NTHR + tid; o < 2 * 8 * 64 * 64; o += F.G * NTHR) {
        const int d = o & 63, j = (o >> 6) & 63, h = (o >> 12) & 7, b = o >> 15;
        const bf16* src = F_PROJ + ((size_t)b * S + j * 256) * NPROJ + C_MK + h * 64 + d; float a = 0.f;
        for (int p = 0; p < 256; ++p) a += bf2f(src[(size_t)p * NPROJ]);
        F_KMEAN[o] = a * (1.0f / 256.0f);
    }
}
__device__ __forceinline__ void attn_phase_naive(Frame& F, int layer) {
    PHASE_IDS;
    constexpr int N_FOX = 2 * 12 * 32, N_NSA = 2 * 2 * 128, N_MOBA = 2 * 8 * 32, N_MEM = 2 * 4 * 32, N_ALL = N_FOX + N_NSA + N_MOBA + N_MEM;
    for (;;) {
        if (tid == 0) F.MISC[0] = __hip_atomic_fetch_add(F.ctl + CW_Q + 64 * layer, 1u, RLX_AGENT);
        __syncthreads();
        int it = (int)F.MISC[0];
        __syncthreads();
        if (it >= N_ALL) break;
        if (it < N_FOX) { const int qblk = 31 - it / 24, bh = it % 24; fox_item_naive(F, bh / 12, bh % 12, qblk); continue; } it -= N_FOX;
        if (it < N_NSA) { const int qblk = 127 - it / 4, bg = it % 4; nsa_item_naive(F, bg >> 1, bg & 1, qblk); continue; } it -= N_NSA;
        if (it < N_MOBA) { const int qblk = 31 - it / 16, bh = it % 16; moba_item_naive(F, bh >> 3, bh & 7, qblk); continue; } it -= N_MOBA;
        { const int qblk = it / 8, bh = it % 8; mem_item_naive(F, layer, bh >> 2, bh & 3, qblk); }
    }
}
__device__ __forceinline__ void act_phase(Frame& F, int layer) {
    PHASE_IDS;
    const float* cw = F_IN(14) + (size_t)layer * 3 * DFF; const float* cb = F_IN(15) + (size_t)layer * DFF;
    constexpr int CG = DFF / 8;
    for (size_t i = (size_t)blockIdx.x * NTHR + tid; i < (size_t)MH * CG; i += (size_t)F.G * NTHR) {
        const int cg = (int)(i % CG), t = (int)(i / CG), c0 = cg * 8;
        const bf16* ur = F_UG + (size_t)t * NUP + c0; const bf16* gr = ur + DFF;
        const uint4 uu = *(const uint4*)ur, g2 = *(const uint4*)gr;
        uint4 g1 = make_uint4(0, 0, 0, 0), g0 = make_uint4(0, 0, 0, 0);
        if (t >= 1) g1 = *(const uint4*)(gr - NUP);
        if (t >= 2) g0 = *(const uint4*)(gr - 2 * NUP);
        const unsigned ua[4] = {uu.x, uu.y, uu.z, uu.w}, a2[4] = {g2.x, g2.y, g2.z, g2.w}, a1[4] = {g1.x, g1.y, g1.z, g1.w}, a0[4] = {g0.x, g0.y, g0.z, g0.w};
        unsigned r[4];
#pragma unroll
        for (int k = 0; k < 4; ++k) {
            const int c = c0 + 2 * k;
            const float x0 = cb[c] + cw[c] * blo(a0[k]) + cw[DFF + c] * blo(a1[k]) + cw[2 * DFF + c] * blo(a2[k]);
            const float x1 = cb[c + 1] + cw[c + 1] * bhi(a0[k]) + cw[DFF + c + 1] * bhi(a1[k]) + cw[2 * DFF + c + 1] * bhi(a2[k]);
            r[k] = pk2(gelu_tanh(x0) * blo(ua[k]), gelu_tanh(x1) * bhi(ua[k]));
        }
        *(uint4*)(F_ACT + (size_t)t * DFF + c0) = make_uint4(r[0], r[1], r[2], r[3]);
    }
}

__device__ __forceinline__ bool in_range(int lo, int hi, int k) { asm volatile("" : "+s"(lo), "+s"(hi), "+s"(k)); return lo <= k && k < hi; }
constexpr int N_STEPS = 1 + NLAYER * 12;
template <int PH> __device__ __forceinline__ void run_phase(Frame& F, const Args& args, int l, int half) {
    unsigned char* ws_ = args.ws; asm volatile("" : "+s"(ws_));
    if constexpr (PH == 0) { p0_prologue(F); }
    if constexpr (PH == 1) {
        pg8::Gemm g{F_HB, F_WIN + (size_t)l * NPROJ * D, M, NPROJ, D}; pg8::StaticOrder So; So.init(M, NPROJ, F.G, (int)blockIdx.x);
        pg8::EpiBf16<0> E{F_PROJ, NPROJ, nullptr, 0, 0, 1.f};
        pg8::gemm_phase<pg8::EpiBf16<0>, pg8::StaticOrder, PG8_ALIGN, PG8_SP2>(F.lds + RING_OFF, g, So, E);
    }
    if constexpr (PH == 2) { prep_phase(F, l); }
    if constexpr (PH == 3) { attn_phase_naive(F, l); }
    if constexpr (PH == 4) {
        pg8::Gemm g{F_O, F_WOUT + (size_t)l * D * D, M, D, D}; pg8::StaticOrder So; So.init(M, D, F.G, (int)blockIdx.x);
        pg8::EpiResF32 E{F_HR, D, ALPHA};
        pg8::gemm_phase<pg8::EpiResF32, pg8::StaticOrder, PG8_ALIGN, PG8_SP2>(F.lds + RING_OFF, g, So, E);
    }
    if constexpr (PH == 5) { ln_phase(F, F_HR, F_IN(11) + (size_t)l * D, F_IN(12) + (size_t)l * D); }
    if constexpr (PH == 6) {
        pg8::Gemm g{F_HB + (size_t)half * MH * D, F_WUP + (size_t)l * NUP * D, MH, NUP, D}; pg8::StaticOrder So; So.init(MH, NUP, F.G, (int)blockIdx.x);
        pg8::EpiBf16<0> E{F_UG, NUP, nullptr, 0, 0, 1.f};
        pg8::gemm_phase<pg8::EpiBf16<0>, pg8::StaticOrder, PG8_ALIGN, PG8_SP2>(F.lds + RING_OFF, g, So, E);
    }
    if constexpr (PH == 7) { act_phase(F, l); }
    if constexpr (PH == 8) {
        pg8::Gemm g{F_ACT, F_WDN + (size_t)l * D * DFF, MH, D, DFF}; pg8::StaticOrder So; So.init(MH, D, F.G, (int)blockIdx.x);
        pg8::EpiResF32 E{F_HR + (size_t)half * MH * D, D, ALPHA};
        pg8::gemm_phase<pg8::EpiResF32, pg8::StaticOrder, PG8_ALIGN, PG8_SP2>(F.lds + RING_OFF, g, So, E);
    }
    if constexpr (PH == 9) { ln_phase(F, F_HR, F_IN(17) + (size_t)l * D, F_IN(18) + (size_t)l * D); }
}
template <int PH> __global__ void __launch_bounds__(NTHR, 2) k_phase(Args args, int l, int half) {
    extern __shared__ __attribute__((aligned(16))) unsigned char lds[];
    Frame F;
    F.lds = (LAS unsigned char*)lds;
    F.MISC = (volatile LAS unsigned*)(F.lds + MISC_OFF);
    F.G = gridDim.x;
    F.A = &args;
    F.ctl = (gu32*)(args.ws + WS_CTL);
    for (int u = threadIdx.x; u < (LDS_BYTES - LDSCTL_OFF) / 4; u += NTHR) ((LAS unsigned*)(F.lds + LDSCTL_OFF))[u] = 0u;
    __syncthreads();
    run_phase<PH>(F, args, l, half);
}

__global__ void __launch_bounds__(NTHR, 2) hybrid_fwd(Args args) {
    extern __shared__ __attribute__((aligned(16))) unsigned char lds[];
    Frame F;
    F.lds = (LAS unsigned char*)lds;
    F.MISC = (volatile LAS unsigned*)(F.lds + MISC_OFF);
    F.G = gridDim.x;
    F.A = &args;
    F.ctl = (gu32*)(args.ws + WS_CTL);
    for (int u = threadIdx.x; u < (LDS_BYTES - LDSCTL_OFF) / 4; u += NTHR) ((LAS unsigned*)(F.lds + LDSCTL_OFF))[u] = 0u;
    __syncthreads();
    XcdBarrier bar = xcd_barrier_post((unsigned*)(F.ctl + CW_BAR), F.MISC + 8);
#define PHASE(PH, l, h) do { run_phase<PH>(F, args, (l), (h)); xcd_barrier(bar); } while (0)
#define LAYER(l) do { PHASE(1, l, 0); PHASE(2, l, 0); PHASE(3, l, 0); PHASE(4, l, 0); PHASE(5, l, 0); \
        PHASE(6, l, 0); PHASE(7, l, 0); PHASE(8, l, 0); PHASE(6, l, 1); PHASE(7, l, 1); PHASE(8, l, 1); } while (0)
    PHASE(0, 0, 0);
    LAYER(0); PHASE(9, 0, 0);
    LAYER(1); run_phase<9>(F, args, 1, 0);
#undef PHASE
#undef LAYER
}

template <int PH> static bool set_lds_one() { return hipFuncSetAttribute((const void*)k_phase<PH>, hipFuncAttributeMaxDynamicSharedMemorySize, LDS_BYTES) == hipSuccess; }
static bool set_lds_all() { return hipFuncSetAttribute((const void*)hybrid_fwd, hipFuncAttributeMaxDynamicSharedMemorySize, LDS_BYTES) == hipSuccess && set_lds_one<0>() && set_lds_one<1>() && set_lds_one<2>() && set_lds_one<3>() && set_lds_one<4>() && set_lds_one<5>() && set_lds_one<6>() && set_lds_one<7>() && set_lds_one<8>() && set_lds_one<9>(); }
extern "C" void kernel_launch(void* const* d_in, const int* in_sizes, int n_in, void* d_out, int out_size, void* d_ws, size_t ws_size, hipStream_t stream) {
    static int grid = 0;
    if (grid == 0) {
        if (n_in != 19 || in_sizes[0] != M * D || out_size != M * D || ws_size < WS_END) { fprintf(stderr, "kernel_launch: unexpected shapes (n_in %d, in0 %d, out %d, ws %zu)\n", n_in, n_in > 0 ? in_sizes[0] : -1, out_size, ws_size); grid = -1; return; }
        int dev = 0, cus = 0;
        if (hipGetDevice(&dev) != hipSuccess || hipDeviceGetAttribute(&cus, hipDeviceAttributeMultiprocessorCount, dev) != hipSuccess) { grid = -1; return; }
        if (!set_lds_all()) { fprintf(stderr, "kernel_launch: hipFuncSetAttribute failed\n"); grid = -1; return; }
        (void)hipGetLastError();
        grid = cus;
    }
    if (grid < 0) return;
    if (hipMemsetAsync((char*)d_ws + WS_CTL, 0, CTL_ZERO_BYTES, stream) != hipSuccess) return;
    Args a{};
    for (int i = 0; i < 19; ++i) a.in[i] = (const float*)d_in[i];
    a.out = (float*)d_out; a.ws = (unsigned char*)d_ws;
#if MK_ONE_LAUNCH
    hipLaunchKernelGGL(hybrid_fwd, dim3(grid), dim3(NTHR), LDS_BYTES, stream, a);
#else
#define LAUNCH(PH, l, h) hipLaunchKernelGGL(k_phase<PH>, dim3(grid), dim3(NTHR), LDS_BYTES, stream, a, (int)(l), (int)(h))
    LAUNCH(0, 0, 0);
    for (int l = 0; l < NLAYER; ++l) {
        LAUNCH(1, l, 0); LAUNCH(2, l, 0); LAUNCH(3, l, 0); LAUNCH(4, l, 0); LAUNCH(5, l, 0);
        for (int h = 0; h < 2; ++h) { LAUNCH(6, l, h); LAUNCH(7, l, h); LAUNCH(8, l, h); }
        LAUNCH(9, l, 0);
    }
#undef LAUNCH
#endif
}
```

```cpp
#include <hip/hip_runtime.h>
#include <cstdio>
#include <cstdint>
namespace pg8 {
#define PG8_LAS __attribute__((address_space(3)))
typedef unsigned short bf16_t;
typedef short bf16x8 __attribute__((ext_vector_type(8)));
typedef float f32x4 __attribute__((ext_vector_type(4)));
typedef unsigned u32x4 __attribute__((ext_vector_type(4)));
constexpr int BM = 256, BK = 64, HALF = 128, HTB = HALF * BK * 2  , STAGE_BYTES = 8 * HTB, NXCD = 8, WGM = 8;

__host__ __device__ __forceinline__ int lds_byte(int r, int c) { const int st = (r >> 4) * 2 + (c >> 5), rr = r & 15, cc = c & 31, ob = rr * 64 + cc * 2; return st * 1024 + (ob ^ (((ob >> 9) & 1) << 5)); }
__host__ __device__ __forceinline__ void stage_rc(int b, int& R, int& C) { const int st = b / 1024, sb = b % 1024, swz = sb ^ (((sb >> 9) & 1) << 5); R = (st >> 1) * 16 + swz / 64; C = (st & 1) * 32 + (swz % 64) / 2; }
__host__ __device__ __forceinline__ int perm32(int rho) { const int n = rho >> 4, i = rho & 15; return 8 * (i >> 2) + 4 * n + (i & 3); }

struct Unit { int pm, pn; };
struct Gemm { const bf16_t* A; const bf16_t* Bt; int M, N, K; };

struct StaticOrder {
    int nM, nN, nwg, G, c;
    __host__ __device__ void init(int M, int N, int G_, int c_) { nM = M / BM; nN = N / BM; nwg = nM * nN; G = G_; c = c_; }
    __host__ __device__ bool next(int i, Unit& u) const {
        const long L = (long)i * G + c; if (L >= nwg) return false;
        int wgid = (int)L; { const int q = nwg / NXCD, r = nwg % NXCD, xcd = wgid % NXCD, off = wgid / NXCD; wgid = (xcd < r ? xcd * (q + 1) : r * (q + 1) + (xcd - r) * q) + off; }
        const int nig = WGM * nN, gid = wgid / nig, fm = gid * WGM, gsz = (nM - fm) < WGM ? (nM - fm) : WGM;
        u.pm = fm + ((wgid % nig) % gsz); u.pn = (wgid % nig) / gsz; return true;
    }
    __device__ __forceinline__ void a_ready(const Unit&) const {}
    __device__ __forceinline__ void done(const Unit&) const {}
};

__device__ __forceinline__ unsigned cvt_pk_bf16(float lo, float hi) { unsigned r; asm volatile("v_cvt_pk_bf16_f32 %0, %1, %2" : "=v"(r) : "v"(lo), "v"(hi)); return r; }
typedef float f32x2 __attribute__((ext_vector_type(2)));
__device__ __forceinline__ f32x2 gelu_pk(f32x2 v) {
    const f32x2 av = __builtin_elementwise_abs(v), d = av * 0.2316418882f + 1.0f;
    f32x2 t; t.x = __builtin_amdgcn_rcpf(d.x); t.y = __builtin_amdgcn_rcpf(d.y);
    f32x2 q = t * 0.5307027145f + (-0.7265760135f); q = q * t + 0.7107068705f; q = q * t + (-0.142248368f); q = q * t + 0.127414796f; q = q * t;
    const f32x2 s = (v * v) * (-0.72134752044f);
    f32x2 e; e.x = __builtin_amdgcn_exp2f(s.x); e.y = __builtin_amdgcn_exp2f(s.y);
    const f32x2 m = v * (q * e), r = v - m;
    f32x2 o; o.x = v.x < 0.f ? m.x : r.x; o.y = v.y < 0.f ? m.y : r.y; return o;
}

template <int ACT  > struct EpiBf16 {
    static constexpr bool PERM = true, AFTER_DRAIN = false; static_assert(ACT == 0 || ACT == 1, "EpiBf16: ACT is 0 (none) or 1 (gelu_pk)");
    bf16_t* O; int ldc; const float* bias; int split_cols; size_t split_stride; float scale0;
    __device__ __forceinline__ void operator()(const f32x4 (&acc)[2][2][4][2], const Unit& u, int wr, int wc, int fr, int fq) const {
        const int row0 = u.pm * BM + wr * 64 + fr; int colt = u.pn * BM; bf16_t* base = O;
        float sc = 1.f; if (split_cols) { const int t = colt / split_cols; base += (size_t)t * split_stride; colt -= t * split_cols; if (t == 0) sc = scale0; }
        const int col0 = colt + wc * 32 + 8 * fq, bcol0 = u.pn * BM + wc * 32 + 8 * fq;
        f32x4 bv[2][2];
#pragma unroll
        for (int bj = 0; bj < 2; ++bj)
#pragma unroll
            for (int n = 0; n < 2; ++n) bv[bj][n] = bias ? *(const f32x4*)(bias + bcol0 + bj * HALF + 4 * n) : (f32x4){0.f, 0.f, 0.f, 0.f};
#pragma unroll
        for (int ai = 0; ai < 2; ++ai)
#pragma unroll
            for (int m = 0; m < 4; ++m) { bf16_t* rowp = base + (size_t)(row0 + ai * HALF + m * 16) * ldc + col0;
#pragma unroll
                for (int bj = 0; bj < 2; ++bj) { f32x4 v0 = acc[ai][bj][m][0] + bv[bj][0], v1 = acc[ai][bj][m][1] + bv[bj][1];
                    if (ACT == 1) { f32x2 a = gelu_pk((f32x2){v0[0], v0[1]}), b = gelu_pk((f32x2){v0[2], v0[3]}), c = gelu_pk((f32x2){v1[0], v1[1]}), d = gelu_pk((f32x2){v1[2], v1[3]});
                        v0 = (f32x4){a.x, a.y, b.x, b.y}; v1 = (f32x4){c.x, c.y, d.x, d.y}; }
                    v0 = v0 * sc; v1 = v1 * sc; u32x4 w; w.x = cvt_pk_bf16(v0[0], v0[1]); w.y = cvt_pk_bf16(v0[2], v0[3]); w.z = cvt_pk_bf16(v1[0], v1[1]); w.w = cvt_pk_bf16(v1[2], v1[3]);
                    *(u32x4*)(rowp + bj * HALF) = w; } }
    }
};


struct EpiResF32 {
    static constexpr bool PERM = false, AFTER_DRAIN = false;
    float* out; int ldc; float alpha;
    __device__ __forceinline__ void operator()(const f32x4 (&acc)[2][2][4][2], const Unit& u, int wr, int wc, int fr, int fq) const {
        const int col0 = u.pn * BM + wc * 32 + 4 * fq;
#pragma unroll
        for (int ai = 0; ai < 2; ++ai)
#pragma unroll
            for (int m = 0; m < 4; ++m) { float* rowp = out + (size_t)(u.pm * BM + ai * HALF + wr * 64 + m * 16 + fr) * ldc + col0;
#pragma unroll
                for (int bj = 0; bj < 2; ++bj)
#pragma unroll
                    for (int n = 0; n < 2; ++n) { f32x4* p = (f32x4*)(rowp + bj * HALF + n * 16); const f32x4 b = *p; *p = b * alpha + acc[ai][bj][m][n]; }
                asm volatile("" ::: "memory"); }
    }
};
template <class Epi, class Sched, bool ALIGN_EPI = false, bool SP2 = false>
__device__ __forceinline__ void gemm_phase(PG8_LAS unsigned char* lds, const Gemm g, const Sched& S, const Epi& E) {
    int tid_ = threadIdx.x; asm volatile("" : "+v"(tid_));
    const int tid = tid_, wid = __builtin_amdgcn_readfirstlane(tid >> 6), lane = tid & 63, wr = wid >> 2, wc = wid & 3, fr = lane & 15, fq = lane >> 4;
    const int K = g.K, nt = K / BK;
    unsigned voffA[2], voffB[2];
#pragma unroll
    for (int i = 0; i < 2; ++i) { int R, C; stage_rc(tid * 16 + i * 8192, R, C); const int Rb = Epi::PERM ? ((R & ~31) + perm32(R & 31)) : R;
        voffA[i] = (unsigned)(R * K + C) * 2u; voffB[i] = (unsigned)(Rb * K + C) * 2u; }
    const size_t kstep = (size_t)(BK * 2);
    const size_t hstep = (size_t)HALF * K * 2;
    const size_t tstep = 2 * hstep;
    const unsigned ldsw = (unsigned)wid * 1024u;
    const int aoff = lds_byte(wr * 64 + fr, fq * 8), boff = lds_byte(wc * 32 + fr, fq * 8);
#define PG8_SA(b, h) (((b) * 2 + (h)) * HTB)
#define PG8_SB(b, h) ((4 + (b) * 2 + (h)) * HTB)
#define PG8_STAGE(bufoff, gbase, voff) do { _Pragma("unroll") for (int _i = 0; _i < 2; ++_i) \
        __builtin_amdgcn_global_load_lds((const unsigned*)((const char*)(gbase) + (voff)[_i]), (PG8_LAS unsigned*)(lds + (bufoff) + ldsw + _i * 8192), 16, 0, 0); } while (0)
#define PG8_LDA(dst, b, h) do { _Pragma("unroll") for (int m = 0; m < 4; ++m) _Pragma("unroll") for (int k = 0; k < 2; ++k) dst[m][k] = *(const PG8_LAS bf16x8*)(lds + PG8_SA(b, h) + aoff + m * 2048 + k * 1024); } while (0)
#define PG8_LDB(dst, b, h) do { _Pragma("unroll") for (int n = 0; n < 2; ++n) _Pragma("unroll") for (int k = 0; k < 2; ++k) dst[n][k] = *(const PG8_LAS bf16x8*)(lds + PG8_SB(b, h) + boff + n * 2048 + k * 1024); } while (0)
#define PG8_MMA(ai, bj, At, Bt) do { __builtin_amdgcn_s_setprio(1); _Pragma("unroll") for (int m = 0; m < 4; ++m) _Pragma("unroll") for (int n = 0; n < 2; ++n) _Pragma("unroll") for (int k = 0; k < 2; ++k) \
        acc[ai][bj][m][n] = __builtin_amdgcn_mfma_f32_16x16x32_bf16(Bt[n][k], At[m][k], acc[ai][bj][m][n], 0, 0, 0); __builtin_amdgcn_s_setprio(0); } while (0)
#define PG8_WAIT_V(n) asm volatile("s_waitcnt vmcnt(" #n ")" ::: "memory")
#define PG8_WAIT_L(n) asm volatile("s_waitcnt lgkmcnt(" #n ")" ::: "memory")
#define PG8_BAR __builtin_amdgcn_s_barrier()
#define PG8_SCHED __builtin_amdgcn_sched_barrier(0)
    Unit cur, nxt; int ui = 0;
    if (!S.next(0, cur)) return;
    f32x4 acc[2][2][4][2];
#pragma unroll
    for (int a = 0; a < 2; ++a)
#pragma unroll
        for (int b = 0; b < 2; ++b)
#pragma unroll
            for (int m = 0; m < 4; ++m)
#pragma unroll
                for (int n = 0; n < 2; ++n) acc[a][b][m][n] = (f32x4){0.f, 0.f, 0.f, 0.f};
    bf16x8 At[4][2], B0[2][2], B1[2][2];
    const char* cA = (const char*)g.A + (size_t)cur.pm * tstep; const char* cB = (const char*)g.Bt + (size_t)cur.pn * tstep;
    S.a_ready(cur);
    if constexpr (SP2) {
        PG8_STAGE(PG8_SB(0, 0), cB, voffB); PG8_STAGE(PG8_SB(0, 1), cB + hstep, voffB); PG8_STAGE(PG8_SA(0, 0), cA, voffA); PG8_STAGE(PG8_SA(0, 1), cA + hstep, voffA);
        if (wr == 1) PG8_BAR;
        PG8_WAIT_V(2); PG8_BAR;
        PG8_STAGE(PG8_SB(1, 0), cB + kstep, voffB); PG8_STAGE(PG8_SA(1, 0), cA + kstep, voffA); PG8_STAGE(PG8_SB(1, 1), cB + hstep + kstep, voffB);
        PG8_WAIT_V(6); PG8_BAR;
    } else {
        PG8_STAGE(PG8_SB(0, 0), cB, voffB); PG8_STAGE(PG8_SA(0, 0), cA, voffA); PG8_STAGE(PG8_SB(0, 1), cB + hstep, voffB); PG8_STAGE(PG8_SA(0, 1), cA + hstep, voffA);
        if (wr == 1) PG8_BAR;
        PG8_WAIT_V(4); PG8_BAR;
        PG8_STAGE(PG8_SB(1, 0), cB + kstep, voffB); PG8_STAGE(PG8_SA(1, 0), cA + kstep, voffA); PG8_STAGE(PG8_SB(1, 1), cB + hstep + kstep, voffB);
        PG8_WAIT_V(6); PG8_BAR;
    }
    for (;;) {
        const bool has_next = S.next(ui + 1, nxt);
        const char* nA = has_next ? (const char*)g.A + (size_t)nxt.pm * tstep : cA; const char* nB = has_next ? (const char*)g.Bt + (size_t)nxt.pn * tstep : cB;
        for (int t = 0; t < nt; t += 2) {
            const bool last = (t == nt - 2);
            const char* a1 = cA + (size_t)(t + 1) * kstep;
            const char* a2 = last ? nA : cA + (size_t)(t + 2) * kstep; const char* b2 = last ? nB : cB + (size_t)(t + 2) * kstep;
            const char* a3 = a2 + kstep; const char* b3 = b2 + kstep;
            if (last && has_next) S.a_ready(nxt);
            if constexpr (SP2) {
            PG8_LDB(B0, 0, 0); PG8_LDB(B1, 0, 1); PG8_SCHED; PG8_LDA(At, 0, 0); PG8_STAGE(PG8_SA(1, 1), a1 + hstep, voffA);
            PG8_WAIT_V(8); PG8_WAIT_L(0); PG8_BAR; PG8_MMA(0, 0, At, B0); PG8_MMA(0, 1, At, B1); PG8_BAR; PG8_SCHED;
            PG8_LDA(At, 0, 1); PG8_STAGE(PG8_SB(0, 0), b2, voffB); PG8_STAGE(PG8_SB(0, 1), b2 + hstep, voffB); PG8_STAGE(PG8_SA(0, 0), a2, voffA);
            PG8_WAIT_V(8); PG8_WAIT_L(0); PG8_BAR; PG8_MMA(1, 0, At, B0); PG8_MMA(1, 1, At, B1); PG8_BAR; PG8_SCHED;
            PG8_LDB(B0, 1, 0); PG8_LDB(B1, 1, 1); PG8_SCHED; PG8_LDA(At, 1, 0); PG8_STAGE(PG8_SA(0, 1), a2 + hstep, voffA);
            PG8_WAIT_V(8); PG8_WAIT_L(0); PG8_BAR; PG8_MMA(0, 0, At, B0); PG8_MMA(0, 1, At, B1); PG8_BAR; PG8_SCHED;
            PG8_LDA(At, 1, 1); PG8_STAGE(PG8_SB(1, 0), b3, voffB); PG8_STAGE(PG8_SB(1, 1), b3 + hstep, voffB); PG8_STAGE(PG8_SA(1, 0), a3, voffA);
            PG8_WAIT_V(8); PG8_WAIT_L(0); PG8_BAR; PG8_MMA(1, 0, At, B0); PG8_MMA(1, 1, At, B1); PG8_BAR; PG8_SCHED;
            } else {
            PG8_LDB(B0, 0, 0); PG8_SCHED; PG8_LDA(At, 0, 0); PG8_STAGE(PG8_SA(1, 1), a1 + hstep, voffA);
            PG8_WAIT_L(8); PG8_BAR; PG8_WAIT_L(0); PG8_MMA(0, 0, At, B0); PG8_BAR; PG8_SCHED;
            PG8_LDB(B1, 0, 1); PG8_STAGE(PG8_SB(0, 0), b2, voffB);
            PG8_BAR; PG8_WAIT_L(0); PG8_MMA(0, 1, At, B1); PG8_BAR;
            PG8_LDA(At, 0, 1); PG8_STAGE(PG8_SA(0, 0), a2, voffA);
            PG8_BAR; PG8_WAIT_L(0); PG8_MMA(1, 0, At, B0); PG8_BAR; PG8_SCHED;
            PG8_STAGE(PG8_SB(0, 1), b2 + hstep, voffB);
            PG8_WAIT_V(6); PG8_BAR; PG8_MMA(1, 1, At, B1); PG8_BAR;
            PG8_LDB(B0, 1, 0); PG8_SCHED; PG8_LDA(At, 1, 0); PG8_STAGE(PG8_SA(0, 1), a2 + hstep, voffA);
            PG8_WAIT_L(8); PG8_BAR; PG8_WAIT_L(0); PG8_MMA(0, 0, At, B0); PG8_BAR; PG8_SCHED;
            PG8_LDB(B1, 1, 1); PG8_STAGE(PG8_SB(1, 0), b3, voffB);
            PG8_BAR; PG8_WAIT_L(0); PG8_MMA(0, 1, At, B1); PG8_BAR;
            PG8_LDA(At, 1, 1); PG8_STAGE(PG8_SA(1, 0), a3, voffA);
            PG8_BAR; PG8_WAIT_L(0); PG8_MMA(1, 0, At, B0); PG8_BAR; PG8_SCHED;
            PG8_STAGE(PG8_SB(1, 1), b3 + hstep, voffB);
            PG8_WAIT_V(6); PG8_BAR; PG8_MMA(1, 1, At, B1); PG8_BAR;
            }
        }
        if constexpr (ALIGN_EPI) { if (wr == 0) PG8_BAR; }
        if constexpr (!Epi::AFTER_DRAIN) { E(acc, cur, wr, wc, fr, fq); S.done(cur); }
        if (!has_next) break;
#pragma unroll
        for (int a = 0; a < 2; ++a)
#pragma unroll
            for (int b = 0; b < 2; ++b)
#pragma unroll
                for (int m = 0; m < 4; ++m)
#pragma unroll
                    for (int n = 0; n < 2; ++n) acc[a][b][m][n] = (f32x4){0.f, 0.f, 0.f, 0.f};
        cur = nxt; cA = nA; cB = nB; ++ui;
        if constexpr (ALIGN_EPI) { if (wr == 1) PG8_BAR; }
    }
    PG8_WAIT_V(0);
    if constexpr (!ALIGN_EPI) { if (wr == 0) PG8_BAR; }
    PG8_BAR;
    if constexpr (Epi::AFTER_DRAIN) { E.fused(acc, cur, wr, wc, fr, fq, lds, wid, lane); S.done(cur); }
#undef PG8_SA
#undef PG8_SB
#undef PG8_STAGE
#undef PG8_LDA
#undef PG8_LDB
#undef PG8_MMA
#undef PG8_WAIT_V
#undef PG8_WAIT_L
#undef PG8_BAR
#undef PG8_SCHED
}
}

#ifndef PG8_SP2
#define PG8_SP2 true
#endif
#ifndef PG8_ALIGN
#define PG8_ALIGN true
#endif
#ifndef MK_ONE_LAUNCH
#define MK_ONE_LAUNCH 1
#endif

constexpr int NWAVES = 8, NTHR = NWAVES * 64;
constexpr int NB = 2, S = 16384, D = 2048, M = NB * S, NLAYER = 2;
constexpr int NPROJ = 5632, NIN = 5412;
constexpr int DFF = 5632, NUP = 2 * DFF;
constexpr int MH = S;
constexpr int C_MQ = 0, C_MK = 512, C_MV = 1024, C_NQ = 1536, C_NKV = 2048, C_FQ = 2816, C_FK = 3584, C_FV = 4352, C_EQ = 5120, C_GATE = 5376, C_FF = 5400;
constexpr float LN_EPS = 1e-5f;
constexpr float ALPHA = 1.41421356237309515f;
constexpr float LOG2E = 1.4426950408889634f;
constexpr float C2 = 0.125f * LOG2E;
constexpr int NCMP = 1023, NCMP_PAD = 1024;

constexpr size_t MiB = 1u << 20;
constexpr size_t WS_CTL = 0, CTL_ZERO_BYTES = 1 * MiB;
constexpr size_t WS_WIN = 1 * MiB, WS_WOUT = 45 * MiB, WS_WUP = 61 * MiB, WS_WDN = 149 * MiB;
constexpr size_t WS_HB = 193 * MiB;
constexpr size_t WS_R = 321 * MiB;
constexpr size_t WS_PROJ = WS_R, WS_O = WS_R + 352 * MiB, WS_UG = WS_R, WS_ACT = WS_R + 352 * MiB;
constexpr size_t WS_KCMP = 849 * MiB;
constexpr size_t WS_MEMKV = 851 * MiB;
constexpr size_t WS_KMEAN = 853 * MiB;
constexpr size_t WS_FOXC = 854 * MiB;
constexpr size_t WS_MEMKVB = 857 * MiB;
constexpr size_t WS_KMEANB = 858 * MiB;
constexpr size_t WS_KCMPB = 859 * MiB;
constexpr size_t WS_END = 860 * MiB;
constexpr int CW_TMO = 0, CW_CODE = 1, CW_BAR = 4096, CW_Q = 8192;

constexpr int RING_OFF = 0, RING_BYTES = 131072;
constexpr int LDSCTL_OFF = 146432, MISC_OFF = LDSCTL_OFF + 320;
constexpr int SEL_OFF = RING_BYTES + 1024;
constexpr int LDS_BYTES = 147456;

#define GAS __attribute__((address_space(1)))
#define LAS __attribute__((address_space(3)))
typedef unsigned short bf16;
typedef unsigned v4u __attribute__((ext_vector_type(4)));
typedef float f32x4 __attribute__((ext_vector_type(4)));
typedef GAS unsigned gu32;
#define RLX_AGENT __ATOMIC_RELAXED, __HIP_MEMORY_SCOPE_AGENT
#define LDS_WAIT() asm volatile("s_waitcnt lgkmcnt(0)" ::: "memory")
__device__ __forceinline__ unsigned f2bf(float f) { unsigned u = __builtin_bit_cast(unsigned, f); return (u + 0x7fffu + ((u >> 16) & 1u)) >> 16; }
__device__ __forceinline__ unsigned pk2(float lo, float hi) { return f2bf(lo) | (f2bf(hi) << 16); }
__device__ __forceinline__ float blo(unsigned u) { return __uint_as_float(u << 16); }
__device__ __forceinline__ float bhi(unsigned u) { return __uint_as_float(u & 0xffff0000u); }
__device__ __forceinline__ float bf2f(bf16 v) { return __uint_as_float((unsigned)v << 16); }
__device__ __forceinline__ float ex2(float x) { return __builtin_amdgcn_exp2f(x); }
__device__ __forceinline__ float gelu_tanh(float x) {
    const float y = 0.7978845608028654f * (x + 0.044715f * x * x * x);
    const float e = __expf(2.0f * y);
    const float th = 1.0f - 2.0f / (e + 1.0f);
    return 0.5f * x * (1.0f + th);
}
#define XB_TMO      128
#define XB_XCNT(j)  (256  + 64 * (j))
#define XB_XSUB(j)  (1280 + 64 * (j))
#define XB_XGEN(j)  (2304 + 64 * (j))
#define XB_TOP      3328
#define XB_TOPGEN   3392
#define XCD_BAR_WORDS 3456
#define XB_SPIN_CAP (1u << 18)

__device__ __forceinline__ unsigned xb_ld(unsigned* p)              { return __hip_atomic_load(p, __ATOMIC_RELAXED, __HIP_MEMORY_SCOPE_AGENT); }
__device__ __forceinline__ unsigned xb_add(unsigned* p, unsigned v) { return __hip_atomic_fetch_add(p, v, __ATOMIC_RELAXED, __HIP_MEMORY_SCOPE_AGENT); }
__device__ __forceinline__ unsigned xb_xcc_id() { return (unsigned)__builtin_amdgcn_s_getreg((3 << 11) | 20) & 0xFu; }
#define XB_SPIN(cond, bar) do { unsigned _sp = 0; while (cond) { __builtin_amdgcn_s_sleep(1); \
    if ((++_sp & 255u) == 0u) { if (xb_ld(&(bar)[XB_TMO])) break; if (_sp > XB_SPIN_CAP) { atomicAdd(&(bar)[XB_TMO], 1u); break; } } } } while (0)

struct XcdBarrier {
    unsigned* bar; unsigned x;
    volatile LAS unsigned* st;
};

__device__ __forceinline__ XcdBarrier xcd_barrier_post(unsigned* bar, volatile LAS unsigned* st) {
    XcdBarrier b; b.bar = bar; b.x = xb_xcc_id(); b.st = st;
    if (threadIdx.x == 0) (void)xb_add(&bar[XB_XCNT(b.x)], 1u);
    return b;
}
__device__ __forceinline__ void xcd_barrier_complete(unsigned* bar, unsigned x, unsigned& nloc, unsigned& nx) {
    const unsigned G = gridDim.x * gridDim.y * gridDim.z;
    unsigned sum, cnt, mine, sp = 0u;
    for (;;) {
        sum = 0u; cnt = 0u; mine = 0u;
#pragma unroll
        for (unsigned j = 0; j < 16; ++j) { const unsigned c = xb_ld(&bar[XB_XCNT(j)]); sum += c; cnt += (c > 0u) ? 1u : 0u; mine = (j == x) ? c : mine; }
        if (sum == G) break;
        __builtin_amdgcn_s_sleep(1);
        if ((++sp & 255u) == 0u) { if (xb_ld(&bar[XB_TMO])) break; if (sp > XB_SPIN_CAP) { atomicAdd(&bar[XB_TMO], 1u); break; } }
    }
    nloc = mine > 0u ? mine : 1u; nx = cnt > 0u ? cnt : 1u;
}

__device__ __forceinline__ void xcd_barrier(const XcdBarrier& b) {
    asm volatile("s_waitcnt vmcnt(0)" ::: "memory");
    __syncthreads();
    if (threadIdx.x == 0) {
        unsigned* bar = b.bar;
        __builtin_amdgcn_s_waitcnt(0);
        unsigned nloc = b.st[0], nx = b.st[1];
        if (nloc == 0u) { xcd_barrier_complete(bar, b.x, nloc, nx); b.st[0] = nloc; b.st[1] = nx; }
        const unsigned old = xb_add(&bar[XB_XSUB(b.x)], 1u);
        const unsigned gen = old / nloc;
        if (old + 1u == (gen + 1u) * nloc) {
            __builtin_amdgcn_fence(__ATOMIC_RELEASE, "agent");
            asm volatile("s_waitcnt vmcnt(0)" ::: "memory");
            const unsigned og = xb_add(&bar[XB_TOP], 1u);
            const unsigned tg = og / nx;
            if (og + 1u == (tg + 1u) * nx) xb_add(&bar[XB_TOPGEN], 1u);
            else XB_SPIN(xb_ld(&bar[XB_TOPGEN]) == tg, bar);
            __builtin_amdgcn_fence(__ATOMIC_ACQUIRE, "agent");
            xb_add(&bar[XB_XGEN(b.x)], 1u);
            asm volatile("s_waitcnt vmcnt(0)" ::: "memory");
        } else {
            XB_SPIN(xb_ld(&bar[XB_XGEN(b.x)]) == gen, bar);
            __builtin_amdgcn_fence(__ATOMIC_ACQUIRE, "agent");
            asm volatile("s_waitcnt vmcnt(0)" ::: "memory");
        }
    }
    __syncthreads();
}

struct Args { const float* in[19]; float* out; unsigned char* ws; int ph_lo, ph_hi; };
struct Frame {
    LAS unsigned char* lds;
    volatile LAS unsigned* MISC;
    gu32* ctl;
    int G;
    const Args* A;
};
#define PHASE_IDS int tid_ = threadIdx.x; asm volatile("" : "+v"(tid_)); const int tid = tid_, lane = tid & 63, wave = __builtin_amdgcn_readfirstlane(tid >> 6); (void)lane; (void)wave; unsigned char* ws_ = F.A->ws; asm volatile("" : "+s"(ws_))
#define F_IN(i) (F.A->in[i])
#define F_HR (F.A->out)
#define F_WIN ((bf16*)(ws_ + WS_WIN))
#define F_WOUT ((bf16*)(ws_ + WS_WOUT))
#define F_WUP ((bf16*)(ws_ + WS_WUP))
#define F_WDN ((bf16*)(ws_ + WS_WDN))
#define F_HB ((bf16*)(ws_ + WS_HB))
#define F_PROJ ((bf16*)(ws_ + WS_PROJ))
#define F_O ((bf16*)(ws_ + WS_O))
#define F_UG ((bf16*)(ws_ + WS_UG))
#define F_ACT ((bf16*)(ws_ + WS_ACT))
#define F_KCMP ((float*)(ws_ + WS_KCMP))
#define F_MEMKV ((float*)(ws_ + WS_MEMKV))
#define F_KMEAN ((float*)(ws_ + WS_KMEAN))
#define F_FOXC ((double*)(ws_ + WS_FOXC))
#define F_MEMKVB ((bf16*)(ws_ + WS_MEMKVB))
#define F_KMEANB ((bf16*)(ws_ + WS_KMEANB))
#define F_KCMPB ((bf16*)(ws_ + WS_KCMPB))
__device__ __forceinline__ float wave_sum(float v) {
#pragma unroll
    for (int o = 1; o < 64; o <<= 1) v += __shfl_xor(v, o);
    return v;
}
__device__ __forceinline__ void p0_transpose_item(const float* W, int K, int N, bf16* WT, LAS float* scr, int item, int lane) {
    const int nblk = N / 32, kb = item / nblk, nb = item % nblk, k0 = 64 * kb, n0 = 32 * nb;
#pragma unroll 8
    for (int i = 0; i < 32; ++i) { const int kk = 2 * i + (lane >> 5); scr[kk * 33 + (lane & 31)] = W[(size_t)(k0 + kk) * N + n0 + (lane & 31)]; }
    LDS_WAIT(); asm volatile("" ::: "memory");
    const int c = lane & 7;
#pragma unroll
    for (int j = 0; j < 4; ++j) { const int n = (lane >> 3) + 8 * j; const LAS float* s = scr + (8 * c) * 33 + n;
        v4u o; o.x = pk2(s[0 * 33], s[1 * 33]); o.y = pk2(s[2 * 33], s[3 * 33]); o.z = pk2(s[4 * 33], s[5 * 33]); o.w = pk2(s[6 * 33], s[7 * 33]);
        *(GAS v4u*)(WT + (size_t)(n0 + n) * K + k0 + 8 * c) = o; }
    LDS_WAIT(); asm volatile("" ::: "memory");
}
__device__ __forceinline__ int in_src(int n) { return n < 2816 ? n : n < 5120 ? n + 24 : n < 5376 ? n + 36 : n < 5400 ? n - 5376 + 2816 : n < 5412 ? n - 5400 + 5144 : -1; }
__device__ __forceinline__ float in_scale(int n) { return (n < 512 || (n >= 1536 && n < 2048) || (n >= 2816 && n < 3584) || (n >= 5120 && n < 5376)) ? C2 : 1.0f; }
__device__ __forceinline__ void p0_transpose_in(const float* W, bf16* WT, LAS float* scr, int item, int lane) {
    constexpr int K = D, nblk = NPROJ / 32; const int kb = item / nblk, nb = item % nblk, k0 = 64 * kb, n0 = 32 * nb;
    const int sc = in_src(n0 + (lane & 31)); const float fs = in_scale(n0 + (lane & 31));
#pragma unroll 8
    for (int i = 0; i < 32; ++i) { const int kk = 2 * i + (lane >> 5); scr[kk * 33 + (lane & 31)] = sc >= 0 ? W[(size_t)(k0 + kk) * NIN + sc] * fs : 0.0f; }
    LDS_WAIT(); asm volatile("" ::: "memory");
    const int c = lane & 7;
#pragma unroll
    for (int j = 0; j < 4; ++j) { const int n = (lane >> 3) + 8 * j; const LAS float* s = scr + (8 * c) * 33 + n;
        v4u o; o.x = pk2(s[0 * 33], s[1 * 33]); o.y = pk2(s[2 * 33], s[3 * 33]); o.z = pk2(s[4 * 33], s[5 * 33]); o.w = pk2(s[6 * 33], s[7 * 33]);
        *(GAS v4u*)(WT + (size_t)(n0 + n) * K + k0 + 8 * c) = o; }
    LDS_WAIT(); asm volatile("" ::: "memory");
}
__device__ __forceinline__ void ln_row(const float* src, const float* g, const float* bt, float* dstf, bf16* dstb, int lane) {
    const f32x4* xr = (const f32x4*)src + lane;
    f32x4 v[8]; float s = 0.f;
#pragma unroll
    for (int j = 0; j < 8; ++j) { v[j] = xr[64 * j]; s += (v[j].x + v[j].y) + (v[j].z + v[j].w); }
    const float mean = wave_sum(s) * (1.f / D); float s2 = 0.f;
#pragma unroll
    for (int j = 0; j < 8; ++j) { v[j] = v[j] - mean; s2 += (v[j].x * v[j].x + v[j].y * v[j].y) + (v[j].z * v[j].z + v[j].w * v[j].w); }
    const float rstd = 1.f / sqrtf(wave_sum(s2) * (1.f / D) + LN_EPS);
    f32x4* of = (f32x4*)dstf + lane; uint2* ob = (uint2*)dstb + lane;
#pragma unroll
    for (int j = 0; j < 8; ++j) { const f32x4 gg = ((const f32x4*)g)[lane + 64 * j], bb = ((const f32x4*)bt)[lane + 64 * j]; const f32x4 y = v[j] * rstd * gg + bb;
        of[64 * j] = y; ob[64 * j] = make_uint2(pk2(y.x, y.y), pk2(y.z, y.w)); }
}
__device__ __forceinline__ void ln_phase(Frame& F, const float* src, const float* g, const float* bt) {
    PHASE_IDS;
    const int gw = blockIdx.x * NWAVES + wave, NGW = F.G * NWAVES;
    for (int m = gw; m < M; m += NGW) ln_row(src + (size_t)m * D, g, bt, F_HR + (size_t)m * D, F_HB + (size_t)m * D, lane);
}
__device__ __forceinline__ void p0_prologue(Frame& F) {
    PHASE_IDS;
    LAS float* scr = (LAS float*)(F.lds + RING_OFF + wave * 16384);
    const int gw = blockIdx.x * NWAVES + wave, NGW = F.G * NWAVES;
    constexpr int I_IN = (D / 64) * (NPROJ / 32), I_OUT = (D / 64) * (D / 32), I_UP = (D / 64) * (NUP / 32), I_DN = (DFF / 64) * (D / 32), I_L = I_IN + I_OUT + I_UP + I_DN;
    for (int it = gw; it < NLAYER * I_L; it += NGW) {
        const int l = it / I_L; int r = it % I_L;
        if (r < I_IN) { p0_transpose_in(F_IN(4) + (size_t)l * D * NIN, F_WIN + (size_t)l * NPROJ * D, scr, r, lane); continue; } r -= I_IN;
        if (r < I_OUT) { p0_transpose_item(F_IN(10) + (size_t)l * D * D, D, D, F_WOUT + (size_t)l * D * D, scr, r, lane); continue; } r -= I_OUT;
        if (r < I_UP) { p0_transpose_item(F_IN(13) + (size_t)l * D * NUP, D, NUP, F_WUP + (size_t)l * NUP * D, scr, r, lane); continue; } r -= I_UP;
        p0_transpose_item(F_IN(16) + (size_t)l * DFF * D, DFF, D, F_WDN + (size_t)l * D * DFF, scr, r, lane);
    }
    ln_phase(F, F_IN(0), F_IN(2), F_IN(3));
    for (int o = blockIdx.x * NTHR + tid; o < NLAYER * 512 * 512; o += F.G * NTHR) {
        const int c = o & 511, r = (o >> 9) & 511, l = o >> 18;
        const float* mr = F_IN(1) + (size_t)r * D; const float* w = F_IN(6) + (size_t)l * D * 512 + c; float a = 0.f;
        for (int k = 0; k < D; ++k) a += mr[k] * w[(size_t)k * 512];
        F_MEMKV[o] = a; F_MEMKVB[o] = (bf16)f2bf(a);
    }
}

__device__ __forceinline__ void load_q64(unsigned (&q)[32], const bf16* p) {
    const uint4* p4 = (const uint4*)p;
#pragma unroll
    for (int c = 0; c < 8; ++c) { const uint4 w = p4[c]; q[4 * c] = w.x; q[4 * c + 1] = w.y; q[4 * c + 2] = w.z; q[4 * c + 3] = w.w; }
}
__device__ __forceinline__ float dot64(const unsigned (&q)[32], const bf16* kp) {
    const uint4* p = (const uint4*)kp; float s0 = 0.f, s1 = 0.f;
#pragma unroll
    for (int c = 0; c < 8; ++c) { const uint4 w = p[c];
        s0 += blo(q[4 * c]) * blo(w.x) + blo(q[4 * c + 1]) * blo(w.y) + blo(q[4 * c + 2]) * blo(w.z) + blo(q[4 * c + 3]) * blo(w.w);
        s1 += bhi(q[4 * c]) * bhi(w.x) + bhi(q[4 * c + 1]) * bhi(w.y) + bhi(q[4 * c + 2]) * bhi(w.z) + bhi(q[4 * c + 3]) * bhi(w.w); if ((c & 3) == 3) asm volatile("" ::: "memory"); }
    return s0 + s1;
}
__device__ __forceinline__ float dot64f(const unsigned (&q)[32], const float* kp) {
    const f32x4* p = (const f32x4*)kp; float s0 = 0.f, s1 = 0.f;
#pragma unroll
    for (int c = 0; c < 16; ++c) { const f32x4 w = p[c]; s0 += blo(q[2 * c]) * w.x + blo(q[2 * c + 1]) * w.z; s1 += bhi(q[2 * c]) * w.y + bhi(q[2 * c + 1]) * w.w; if ((c & 3) == 3) asm volatile("" ::: "memory"); }
    return s0 + s1;
}
__device__ __forceinline__ void axpy64(float (&o)[64], float f, float p, const bf16* vp) {
    const uint4* p4 = (const uint4*)vp;
#pragma unroll
    for (int c = 0; c < 8; ++c) { const uint4 w = p4[c];
        o[8 * c] = o[8 * c] * f + p * blo(w.x); o[8 * c + 1] = o[8 * c + 1] * f + p * bhi(w.x); o[8 * c + 2] = o[8 * c + 2] * f + p * blo(w.y); o[8 * c + 3] = o[8 * c + 3] * f + p * bhi(w.y);
        o[8 * c + 4] = o[8 * c + 4] * f + p * blo(w.z); o[8 * c + 5] = o[8 * c + 5] * f + p * bhi(w.z); o[8 * c + 6] = o[8 * c + 6] * f + p * blo(w.w); o[8 * c + 7] = o[8 * c + 7] * f + p * bhi(w.w); if ((c & 3) == 3) asm volatile("" ::: "memory"); }
}
__device__ __forceinline__ void axpy64f(float (&o)[64], float f, float p, const float* vp) {
    const f32x4* p4 = (const f32x4*)vp;
#pragma unroll
    for (int c = 0; c < 16; ++c) { const f32x4 w = p4[c]; o[4 * c] = o[4 * c] * f + p * w.x; o[4 * c + 1] = o[4 * c + 1] * f + p * w.y; o[4 * c + 2] = o[4 * c + 2] * f + p * w.z; o[4 * c + 3] = o[4 * c + 3] * f + p * w.w; if ((c & 3) == 3) asm volatile("" ::: "memory"); }
}
#define KEY_STEP(sv, vptr) do { const float mn_ = fmaxf(m, (sv)); const float f_ = ex2(m - mn_), p_ = ex2((sv) - mn_); l = l * f_ + p_; axpy64(o, f_, p_, (vptr)); m = mn_; } while (0)
#define KEY_STEPF(sv, vptr) do { const float mn_ = fmaxf(m, (sv)); const float f_ = ex2(m - mn_), p_ = ex2((sv) - mn_); l = l * f_ + p_; axpy64f(o, f_, p_, (vptr)); m = mn_; } while (0)
__device__ __forceinline__ void store_o64(bf16* op, const float (&o)[64], float sc) {
    uint4* p4 = (uint4*)op;
#pragma unroll
    for (int c = 0; c < 8; ++c) { uint4 w; w.x = pk2(o[8 * c] * sc, o[8 * c + 1] * sc); w.y = pk2(o[8 * c + 2] * sc, o[8 * c + 3] * sc); w.z = pk2(o[8 * c + 4] * sc, o[8 * c + 5] * sc); w.w = pk2(o[8 * c + 6] * sc, o[8 * c + 7] * sc); p4[c] = w; }
}
#define UNI(x) __builtin_amdgcn_readfirstlane(x)

__device__ __forceinline__ void fox_item_naive(Frame& F, int b, int h, int qblk) {
    PHASE_IDS;
    const int t = qblk * 512 + tid; const size_t row = (size_t)b * S + t;
    unsigned q[32]; load_q64(q, F_PROJ + row * NPROJ + C_FQ + h * 64);
    const double* cc = F_FOXC + (size_t)(b * 12 + h) * S; const double ci = cc[t];
    float m = -INFINITY, l = 0.f; float o[64];
#pragma unroll
    for (int d = 0; d < 64; ++d) o[d] = 0.f;
    const int jmax = UNI(qblk * 512 + wave * 64 + 63);
    const bf16* kb = F_PROJ + (size_t)b * S * NPROJ + C_FK + h * 64; const bf16* vb = F_PROJ + (size_t)b * S * NPROJ + C_FV + h * 64;
    for (int j = 0; j <= jmax; ++j) {
        const float bias = (float)(ci - cc[j]);
        if (j <= t) { const float s = dot64(q, kb + (size_t)j * NPROJ) + bias; KEY_STEP(s, vb + (size_t)j * NPROJ); }
    }
    store_o64(F_O + row * D + (16 + h) * 64, o, 1.0f / l);
}
__device__ __forceinline__ void mem_item_naive(Frame& F, int layer, int b, int h, int qblk) {
    PHASE_IDS;
    const int t = qblk * 512 + tid; const size_t row = (size_t)b * S + t;
    unsigned q[32]; load_q64(q, F_PROJ + row * NPROJ + C_EQ + h * 64);
    float m = -INFINITY, l = 0.f; float o[64];
#pragma unroll
    for (int d = 0; d < 64; ++d) o[d] = 0.f;
    const float* kv = F_MEMKV + (size_t)layer * 512 * 512 + (size_t)b * 256 * 512;
    for (int j = 0; j < 256; ++j) { const float s = dot64f(q, kv + (size_t)j * 512 + h * 64); KEY_STEPF(s, kv + (size_t)j * 512 + 256 + h * 64); }
    store_o64(F_O + row * D + (28 + h) * 64, o, 1.0f / l);
}
__device__ __forceinline__ void moba_item_naive(Frame& F, int b, int h, int qblk) {
    PHASE_IDS;
    const int t = qblk * 512 + tid; const size_t row = (size_t)b * S + t;
    unsigned q[32]; load_q64(q, F_PROJ + row * NPROJ + C_MQ + h * 64);
    const int own = UNI((qblk * 512 + wave * 64) >> 8);
    float g0 = -INFINITY, g1 = -INFINITY, g2 = -INFINITY; int i0 = -1, i1 = -1, i2 = -1;
    const float* km = F_KMEAN + (size_t)(b * 8 + h) * 64 * 64;
    for (int j = 0; j < own; ++j) {
        const float g = dot64f(q, km + j * 64);
        if (g > g0) { g2 = g1; i2 = i1; g1 = g0; i1 = i0; g0 = g; i0 = j; }
        else if (g > g1) { g2 = g1; i2 = i1; g1 = g; i1 = j; }
        else if (g > g2) { g2 = g; i2 = j; }
    }
    const float slope = exp2f(-(float)(h + 1)) * LOG2E;
    float m = -INFINITY, l = 0.f; float o[64];
#pragma unroll
    for (int d = 0; d < 64; ++d) o[d] = 0.f;
    const bf16* kb = F_PROJ + (size_t)b * S * NPROJ + C_MK + h * 64; const bf16* vb = F_PROJ + (size_t)b * S * NPROJ + C_MV + h * 64;
    const int jmax = UNI(qblk * 512 + wave * 64 + 63);
    for (int j = own * 256; j <= jmax; ++j) {
        if (j <= t) { const float s = dot64(q, kb + (size_t)j * NPROJ) - slope * (float)(t - j); KEY_STEP(s, vb + (size_t)j * NPROJ); }
    }
#pragma unroll
    for (int n = 0; n < 3; ++n) {
        const int sb = n == 0 ? i0 : n == 1 ? i1 : i2;
        for (int off = 0; off < 256; ++off) {
            if (sb >= 0) { const int j = sb * 256 + off; const float s = dot64(q, kb + (size_t)j * NPROJ) - slope * (float)(t - j); KEY_STEP(s, vb + (size_t)j * NPROJ); }
        }
    }
    store_o64(F_O + row * D + h * 64, o, 1.0f / l);
}
__device__ __forceinline__ void nsa_item_naive(Frame& F, int b, int g, int qblk) {
    PHASE_IDS;
    const int ql = tid >> 2, hh = tid & 3, h = g * 4 + hh; const int t = qblk * 128 + ql; const size_t row = (size_t)b * S + t;
    LAS float* imp = (LAS float*)(F.lds + RING_OFF) + ql * 256;
    LAS int* selL = (LAS int*)(F.lds + SEL_OFF) + ql * 16;
    LAS float* stash = (LAS float*)(F.lds + RING_OFF) + tid * 64;
    for (int i = tid; i < 128 * 256; i += NTHR) ((LAS float*)(F.lds + RING_OFF))[i] = 0.f;
    __syncthreads();
    unsigned q[32]; load_q64(q, F_PROJ + row * NPROJ + C_NQ + h * 64);
    const float slope = exp2f(-(float)(h + 1)) * LOG2E;
    const float* kc = F_KCMP + (size_t)((0 * 2 + b) * 2 + g) * NCMP_PAD * 64; const float* vc = F_KCMP + (size_t)((1 * 2 + b) * 2 + g) * NCMP_PAD * 64;
    const int tmax = UNI(qblk * 128 + wave * 16 + 15);
    const int ncw = tmax >= 31 ? ((tmax - 31) >> 4) + 1 : 0;
    float m = -INFINITY, l = 0.f;
    for (int n = 0; n < ncw; ++n) {
        const int ce = 16 * n + 31;
        if (ce <= t) { const float s = dot64f(q, kc + n * 64) - slope * (float)(t - ce); const float mn = fmaxf(m, s); l = l * ex2(m - mn) + ex2(s - mn); m = mn; }
    }
    float o[64];
#pragma unroll
    for (int d = 0; d < 64; ++d) o[d] = 0.f;
    const float rl = l > 0.f ? 1.0f / l : 0.f;
    for (int n = 0; n < ncw; ++n) {
        const int ce = 16 * n + 31; float p = 0.f;
        if (ce <= t) { const float s = dot64f(q, kc + n * 64) - slope * (float)(t - ce); p = ex2(s - m) * rl; axpy64f(o, 1.0f, p, vc + n * 64); }
        float p4 = p + __shfl_xor(p, 1); p4 = p4 + __shfl_xor(p4, 2);
        if (hh == 0) { imp[n >> 2] += p4; if ((n & 3) == 3) imp[(n >> 2) + 1] += p4; }
    }
    __syncthreads();
    const int jt = t >> 6;
    if (hh == 0) { imp[0] = 1.0e4f; imp[jt] = 1.0e4f; if (jt >= 1) imp[jt - 1] = 1.0e4f; }
    __syncthreads();
    int nsel = 0;
    for (int i = 0; i < 16; ++i) {
        float best = -1.0f; int bi = -1;
        for (int k = 0; k <= jt; ++k) { const float v = imp[k]; if (v > best) { best = v; bi = k; } }
        if (bi < 0) break;
        __builtin_amdgcn_wave_barrier();
        imp[bi] = -2.0f; selL[i] = bi; nsel = i + 1;
        __builtin_amdgcn_wave_barrier();
    }
    __syncthreads();
    const bf16* gp = F_PROJ + row * NPROJ + C_GATE + h * 3;
    const float ga = 1.0f / (1.0f + __expf(-bf2f(gp[0]))), gb = 1.0f / (1.0f + __expf(-bf2f(gp[1]))), gc = 1.0f / (1.0f + __expf(-bf2f(gp[2])));
#pragma unroll
    for (int d = 0; d < 64; ++d) stash[d] = ga * o[d];
    const bf16* pb = F_PROJ + (size_t)b * S * NPROJ;
    m = -INFINITY; l = 0.f;
#pragma unroll
    for (int d = 0; d < 64; ++d) o[d] = 0.f;
    for (int i = 0; i < 16; ++i) {
        const int blk = i < nsel ? selL[i] : -1;
        for (int off = 0; off < 64; ++off) {
            const int j = blk * 64 + off;
            if (blk >= 0 && j <= t) { const float s = dot64(q, pb + (size_t)j * NPROJ + C_NKV + 2 * 128 + g * 64) - slope * (float)(t - j); KEY_STEP(s, pb + (size_t)j * NPROJ + C_NKV + 3 * 128 + g * 64); }
        }
    }
    { const float sc = l > 0.f ? gb / l : 0.f;
#pragma unroll
      for (int d = 0; d < 64; ++d) stash[d] += sc * o[d]; }
    m = -INFINITY; l = 0.f;
#pragma unroll
    for (int d = 0; d < 64; ++d) o[d] = 0.f;
    const int tmin = UNI(qblk * 128 + wave * 16);
    for (int j = (tmin - 511 > 0 ? tmin - 511 : 0); j <= tmax; ++j) {
        if (j <= t && t - j < 512) { const float s = dot64(q, pb + (size_t)j * NPROJ + C_NKV + 4 * 128 + g * 64) - slope * (float)(t - j); KEY_STEP(s, pb + (size_t)j * NPROJ + C_NKV + 5 * 128 + g * 64); }
    }
    { const float sc = l > 0.f ? gc / l : 0.f;
#pragma unroll
      for (int d = 0; d < 64; ++d) o[d] = stash[d] + sc * o[d]; }
    store_o64(F_O + row * D + (8 + h) * 64, o, 1.0f);
    __syncthreads();
}
__device__ __forceinline__ void cmp_item_naive(Frame& F, int layer, int item) {
    PHASE_IDS;
    const int chunk = item & 127, g = (item >> 7) & 1, b = (item >> 8) & 1, kv = item >> 9; const int n0 = chunk * 8;
    LAS float* X = (LAS float*)(F.lds + RING_OFF);
    LAS float* H = X + 144 * 64;
    const bf16* src = F_PROJ + (size_t)b * S * NPROJ + C_NKV + kv * 128 + g * 64;
    for (int i = tid; i < 144 * 64; i += NTHR) { const int p = 16 * n0 + (i >> 6); X[i] = p < S ? bf2f(src[(size_t)p * NPROJ + (i & 63)]) : 0.f; }
    __syncthreads();
    const int e = tid & 127, sub = tid >> 7;
    const float* w1 = F_IN(8) + (size_t)(layer * 2 + kv) * 32 * 64 * 128; const float* pe = F_IN(7) + (size_t)(layer * 2 + kv) * 32 * 64;
    float a0 = 0.f, a1 = 0.f;
    for (int ld = 0; ld < 2048; ++ld) { const float w = w1[(size_t)ld * 128 + e]; const float pv = pe[ld]; a0 += (X[(2 * sub) * 16 * 64 + ld] + pv) * w; a1 += (X[(2 * sub + 1) * 16 * 64 + ld] + pv) * w; }
    H[(2 * sub) * 128 + e] = gelu_tanh(a0); H[(2 * sub + 1) * 128 + e] = gelu_tanh(a1);
    __syncthreads();
    const int tok = tid >> 6, dd = tid & 63; const float* w2 = F_IN(9) + (size_t)(layer * 2 + kv) * 128 * 64; float a = 0.f;
    for (int k = 0; k < 128; ++k) a += H[tok * 128 + k] * w2[k * 64 + dd];
    { const size_t oi = ((size_t)((kv * 2 + b) * 2 + g) * NCMP_PAD + n0 + tok) * 64 + dd; const float av = n0 + tok < NCMP ? a : 0.f; F_KCMP[oi] = av; F_KCMPB[oi] = (bf16)f2bf(av); }
    __syncthreads();
}
__device__ __forceinline__ void prep_phase(Frame& F, int layer) {
    PHASE_IDS;
    if (blockIdx.x < 24) {
        const int b = blockIdx.x / 12, h = blockIdx.x % 12; const float bf = F_IN(5)[layer * 12 + h];
        LAS double* part = (LAS double*)(F.lds + RING_OFF);
        const bf16* src = F_PROJ + (size_t)b * S * NPROJ + C_FF + h; float lf[32]; double s = 0.0;
#pragma unroll
        for (int i = 0; i < 32; ++i) { const float x = bf2f(src[(size_t)(tid * 32 + i) * NPROJ]) + bf; lf[i] = (fminf(x, 0.f) - log1pf(__expf(-fabsf(x)))) * LOG2E; s += (double)lf[i]; }
        part[tid] = s; __syncthreads();
        double pre = 0.0; for (int k = 0; k < tid; ++k) pre += part[k];
        double* dst = F_FOXC + (size_t)(b * 12 + h) * S + tid * 32;
#pragma unroll
        for (int i = 0; i < 32; ++i) { pre += (double)lf[i]; dst[i] = pre; }
        __syncthreads();
    }
    for (int it = blockIdx.x; it < 1024; it += F.G) cmp_item_naive(F, layer, it);
    for (int o = blockIdx.x * NTHR + tid; o < 2 * 8 * 64 * 64; o += F.G * NTHR) {
        const int d = o & 63, j = (o >> 6) & 63, h = (o >> 12) & 7, b = o >> 15;
        const bf16* src = F_PROJ + ((size_t)b * S + j * 256) * NPROJ + C_MK + h * 64 + d; float a = 0.f;
        for (int p = 0; p < 256; ++p) a += bf2f(src[(size_t)p * NPROJ]);
        const float km = a * (1.0f / 256.0f); F_KMEAN[o] = km;
        const unsigned kh = f2bf(km); F_KMEANB[o] = (bf16)kh; F_KMEANB[2 * 8 * 64 * 64 + o] = (bf16)f2bf(km - __uint_as_float(kh << 16));
    }
}
__device__ __forceinline__ void act_phase(Frame& F, int layer) {
    PHASE_IDS;
    const float* cw = F_IN(14) + (size_t)layer * 3 * DFF; const float* cb = F_IN(15) + (size_t)layer * DFF;
    constexpr int CG = DFF / 8;
    for (size_t i = (size_t)blockIdx.x * NTHR + tid; i < (size_t)MH * CG; i += (size_t)F.G * NTHR) {
        const int cg = (int)(i % CG), t = (int)(i / CG), c0 = cg * 8;
        const bf16* ur = F_UG + (size_t)t * NUP + c0; const bf16* gr = ur + DFF;
        const uint4 uu = *(const uint4*)ur, g2 = *(const uint4*)gr;
        uint4 g1 = make_uint4(0, 0, 0, 0), g0 = make_uint4(0, 0, 0, 0);
        if (t >= 1) g1 = *(const uint4*)(gr - NUP);
        if (t >= 2) g0 = *(const uint4*)(gr - 2 * NUP);
        const unsigned ua[4] = {uu.x, uu.y, uu.z, uu.w}, a2[4] = {g2.x, g2.y, g2.z, g2.w}, a1[4] = {g1.x, g1.y, g1.z, g1.w}, a0[4] = {g0.x, g0.y, g0.z, g0.w};
        unsigned r[4];
#pragma unroll
        for (int k = 0; k < 4; ++k) {
            const int c = c0 + 2 * k;
            const float x0 = cb[c] + cw[c] * blo(a0[k]) + cw[DFF + c] * blo(a1[k]) + cw[2 * DFF + c] * blo(a2[k]);
            const float x1 = cb[c + 1] + cw[c + 1] * bhi(a0[k]) + cw[DFF + c + 1] * bhi(a1[k]) + cw[2 * DFF + c + 1] * bhi(a2[k]);
            r[k] = pk2(gelu_tanh(x0) * blo(ua[k]), gelu_tanh(x1) * bhi(ua[k]));
        }
        *(uint4*)(F_ACT + (size_t)t * DFF + c0) = make_uint4(r[0], r[1], r[2], r[3]);
    }
}

namespace ga {
typedef short bf16x8 __attribute__((ext_vector_type(8)));
typedef short s16x4 __attribute__((ext_vector_type(4)));
typedef float f32x16 __attribute__((ext_vector_type(16)));
typedef unsigned u32x4 __attribute__((ext_vector_type(4)));
typedef LAS const char* lds_cptr;
typedef short v4i16_t __attribute__((ext_vector_type(4)));
constexpr int SLOTB = 8192, L_K = 0, L_V = 2 * SLOTB, L_WSF = 4 * SLOTB, L_OST = L_WSF + 2048, L_VAR = L_OST + 32768;
__device__ __forceinline__ int crow(int r, int hi) { return (r & 3) + 8 * (r >> 2) + 4 * hi; }
__device__ __forceinline__ void glds16(const void* gsrc, unsigned lds_dst) { unsigned keep;
    asm volatile("s_mov_b32 %0, m0\n\ts_mov_b32 m0, %2\n\ts_nop 0\n\tglobal_load_lds_dwordx4 %1, off\n\ts_mov_b32 m0, %0" : "=&s"(keep) : "v"(gsrc), "s"(lds_dst) : "memory"); }
typedef float f32x2_t __attribute__((ext_vector_type(2))); typedef __bf16 bf16x2_t __attribute__((ext_vector_type(2)));
__device__ __forceinline__ unsigned cvtpk(float lo, float hi) { f32x2_t v = {lo, hi}; bf16x2_t b = __builtin_convertvector(v, bf16x2_t); return __builtin_bit_cast(unsigned, b); }
__device__ __forceinline__ s16x4 vtr(lds_cptr p) { return __builtin_bit_cast(s16x4, __builtin_amdgcn_ds_read_tr16_b64_v4i16((LAS v4i16_t*)p)); }
#define GA_WAIT_BAR(N) asm volatile("s_waitcnt vmcnt(" #N ") lgkmcnt(0)\n\ts_barrier" ::: "memory")

struct Core { bf16x8 qr[4]; float m, l; f32x16 o0, o1; };
__device__ __forceinline__ void core_reset(Core& c) { c.m = -INFINITY; c.l = 0.f; c.o0 = f32x16{}; c.o1 = f32x16{}; }
__device__ __forceinline__ void load_q(Core& c, const bf16* qrow, int hi) {
#pragma unroll
    for (int d0 = 0; d0 < 4; ++d0) c.qr[d0] = *(const bf16x8*)(qrow + d0 * 16 + hi * 8);
}
struct TileDma {
    const bf16* ksrc; const bf16* vsrc; unsigned kdst, vdst;
    __device__ __forceinline__ void init(const bf16* K, int kpitch, const bf16* V, int vpitch, LAS unsigned char* base, int wid, int lane) {
        ksrc = K + (size_t)lane * kpitch + wid * 8;
        vsrc = V + (size_t)(16 * (wid & 3) + (lane >> 2)) * vpitch + (wid >> 2) * 32 + (lane & 3) * 8;
        const unsigned b0 = (unsigned)(uintptr_t)base; kdst = b0 + L_K + wid * 1024; vdst = b0 + L_V + wid * 1024;
    }
    __device__ __forceinline__ void issue(size_t koff, size_t voff, int slot) const {
        glds16(ksrc + koff, (unsigned)__builtin_amdgcn_readfirstlane(kdst + slot * SLOTB));
        glds16(vsrc + voff, (unsigned)__builtin_amdgcn_readfirstlane(vdst + slot * SLOTB));
    }
};
__device__ __forceinline__ void dma_k_only(const TileDma& dma, size_t koff, int slot) { glds16(dma.ksrc + koff, (unsigned)__builtin_amdgcn_readfirstlane(dma.kdst + slot * SLOTB)); }
__device__ __forceinline__ void qk_tile(f32x16& p0, f32x16& p1, const Core& c, LAS unsigned char* base, int slot, int r32, int hi) {
    const lds_cptr kb = (lds_cptr)base + L_K + slot * SLOTB + hi * 1024 + r32 * 16;
    p0 = f32x16{}; p1 = f32x16{};
#pragma unroll
    for (int d0 = 0; d0 < 4; ++d0) {
        const bf16x8 b0 = *(const LAS bf16x8*)(kb + d0 * 2048), b1 = *(const LAS bf16x8*)(kb + d0 * 2048 + 512);
        p0 = __builtin_amdgcn_mfma_f32_32x32x16_bf16(b0, c.qr[d0], p0, 0, 0, 0);
        p1 = __builtin_amdgcn_mfma_f32_32x32x16_bf16(b1, c.qr[d0], p1, 0, 0, 0);
    }
}
__device__ __forceinline__ float rowmax32(const f32x16& p0, const f32x16& p1) {
    float a = fmaxf(p0[0], p1[0]);
#pragma unroll
    for (int r = 1; r < 16; ++r) a = fmaxf(a, fmaxf(p0[r], p1[r]));
    return fmaxf(a, __shfl_xor(a, 32));
}
__device__ __forceinline__ void softmax_pv(Core& c, f32x16& p0, f32x16& p1, LAS unsigned char* base, int slot, int wid, int lane, int r32, int hi) {
    const float rm = rowmax32(p0, p1);
    const float mn = fmaxf(c.m, rm);
    const float mu = (mn == -INFINITY) ? 0.f : mn;
    const float alpha = ex2(c.m - mu);
    float ps = 0.f;
#pragma unroll
    for (int r = 0; r < 16; ++r) { p0[r] = ex2(p0[r] - mu); p1[r] = ex2(p1[r] - mu); ps += p0[r] + p1[r]; }
    c.l = c.l * alpha + ps; c.m = mn;
    LAS float* wsf = (LAS float*)(base + L_WSF) + wid * 64;
    if (__any(alpha != 1.0f)) {
        if (hi == 0) wsf[r32] = alpha;
        __builtin_amdgcn_fence(__ATOMIC_RELEASE, "wavefront"); asm volatile("s_waitcnt lgkmcnt(0)" ::: "memory");
#pragma unroll
        for (int r = 0; r < 16; ++r) { const float f = wsf[crow(r, hi)]; c.o0[r] *= f; c.o1[r] *= f; }
        asm volatile("s_waitcnt lgkmcnt(0)" ::: "memory");
    }
    u32x4 pw[4];
#pragma unroll
    for (int k = 0; k < 4; ++k) { pw[0][k] = cvtpk(p0[2 * k], p0[2 * k + 1]); pw[1][k] = cvtpk(p0[8 + 2 * k], p0[8 + 2 * k + 1]); pw[2][k] = cvtpk(p1[2 * k], p1[2 * k + 1]); pw[3][k] = cvtpk(p1[8 + 2 * k], p1[8 + 2 * k + 1]); }
    const lds_cptr vp = (lds_cptr)base + L_V + slot * SLOTB + ((lane >> 4) & 1) * 32 + (lane & 3) * 8 + (4 * hi + ((lane & 15) >> 2)) * 64;
#pragma unroll
    for (int ks = 0; ks < 4; ++ks) {
        const s16x4 lo0 = vtr(vp + ks * 1024), hi0 = vtr(vp + ks * 1024 + 512), lo1 = vtr(vp + 4096 + ks * 1024), hi1 = vtr(vp + 4096 + ks * 1024 + 512);
        const bf16x8 v0 = (bf16x8){lo0[0], lo0[1], lo0[2], lo0[3], hi0[0], hi0[1], hi0[2], hi0[3]}, v1 = (bf16x8){lo1[0], lo1[1], lo1[2], lo1[3], hi1[0], hi1[1], hi1[2], hi1[3]};
        const bf16x8 pa = __builtin_bit_cast(bf16x8, pw[ks]);
        c.o0 = __builtin_amdgcn_mfma_f32_32x32x16_bf16(pa, v0, c.o0, 0, 0, 0);
        c.o1 = __builtin_amdgcn_mfma_f32_32x32x16_bf16(pa, v1, c.o1, 0, 0, 0);
    }
}
__device__ __forceinline__ float row_l(const Core& c) { return c.l + __shfl_xor(c.l, 32); }
__device__ __forceinline__ void scale_o(f32x16& a0, f32x16& a1, const Core& c, float rowscale, bool accumulate, LAS unsigned char* base, int wid, int r32, int hi) {
    LAS float* wsf = (LAS float*)(base + L_WSF) + wid * 64;
    if (hi == 0) wsf[r32] = rowscale;
    __builtin_amdgcn_fence(__ATOMIC_RELEASE, "wavefront"); asm volatile("s_waitcnt lgkmcnt(0)" ::: "memory");
#pragma unroll
    for (int r = 0; r < 16; ++r) { const float f = wsf[crow(r, hi)]; if (accumulate) { a0[r] += f * c.o0[r]; a1[r] += f * c.o1[r]; } else { a0[r] = f * c.o0[r]; a1[r] = f * c.o1[r]; } }
    asm volatile("s_waitcnt lgkmcnt(0)" ::: "memory");
}
template <class RowPtr>
__device__ __forceinline__ void store_rows(const f32x16& a0, const f32x16& a1, LAS unsigned char* base, int wid, int lane, int r32, int hi, const RowPtr& rowptr) {
    LAS bf16* stg = (LAS bf16*)(base + L_OST) + wid * 2048;
#pragma unroll
    for (int r = 0; r < 16; ++r) { const int orow = crow(r, hi); stg[orow * 64 + r32] = (bf16)f2bf(a0[r]); stg[orow * 64 + 32 + r32] = (bf16)f2bf(a1[r]); }
    __builtin_amdgcn_fence(__ATOMIC_RELEASE, "wavefront"); asm volatile("s_waitcnt lgkmcnt(0)" ::: "memory");
#pragma unroll
    for (int i = 0; i < 4; ++i) { const int row = i * 8 + (lane >> 3), ch = lane & 7; const u32x4 v = *(const LAS u32x4*)(stg + row * 64 + ch * 8); *(u32x4*)(rowptr(row) + ch * 8) = v; }
    asm volatile("s_waitcnt lgkmcnt(0)" ::: "memory");
}
template <bool HAS_V, class RowFn, class BiasMask>
__device__ __forceinline__ void run_tiles_t(Core& c, const TileDma& dma, int kpitch, int vpitch, int nt, const RowFn& rowfn, const BiasMask& bm, LAS unsigned char* base, int wid, int lane, int r32, int hi) {
    if (nt <= 0) return;
    { const int r0 = rowfn(0); if (HAS_V) dma.issue((size_t)r0 * kpitch, (size_t)r0 * vpitch, 0); else dma_k_only(dma, (size_t)r0 * kpitch, 0); }
    for (int i = 0; i < nt; ++i) {
        const int slot = i & 1;
        if (i + 1 < nt) { const int r1 = rowfn(i + 1);
            if (HAS_V) { dma.issue((size_t)r1 * kpitch, (size_t)r1 * vpitch, slot ^ 1); GA_WAIT_BAR(2); } else { dma_k_only(dma, (size_t)r1 * kpitch, slot ^ 1); GA_WAIT_BAR(1); } }
        else { GA_WAIT_BAR(0); }
        f32x16 p0, p1;
        qk_tile(p0, p1, c, base, slot, r32, hi);
        bm(p0, p1, i);
        if (HAS_V) softmax_pv(c, p0, p1, base, slot, wid, lane, r32, hi);
        if (HAS_V) { GA_WAIT_BAR(2); } else { GA_WAIT_BAR(1); }
    }
}
template <class RowFn, class BiasMask>
__device__ __forceinline__ void run_tiles(Core& c, const TileDma& dma, int kpitch, int vpitch, int nt, const RowFn& rowfn, const BiasMask& bm, LAS unsigned char* base, int wid, int lane, int r32, int hi) {
    run_tiles_t<true>(c, dma, kpitch, vpitch, nt, rowfn, bm, base, wid, lane, r32, hi);
}

__device__ __forceinline__ void mem_unit(Frame& F, int layer, int b, int h, int qb) {
    PHASE_IDS; const int r32 = lane & 31, hi = lane >> 5;
    LAS unsigned char* base = F.lds + RING_OFF;
    const size_t row = (size_t)b * S + qb * 256 + wave * 32 + r32;
    Core c; core_reset(c); load_q(c, F_PROJ + row * NPROJ + C_EQ + h * 64, hi);
    const bf16* kv = F_MEMKVB + (size_t)layer * 512 * 512 + (size_t)b * 256 * 512;
    TileDma dma; dma.init(kv + h * 64, 512, kv + 256 + h * 64, 512, base, wave, lane);
    asm volatile("s_waitcnt vmcnt(0)" ::: "memory");
    run_tiles(c, dma, 512, 512, 4, [](int i) { return i * 64; }, [](f32x16&, f32x16&, int) {}, base, wave, lane, r32, hi);
    const float l = row_l(c);
    f32x16 a0, a1; scale_o(a0, a1, c, 1.0f / l, false, base, wave, r32, hi);
    bf16* ob = F_O + ((size_t)b * S + qb * 256 + wave * 32) * D + (28 + h) * 64;
    store_rows(a0, a1, base, wave, lane, r32, hi, [ob](int r) { return ob + (size_t)r * D; });
    GA_WAIT_BAR(0);
}
__device__ __forceinline__ void fox_unit(Frame& F, int b, int h, int qb) {
    PHASE_IDS; const int r32 = lane & 31, hi = lane >> 5;
    LAS unsigned char* base = F.lds + RING_OFF;
    LAS float* T = (LAS float*)(base + L_VAR);
    const int q0 = qb * 256, nk = q0 + 256;
    const double* cc = F_FOXC + (size_t)(b * 12 + h) * S;
    const double cref = q0 > 0 ? cc[q0 - 1] : 0.0;
    for (int j = tid; j < nk; j += NTHR) T[j] = (float)(cref - cc[j]);
    const size_t row = (size_t)b * S + q0 + wave * 32 + r32;
    Core c; core_reset(c); load_q(c, F_PROJ + row * NPROJ + C_FQ + h * 64, hi);
    const bf16* pb = F_PROJ + (size_t)b * S * NPROJ;
    TileDma dma; dma.init(pb + C_FK + h * 64, NPROJ, pb + C_FV + h * 64, NPROJ, base, wave, lane);
    GA_WAIT_BAR(0);
    const int nt = nk / 64, trow = wave * 32 + r32;
    run_tiles(c, dma, NPROJ, NPROJ, nt, [](int i) { return i * 64; },
        [=](f32x16& p0, f32x16& p1, int i) {
            const LAS f32x4* tp = (const LAS f32x4*)(T + i * 64 + 4 * hi);
#pragma unroll
            for (int g = 0; g < 4; ++g) { const f32x4 t0 = tp[2 * g], t1 = tp[8 + 2 * g];
                p0[4 * g] += t0.x; p0[4 * g + 1] += t0.y; p0[4 * g + 2] += t0.z; p0[4 * g + 3] += t0.w; p1[4 * g] += t1.x; p1[4 * g + 1] += t1.y; p1[4 * g + 2] += t1.z; p1[4 * g + 3] += t1.w; }
            if (i >= nt - 4) {
                const int kb = (i - (nt - 4)) * 64 + 4 * hi;
#pragma unroll
                for (int r = 0; r < 16; ++r) { const int kv = kb + (r & 3) + 8 * (r >> 2); if (kv > trow) p0[r] = -INFINITY; if (kv + 32 > trow) p1[r] = -INFINITY; }
            }
        }, base, wave, lane, r32, hi);
    const float l = row_l(c);
    f32x16 a0, a1; scale_o(a0, a1, c, 1.0f / l, false, base, wave, r32, hi);
    bf16* ob = F_O + ((size_t)b * S + q0 + wave * 32) * D + (16 + h) * 64;
    store_rows(a0, a1, base, wave, lane, r32, hi, [ob](int r) { return ob + (size_t)r * D; });
    GA_WAIT_BAR(0);
}

__device__ __forceinline__ bool gate_better(float vb, int ib, float va, int ia) { return vb > va || (vb == va && ib < ia); }
#define GATE_INS(v, i) do { const float v_ = (v); const int i_ = (i); \
    if (gate_better(v_, i_, g0, i0)) { g2 = g1; i2 = i1; g1 = g0; i1 = i0; g0 = v_; i0 = i_; } \
    else if (gate_better(v_, i_, g1, i1)) { g2 = g1; i2 = i1; g1 = v_; i1 = i_; } \
    else if (gate_better(v_, i_, g2, i2)) { g2 = v_; i2 = i_; } } while (0)
__device__ __forceinline__ void moba_unit(Frame& F, int b, int h, int own) {
    PHASE_IDS; const int r32 = lane & 31, hi = lane >> 5;
    LAS unsigned char* base = F.lds + RING_OFF;
    LAS unsigned long long* um = (LAS unsigned long long*)(base + L_VAR);
    LAS int* tl = (LAS int*)(base + L_VAR + 64);
    const int q0 = own * 256, t = q0 + wave * 32 + r32;
    const size_t row = (size_t)b * S + t;
    Core c; core_reset(c); load_q(c, F_PROJ + row * NPROJ + C_MQ + h * 64, hi);
    const bf16* pb = F_PROJ + (size_t)b * S * NPROJ;
    float g0 = -INFINITY, g1 = -INFINITY, g2 = -INFINITY; int i0 = -1, i1 = -1, i2 = -1;
    if (own > 0) {
        TileDma gd; const bf16* kmh = F_KMEANB + (size_t)(b * 8 + h) * 64 * 64; gd.init(kmh, 64, kmh, 64, base, wave, lane);
        asm volatile("s_waitcnt vmcnt(0)" ::: "memory");
        dma_k_only(gd, 0, 0); dma_k_only(gd, (size_t)2 * 8 * 64 * 64, 1);
        GA_WAIT_BAR(0);
        f32x16 p0, p1, s0, s1; qk_tile(p0, p1, c, base, 0, r32, hi); qk_tile(s0, s1, c, base, 1, r32, hi);
#pragma unroll
        for (int r = 0; r < 16; ++r) { const int j = crow(r, hi); if (j < own) GATE_INS(p0[r] + s0[r], j); }
#pragma unroll
        for (int r = 0; r < 16; ++r) { const int j = 32 + crow(r, hi); if (j < own) GATE_INS(p1[r] + s1[r], j); }
        const float a0 = __shfl_xor(g0, 32), a1 = __shfl_xor(g1, 32), a2 = __shfl_xor(g2, 32); const int j0 = __shfl_xor(i0, 32), j1 = __shfl_xor(i1, 32), j2 = __shfl_xor(i2, 32);
        if (j0 >= 0) GATE_INS(a0, j0);
        if (j1 >= 0) GATE_INS(a1, j1);
        if (j2 >= 0) GATE_INS(a2, j2);
        GA_WAIT_BAR(0);
    }
    unsigned long long mk = 0ull;
    if (i0 >= 0) mk |= 1ull << i0;
    if (i1 >= 0) mk |= 1ull << i1;
    if (i2 >= 0) mk |= 1ull << i2;
#pragma unroll
    for (int o = 1; o < 64; o <<= 1) { const unsigned lo_ = __shfl_xor((unsigned)mk, o), hi_ = __shfl_xor((unsigned)(mk >> 32), o); mk |= ((unsigned long long)hi_ << 32) | lo_; }
    if (lane == 0) um[wave] = mk;
    GA_WAIT_BAR(0);
    unsigned long long un = 0ull;
#pragma unroll
    for (int w = 0; w < 8; ++w) un |= um[w];
    if (tid < 4) tl[tid] = q0 + 64 * tid;
    if (tid < 64 && ((un >> tid) & 1ull)) { const int pos = __builtin_popcountll(un & ((1ull << tid) - 1ull));
#pragma unroll
        for (int k = 0; k < 4; ++k) tl[4 + 4 * pos + k] = tid * 256 + 64 * k; }
    const int nt = __builtin_amdgcn_readfirstlane(4 + 4 * __builtin_popcountll(un));
    TileDma dma; dma.init(pb + C_MK + h * 64, NPROJ, pb + C_MV + h * 64, NPROJ, base, wave, lane);
    GA_WAIT_BAR(0);
    const float slope = exp2f(-(float)(h + 1)) * LOG2E;
    run_tiles(c, dma, NPROJ, NPROJ, nt, [=](int i) { return __builtin_amdgcn_readfirstlane(tl[i]); },
        [=](f32x16& p0, f32x16& p1, int i) {
            const int tr = __builtin_amdgcn_readfirstlane(tl[i]), J = tr >> 8;
            const bool sel = (i < 4) || J == i0 || J == i1 || J == i2;
            const float bs = sel ? slope * (float)(tr + 4 * hi - t) : -INFINITY;
#pragma unroll
            for (int r = 0; r < 16; ++r) { const float kf = (float)((r & 3) + 8 * (r >> 2)); p0[r] += bs + slope * kf; p1[r] += bs + slope * (kf + 32.0f); }
            if (i < 4) {
                const int kb = tr + 4 * hi;
#pragma unroll
                for (int r = 0; r < 16; ++r) { const int kv = kb + (r & 3) + 8 * (r >> 2); if (kv > t) p0[r] = -INFINITY; if (kv + 32 > t) p1[r] = -INFINITY; }
            }
        }, base, wave, lane, r32, hi);
    const float l = row_l(c);
    f32x16 a0, a1; scale_o(a0, a1, c, 1.0f / l, false, base, wave, r32, hi);
    bf16* ob = F_O + ((size_t)b * S + q0 + wave * 32) * D + h * 64;
    store_rows(a0, a1, base, wave, lane, r32, hi, [ob](int r) { return ob + (size_t)r * D; });
    GA_WAIT_BAR(0);
}
template <int CTRL> __device__ __forceinline__ float dpp_f(float x) { return __int_as_float(__builtin_amdgcn_update_dpp(0, __float_as_int(x), CTRL, 0xF, 0xF, true)); }
__device__ __forceinline__ unsigned long long wave_max_u64(unsigned long long k) {
#pragma unroll
    for (int o = 1; o < 64; o <<= 1) { const unsigned lo_ = __shfl_xor((unsigned)k, o), hi_ = __shfl_xor((unsigned)(k >> 32), o); const unsigned long long x = ((unsigned long long)hi_ << 32) | lo_; k = x > k ? x : k; }
    return k;
}
__device__ __forceinline__ void nsa_unit(Frame& F, int b, int g, int qblk) {
    PHASE_IDS; const int r32 = lane & 31, hi = lane >> 5;
    LAS unsigned char* base = F.lds + RING_OFF;
    LAS float* imp = (LAS float*)(base + L_VAR);
    LAS unsigned* selm = (LAS unsigned*)(base + L_VAR + 65536);
    LAS unsigned* um = (LAS unsigned*)(base + L_VAR + 65536 + 2048);
    LAS int* tl = (LAS int*)(base + L_VAR + 65536 + 2048 + 64);
    const int q0 = qblk * 64, ql = wave * 8 + (r32 >> 2), hh = r32 & 3, h = g * 4 + hh, t = q0 + ql, jt = qblk;
    const size_t row = (size_t)b * S + t;
    { f32x4* z = (f32x4*)0; (void)z; LAS f32x4* iz = (LAS f32x4*)imp; for (int i = tid; i < 64 * 256 / 4; i += NTHR) iz[i] = (f32x4){0.f, 0.f, 0.f, 0.f};
      for (int i = tid; i < 64 * 8 + 16; i += NTHR) selm[i] = 0u; }
    Core c; core_reset(c); load_q(c, F_PROJ + row * NPROJ + C_NQ + h * 64, hi);
    const bf16* gp = F_PROJ + row * NPROJ + C_GATE + h * 3;
    const float ga_ = 1.0f / (1.0f + __expf(-bf2f(gp[0]))), gb_ = 1.0f / (1.0f + __expf(-bf2f(gp[1]))), gc_ = 1.0f / (1.0f + __expf(-bf2f(gp[2])));
    const float slope = exp2f(-(float)(h + 1)) * LOG2E;
    const bf16* pb = F_PROJ + (size_t)b * S * NPROJ;
    f32x16 a0, a1;
    const int ncu = min(NCMP, (q0 + 32) / 16 + 1), ntc = (ncu + 63) >> 6;
    { const bf16* kc = F_KCMPB + (size_t)((0 * 2 + b) * 2 + g) * NCMP_PAD * 64; const bf16* vc = F_KCMPB + (size_t)((1 * 2 + b) * 2 + g) * NCMP_PAD * 64;
      TileDma dma; dma.init(kc, 64, vc, 64, base, wave, lane);
      GA_WAIT_BAR(0);
      auto cmp_bias = [=](f32x16& p0, f32x16& p1, int i) {
          const int ce0 = 16 * (i * 64 + 4 * hi) + 31 - t;
#pragma unroll
          for (int r = 0; r < 16; ++r) { const int d = ce0 + 16 * ((r & 3) + 8 * (r >> 2)); p0[r] = d <= 0 ? p0[r] + slope * (float)d : -INFINITY; p1[r] = d + 512 <= 0 ? p1[r] + slope * (float)(d + 512) : -INFINITY; }
      };
      run_tiles(c, dma, 64, 64, ntc, [](int i) { return i * 64; }, cmp_bias, base, wave, lane, r32, hi);
      const float lc = row_l(c); const float rl = lc > 0.f ? 1.0f / lc : 0.f; const float mu = c.m == -INFINITY ? 0.f : c.m;
      scale_o(a0, a1, c, ga_ * rl, false, base, wave, r32, hi);
      LAS float* impq = imp + ql * 256;
      run_tiles_t<false>(c, dma, 64, 64, ntc, [](int i) { return i * 64; },
          [=](f32x16& p0, f32x16& p1, int i) {
              cmp_bias(p0, p1, i);
#pragma unroll
              for (int r = 0; r < 16; ++r) { float x = ex2(p0[r] - mu) * rl; x += dpp_f<0xB1>(x); x += dpp_f<0x4E>(x); p0[r] = x; float y = ex2(p1[r] - mu) * rl; y += dpp_f<0xB1>(y); y += dpp_f<0x4E>(y); p1[r] = y; }
              if (hh == 0) {
#pragma unroll
                  for (int g4 = 0; g4 < 4; ++g4) {
                      const int j = i * 16 + 2 * g4 + hi;
                      __hip_atomic_fetch_add(impq + j, ((p0[4 * g4] + p0[4 * g4 + 1]) + p0[4 * g4 + 2]) + p0[4 * g4 + 3], __ATOMIC_RELAXED, __HIP_MEMORY_SCOPE_WORKGROUP);
                      __hip_atomic_fetch_add(impq + j + 1, p0[4 * g4 + 3], __ATOMIC_RELAXED, __HIP_MEMORY_SCOPE_WORKGROUP);
                      __hip_atomic_fetch_add(impq + j + 8, ((p1[4 * g4] + p1[4 * g4 + 1]) + p1[4 * g4 + 2]) + p1[4 * g4 + 3], __ATOMIC_RELAXED, __HIP_MEMORY_SCOPE_WORKGROUP);
                      if (j + 9 < 256) __hip_atomic_fetch_add(impq + j + 9, p1[4 * g4 + 3], __ATOMIC_RELAXED, __HIP_MEMORY_SCOPE_WORKGROUP);
                  }
              }
          }, base, wave, lane, r32, hi);
    }
    GA_WAIT_BAR(0);
    for (int qi = 0; qi < 8; ++qi) {
        const int qq = wave * 8 + qi; const LAS float* iq = imp + qq * 256;
        float v[4];
#pragma unroll
        for (int k = 0; k < 4; ++k) { const int j = lane + 64 * k; v[k] = j <= jt ? ((j == 0 || j == jt || j == jt - 1) ? 1.0e4f : iq[j]) : -1.0f; }
        for (int it = 0; it < 16; ++it) {
            float bv = -1.0f; int bj = 0;
#pragma unroll
            for (int k = 0; k < 4; ++k) if (v[k] > bv) { bv = v[k]; bj = lane + 64 * k; }
            const unsigned long long key = bv >= 0.f ? (((unsigned long long)__float_as_uint(bv) << 32) | (unsigned)(0xFFFFFFFFu - (unsigned)bj)) : 0ull;
            const unsigned long long best = wave_max_u64(key);
            if (best == 0ull) break;
            const int wj = (int)(0xFFFFFFFFu - (unsigned)best);
#pragma unroll
            for (int k = 0; k < 4; ++k) if (wj == lane + 64 * k) v[k] = -1.0f;
            if (lane == 0) { __hip_atomic_fetch_or(selm + qq * 8 + (wj >> 5), 1u << (wj & 31), __ATOMIC_RELAXED, __HIP_MEMORY_SCOPE_WORKGROUP); __hip_atomic_fetch_or(um + (wj >> 5), 1u << (wj & 31), __ATOMIC_RELAXED, __HIP_MEMORY_SCOPE_WORKGROUP); }
        }
    }
    GA_WAIT_BAR(0);
    int nts;
    { unsigned u[8]; int pre[8]; int tot = 0;
#pragma unroll
      for (int w = 0; w < 8; ++w) { u[w] = um[w]; pre[w] = tot; tot += __builtin_popcount(u[w]); }
      nts = __builtin_amdgcn_readfirstlane(tot);
      if (tid < 256) { const int w = tid >> 5, bit = tid & 31; unsigned uw = 0; int pw_ = 0;
#pragma unroll
          for (int k = 0; k < 8; ++k) if (k == w) { uw = u[k]; pw_ = pre[k]; }
          if ((uw >> bit) & 1u) tl[pw_ + __builtin_popcount(uw & ((1u << bit) - 1u))] = tid * 64; }
    }
    GA_WAIT_BAR(0);
    { core_reset(c);
      TileDma dma; dma.init(pb + C_NKV + 2 * 128 + g * 64, NPROJ, pb + C_NKV + 3 * 128 + g * 64, NPROJ, base, wave, lane);
      const LAS unsigned* sq = selm + ql * 8;
      run_tiles(c, dma, NPROJ, NPROJ, nts, [=](int i) { return __builtin_amdgcn_readfirstlane(tl[i]); },
          [=](f32x16& p0, f32x16& p1, int i) {
              const int tr = __builtin_amdgcn_readfirstlane(tl[i]), J = tr >> 6;
              const bool sel = (sq[J >> 5] >> (J & 31)) & 1u;
              const int d0 = tr + 4 * hi - t;
#pragma unroll
              for (int r = 0; r < 16; ++r) { const int d = d0 + (r & 3) + 8 * (r >> 2); p0[r] = (sel && d <= 0) ? p0[r] + slope * (float)d : -INFINITY; p1[r] = (sel && d + 32 <= 0) ? p1[r] + slope * (float)(d + 32) : -INFINITY; }
          }, base, wave, lane, r32, hi);
      const float ls = row_l(c);
      scale_o(a0, a1, c, ls > 0.f ? gb_ / ls : 0.f, true, base, wave, r32, hi);
    }
    { core_reset(c);
      TileDma dma; dma.init(pb + C_NKV + 4 * 128 + g * 64, NPROJ, pb + C_NKV + 5 * 128 + g * 64, NPROJ, base, wave, lane);
      const int first = q0 >= 512 ? q0 - 512 : 0, ntw = (q0 - first) / 64 + 1;
      run_tiles(c, dma, NPROJ, NPROJ, ntw, [=](int i) { return first + i * 64; },
          [=](f32x16& p0, f32x16& p1, int i) {
              const int d0 = first + i * 64 + 4 * hi - t;
#pragma unroll
              for (int r = 0; r < 16; ++r) { const int d = d0 + (r & 3) + 8 * (r >> 2); p0[r] = (d <= 0 && d > -512) ? p0[r] + slope * (float)d : -INFINITY; p1[r] = (d + 32 <= 0 && d + 32 > -512) ? p1[r] + slope * (float)(d + 32) : -INFINITY; }
          }, base, wave, lane, r32, hi);
      const float lw = row_l(c);
      scale_o(a0, a1, c, lw > 0.f ? gc_ / lw : 0.f, true, base, wave, r32, hi);
    }
    bf16* ob = F_O + ((size_t)b * S + q0 + wave * 8) * D + (8 + g * 4) * 64;
    store_rows(a0, a1, base, wave, lane, r32, hi, [ob](int r) { return ob + (size_t)(r >> 2) * D + (r & 3) * 64; });
    GA_WAIT_BAR(0);
}
}
__device__ __forceinline__ void attn_phase(Frame& F, int layer) {
    PHASE_IDS;
    constexpr int N_FOX = 2 * 12 * 64, N_NSA = 2 * 2 * 256, N_MOBA = 2 * 8 * 64, N_MEM = 2 * 4 * 64, N_ALL = N_FOX + N_NSA + N_MOBA + N_MEM;
    for (;;) {
        if (tid == 0) F.MISC[0] = __hip_atomic_fetch_add(F.ctl + CW_Q + 64 * layer, 1u, RLX_AGENT);
        __syncthreads();
        int it = (int)F.MISC[0];
        __syncthreads();
        if (it >= N_ALL) break;
        if (it < N_FOX) { const int qb = 63 - it / 24, bh = it % 24; ga::fox_unit(F, bh / 12, bh % 12, qb); continue; } it -= N_FOX;
        if (it < N_NSA) { const int qblk = 255 - it / 4, bg = it % 4; ga::nsa_unit(F, bg >> 1, bg & 1, qblk); continue; } it -= N_NSA;
        if (it < N_MOBA) { const int own = 63 - it / 16, bh = it % 16; ga::moba_unit(F, bh >> 3, bh & 7, own); continue; } it -= N_MOBA;
        { const int qb = it / 8, bh = it % 8; ga::mem_unit(F, layer, bh >> 2, bh & 3, qb); }
    }
}

__device__ __forceinline__ bool in_range(int lo, int hi, int k) { asm volatile("" : "+s"(lo), "+s"(hi), "+s"(k)); return lo <= k && k < hi; }
constexpr int N_STEPS = 1 + NLAYER * 12;
template <int PH> __device__ __forceinline__ void run_phase(Frame& F, const Args& args, int l, int half) {
    unsigned char* ws_ = args.ws; asm volatile("" : "+s"(ws_));
    if constexpr (PH == 0) { p0_prologue(F); }
    if constexpr (PH == 1) {
        pg8::Gemm g{F_HB, F_WIN + (size_t)l * NPROJ * D, M, NPROJ, D}; pg8::StaticOrder So; So.init(M, NPROJ, F.G, (int)blockIdx.x);
        pg8::EpiBf16<0> E{F_PROJ, NPROJ, nullptr, 0, 0, 1.f};
        pg8::gemm_phase<pg8::EpiBf16<0>, pg8::StaticOrder, PG8_ALIGN, PG8_SP2>(F.lds + RING_OFF, g, So, E);
    }
    if constexpr (PH == 2) { prep_phase(F, l); }
    if constexpr (PH == 3) { attn_phase(F, l); }
    if constexpr (PH == 4) {
        pg8::Gemm g{F_O, F_WOUT + (size_t)l * D * D, M, D, D}; pg8::StaticOrder So; So.init(M, D, F.G, (int)blockIdx.x);
        pg8::EpiResF32 E{F_HR, D, ALPHA};
        pg8::gemm_phase<pg8::EpiResF32, pg8::StaticOrder, PG8_ALIGN, PG8_SP2>(F.lds + RING_OFF, g, So, E);
    }
    if constexpr (PH == 5) { ln_phase(F, F_HR, F_IN(11) + (size_t)l * D, F_IN(12) + (size_t)l * D); }
    if constexpr (PH == 6) {
        pg8::Gemm g{F_HB + (size_t)half * MH * D, F_WUP + (size_t)l * NUP * D, MH, NUP, D}; pg8::StaticOrder So; So.init(MH, NUP, F.G, (int)blockIdx.x);
        pg8::EpiBf16<0> E{F_UG, NUP, nullptr, 0, 0, 1.f};
        pg8::gemm_phase<pg8::EpiBf16<0>, pg8::StaticOrder, PG8_ALIGN, PG8_SP2>(F.lds + RING_OFF, g, So, E);
    }
    if constexpr (PH == 7) { act_phase(F, l); }
    if constexpr (PH == 8) {
        pg8::Gemm g{F_ACT, F_WDN + (size_t)l * D * DFF, MH, D, DFF}; pg8::StaticOrder So; So.init(MH, D, F.G, (int)blockIdx.x);
        pg8::EpiResF32 E{F_HR + (size_t)half * MH * D, D, ALPHA};
        pg8::gemm_phase<pg8::EpiResF32, pg8::StaticOrder, PG8_ALIGN, PG8_SP2>(F.lds + RING_OFF, g, So, E);
    }
    if constexpr (PH == 9) { ln_phase(F, F_HR, F_IN(17) + (size_t)l * D, F_IN(18) + (size_t)l * D); }
}
template <int PH> __global__ void __launch_bounds__(NTHR, 2) k_phase(Args args, int l, int half) {
    extern __shared__ __attribute__((aligned(16))) unsigned char lds[];
    Frame F;
    F.lds = (LAS unsigned char*)lds;
    F.MISC = (volatile LAS unsigned*)(F.lds + MISC_OFF);
    F.G = gridDim.x;
    F.A = &args;
    F.ctl = (gu32*)(args.ws + WS_CTL);
    for (int u = threadIdx.x; u < (LDS_BYTES - LDSCTL_OFF) / 4; u += NTHR) ((LAS unsigned*)(F.lds + LDSCTL_OFF))[u] = 0u;
    __syncthreads();
    run_phase<PH>(F, args, l, half);
}

__global__ void __launch_bounds__(NTHR, 2) hybrid_fwd(Args args) {
    extern __shared__ __attribute__((aligned(16))) unsigned char lds[];
    Frame F;
    F.lds = (LAS unsigned char*)lds;
    F.MISC = (volatile LAS unsigned*)(F.lds + MISC_OFF);
    F.G = gridDim.x;
    F.A = &args;
    F.ctl = (gu32*)(args.ws + WS_CTL);
    for (int u = threadIdx.x; u < (LDS_BYTES - LDSCTL_OFF) / 4; u += NTHR) ((LAS unsigned*)(F.lds + LDSCTL_OFF))[u] = 0u;
    __syncthreads();
    XcdBarrier bar = xcd_barrier_post((unsigned*)(F.ctl + CW_BAR), F.MISC + 8);
#define PHASE(PH, l, h) do { run_phase<PH>(F, args, (l), (h)); xcd_barrier(bar); } while (0)
#define LAYER(l) do { PHASE(1, l, 0); PHASE(2, l, 0); PHASE(3, l, 0); PHASE(4, l, 0); PHASE(5, l, 0); \
        PHASE(6, l, 0); PHASE(7, l, 0); PHASE(8, l, 0); PHASE(6, l, 1); PHASE(7, l, 1); PHASE(8, l, 1); } while (0)
    PHASE(0, 0, 0);
    LAYER(0); PHASE(9, 0, 0);
    LAYER(1); run_phase<9>(F, args, 1, 0);
#undef PHASE
#undef LAYER
}

template <int PH> static bool set_lds_one() { return hipFuncSetAttribute((const void*)k_phase<PH>, hipFuncAttributeMaxDynamicSharedMemorySize, LDS_BYTES) == hipSuccess; }
static bool set_lds_all() { return hipFuncSetAttribute((const void*)hybrid_fwd, hipFuncAttributeMaxDynamicSharedMemorySize, LDS_BYTES) == hipSuccess && set_lds_one<0>() && set_lds_one<1>() && set_lds_one<2>() && set_lds_one<3>() && set_lds_one<4>() && set_lds_one<5>() && set_lds_one<6>() && set_lds_one<7>() && set_lds_one<8>() && set_lds_one<9>(); }
extern "C" void kernel_launch(void* const* d_in, const int* in_sizes, int n_in, void* d_out, int out_size, void* d_ws, size_t ws_size, hipStream_t stream) {
    static int grid = 0;
    if (grid == 0) {
        if (n_in != 19 || in_sizes[0] != M * D || out_size != M * D || ws_size < WS_END) { fprintf(stderr, "kernel_launch: unexpected shapes (n_in %d, in0 %d, out %d, ws %zu)\n", n_in, n_in > 0 ? in_sizes[0] : -1, out_size, ws_size); grid = -1; return; }
        int dev = 0, cus = 0;
        if (hipGetDevice(&dev) != hipSuccess || hipDeviceGetAttribute(&cus, hipDeviceAttributeMultiprocessorCount, dev) != hipSuccess) { grid = -1; return; }
        if (!set_lds_all()) { fprintf(stderr, "kernel_launch: hipFuncSetAttribute failed\n"); grid = -1; return; }
        (void)hipGetLastError();
        grid = cus;
    }
    if (grid < 0) return;
    if (hipMemsetAsync((char*)d_ws + WS_CTL, 0, CTL_ZERO_BYTES, stream) != hipSuccess) return;
    Args a{};
    for (int i = 0; i < 19; ++i) a.in[i] = (const float*)d_in[i];
    a.out = (float*)d_out; a.ws = (unsigned char*)d_ws;
#if MK_ONE_LAUNCH
    hipLaunchKernelGGL(hybrid_fwd, dim3(grid), dim3(NTHR), LDS_BYTES, stream, a);
#else
#define LAUNCH(PH, l, h) hipLaunchKernelGGL(k_phase<PH>, dim3(grid), dim3(NTHR), LDS_BYTES, stream, a, (int)(l), (int)(h))
    LAUNCH(0, 0, 0);
    for (int l = 0; l < NLAYER; ++l) {
        LAUNCH(1, l, 0); LAUNCH(2, l, 0); LAUNCH(3, l, 0); LAUNCH(4, l, 0); LAUNCH(5, l, 0);
        for (int h = 0; h < 2; ++h) { LAUNCH(6, l, h); LAUNCH(7, l, h); LAUNCH(8, l, h); }
        LAUNCH(9, l, 0);
    }
#undef LAUNCH
#endif
}
```

```cpp
#include <hip/hip_runtime.h>
#include <cstdio>
#include <cstdint>
namespace pg8 {
#define PG8_LAS __attribute__((address_space(3)))
typedef unsigned short bf16_t;
typedef short bf16x8 __attribute__((ext_vector_type(8)));
typedef float f32x4 __attribute__((ext_vector_type(4)));
typedef unsigned u32x4 __attribute__((ext_vector_type(4)));
constexpr int BM = 256, BK = 64, HALF = 128, HTB = HALF * BK * 2  , STAGE_BYTES = 8 * HTB, NXCD = 8, WGM = 8;

__host__ __device__ __forceinline__ int lds_byte(int r, int c) { const int st = (r >> 4) * 2 + (c >> 5), rr = r & 15, cc = c & 31, ob = rr * 64 + cc * 2; return st * 1024 + (ob ^ (((ob >> 9) & 1) << 5)); }
__host__ __device__ __forceinline__ void stage_rc(int b, int& R, int& C) { const int st = b / 1024, sb = b % 1024, swz = sb ^ (((sb >> 9) & 1) << 5); R = (st >> 1) * 16 + swz / 64; C = (st & 1) * 32 + (swz % 64) / 2; }
__host__ __device__ __forceinline__ int perm32(int rho) { const int n = rho >> 4, i = rho & 15; return 8 * (i >> 2) + 4 * n + (i & 3); }

struct Unit { int pm, pn; };
struct Gemm { const bf16_t* A; const bf16_t* Bt; int M, N, K; int amode; };
__device__ __forceinline__ long a_row0(const Gemm& g, int pm) { return g.amode == 0 ? (long)pm * BM : (long)(pm / 65) * 16384 + (long)(pm % 65) * 254 - 2; }

struct StaticOrder {
    int nM, nN, nwg, G, c;
    __host__ __device__ void init(int M, int N, int G_, int c_) { nM = M / BM; nN = N / BM; nwg = nM * nN; G = G_; c = c_; }
    __host__ __device__ bool next(int i, Unit& u) const {
        const long L = (long)i * G + c; if (L >= nwg) return false;
        int wgid = (int)L; { const int q = nwg / NXCD, r = nwg % NXCD, xcd = wgid % NXCD, off = wgid / NXCD; wgid = (xcd < r ? xcd * (q + 1) : r * (q + 1) + (xcd - r) * q) + off; }
        const int nig = WGM * nN, gid = wgid / nig, fm = gid * WGM, gsz = (nM - fm) < WGM ? (nM - fm) : WGM;
        u.pm = fm + ((wgid % nig) % gsz); u.pn = (wgid % nig) / gsz; return true;
    }
    __device__ __forceinline__ void a_ready(const Unit&) const {}
    __device__ __forceinline__ void done(const Unit&) const {}
};

__device__ __forceinline__ unsigned cvt_pk_bf16(float lo, float hi) { unsigned r; asm volatile("v_cvt_pk_bf16_f32 %0, %1, %2" : "=v"(r) : "v"(lo), "v"(hi)); return r; }
typedef float f32x2 __attribute__((ext_vector_type(2)));
__device__ __forceinline__ f32x2 gelu_pk(f32x2 v) {
    const f32x2 av = __builtin_elementwise_abs(v), d = av * 0.2316418882f + 1.0f;
    f32x2 t; t.x = __builtin_amdgcn_rcpf(d.x); t.y = __builtin_amdgcn_rcpf(d.y);
    f32x2 q = t * 0.5307027145f + (-0.7265760135f); q = q * t + 0.7107068705f; q = q * t + (-0.142248368f); q = q * t + 0.127414796f; q = q * t;
    const f32x2 s = (v * v) * (-0.72134752044f);
    f32x2 e; e.x = __builtin_amdgcn_exp2f(s.x); e.y = __builtin_amdgcn_exp2f(s.y);
    const f32x2 m = v * (q * e), r = v - m;
    f32x2 o; o.x = v.x < 0.f ? m.x : r.x; o.y = v.y < 0.f ? m.y : r.y; return o;
}

template <int ACT  > struct EpiBf16 {
    static constexpr bool PERM = true, AFTER_DRAIN = false; static_assert(ACT == 0 || ACT == 1, "EpiBf16: ACT is 0 (none) or 1 (gelu_pk)");
    bf16_t* O; int ldc; const float* bias; int split_cols; size_t split_stride; float scale0;
    __device__ __forceinline__ void operator()(const f32x4 (&acc)[2][2][4][2], const Unit& u, int wr, int wc, int fr, int fq) const {
        const int row0 = u.pm * BM + wr * 64 + fr; int colt = u.pn * BM; bf16_t* base = O;
        float sc = 1.f; if (split_cols) { const int t = colt / split_cols; base += (size_t)t * split_stride; colt -= t * split_cols; if (t == 0) sc = scale0; }
        const int col0 = colt + wc * 32 + 8 * fq, bcol0 = u.pn * BM + wc * 32 + 8 * fq;
        f32x4 bv[2][2];
#pragma unroll
        for (int bj = 0; bj < 2; ++bj)
#pragma unroll
            for (int n = 0; n < 2; ++n) bv[bj][n] = bias ? *(const f32x4*)(bias + bcol0 + bj * HALF + 4 * n) : (f32x4){0.f, 0.f, 0.f, 0.f};
#pragma unroll
        for (int ai = 0; ai < 2; ++ai)
#pragma unroll
            for (int m = 0; m < 4; ++m) { bf16_t* rowp = base + (size_t)(row0 + ai * HALF + m * 16) * ldc + col0;
#pragma unroll
                for (int bj = 0; bj < 2; ++bj) { f32x4 v0 = acc[ai][bj][m][0] + bv[bj][0], v1 = acc[ai][bj][m][1] + bv[bj][1];
                    if (ACT == 1) { f32x2 a = gelu_pk((f32x2){v0[0], v0[1]}), b = gelu_pk((f32x2){v0[2], v0[3]}), c = gelu_pk((f32x2){v1[0], v1[1]}), d = gelu_pk((f32x2){v1[2], v1[3]});
                        v0 = (f32x4){a.x, a.y, b.x, b.y}; v1 = (f32x4){c.x, c.y, d.x, d.y}; }
                    v0 = v0 * sc; v1 = v1 * sc; u32x4 w; w.x = cvt_pk_bf16(v0[0], v0[1]); w.y = cvt_pk_bf16(v0[2], v0[3]); w.z = cvt_pk_bf16(v1[0], v1[1]); w.w = cvt_pk_bf16(v1[2], v1[3]);
                    *(u32x4*)(rowp + bj * HALF) = w; } }
    }
};


struct EpiResF32 {
    static constexpr bool PERM = false, AFTER_DRAIN = false;
    float* out; int ldc; float alpha;
    __device__ __forceinline__ void operator()(const f32x4 (&acc)[2][2][4][2], const Unit& u, int wr, int wc, int fr, int fq) const {
        const int col0 = u.pn * BM + wc * 32 + 4 * fq;
#pragma unroll
        for (int ai = 0; ai < 2; ++ai)
#pragma unroll
            for (int m = 0; m < 4; ++m) { float* rowp = out + (size_t)(u.pm * BM + ai * HALF + wr * 64 + m * 16 + fr) * ldc + col0;
#pragma unroll
                for (int bj = 0; bj < 2; ++bj)
#pragma unroll
                    for (int n = 0; n < 2; ++n) { f32x4* p = (f32x4*)(rowp + bj * HALF + n * 16); const f32x4 b = *p; *p = b * alpha + acc[ai][bj][m][n]; }
                asm volatile("" ::: "memory"); }
    }
};

template <int C> __device__ __forceinline__ f32x4 ror4(const f32x4 v) { f32x4 r;
#pragma unroll
    for (int i = 0; i < 4; ++i) r[i] = __int_as_float(__builtin_amdgcn_update_dpp(0, __float_as_int(v[i]), C, 0xF, 0xF, true));
    return r; }
struct EpiConvAct {
    static constexpr bool PERM = true, AFTER_DRAIN = false;
    bf16_t* O; int ldc; const float* cw; const float* cb; int dff; PG8_LAS float* xb;
    __device__ __forceinline__ static float gelu_t(float x) { const float y = 0.7978845608028654f * (x + 0.044715f * x * x * x); const float e = __builtin_amdgcn_exp2f(y * 2.885390081777927f); return 0.5f * x * (2.0f - 2.0f * __builtin_amdgcn_rcpf(e + 1.0f)); }
    __device__ __forceinline__ void operator()(const f32x4 (&acc)[2][2][4][2], const Unit& u, int wr, int wc, int fr, int fq) const {
        if (fr >= 14) {
#pragma unroll
            for (int ai = 0; ai < 2; ++ai)
#pragma unroll
                for (int n = 0; n < 2; ++n) *(PG8_LAS f32x4*)(xb + ((((ai * 2 + wr) * 4 + wc) * 2 + (fr - 14)) * 4 + fq) * 8 + n * 4) = acc[ai][1][3][n];
        }
        asm volatile("s_waitcnt lgkmcnt(0)" ::: "memory"); __builtin_amdgcn_s_barrier(); asm volatile("" ::: "memory");
        const int seq = u.pm / 65, kt = u.pm % 65; const int tbase = kt * 254 - 2 + wr * 64 + fr;
        const int c0 = u.pn * 128 + wc * 32 + 8 * fq;
        f32x4 w0[2], w1[2], w2[2], bb[2];
#pragma unroll
        for (int n = 0; n < 2; ++n) { w0[n] = *(const f32x4*)(cw + c0 + 4 * n); w1[n] = *(const f32x4*)(cw + dff + c0 + 4 * n); w2[n] = *(const f32x4*)(cw + 2 * dff + c0 + 4 * n); bb[n] = *(const f32x4*)(cb + c0 + 4 * n); }
#pragma unroll
        for (int ai = 0; ai < 2; ++ai) {
            f32x4 gp[2];
            const int pai = wr == 1 ? ai : ai - 1, pwr = wr ^ 1;
#pragma unroll
            for (int n = 0; n < 2; ++n) gp[n] = (fr >= 14 && pai >= 0) ? *(const PG8_LAS f32x4*)(xb + ((((pai * 2 + pwr) * 4 + wc) * 2 + (fr - 14)) * 4 + fq) * 8 + n * 4) : (f32x4){0.f, 0.f, 0.f, 0.f};
#pragma unroll
            for (int m = 0; m < 4; ++m) {
                const int trow = ai * 128 + wr * 64 + m * 16 + fr, t = tbase + ai * 128 + m * 16;
                unsigned pk[4];
#pragma unroll
                for (int n = 0; n < 2; ++n) {
                    const f32x4 g0 = acc[ai][1][m][n], gm = m == 0 ? gp[n] : acc[ai][1][m - 1][n];
                    const f32x4 a1 = ror4<0x121>(g0), b1 = ror4<0x121>(gm), a2 = ror4<0x122>(g0), b2 = ror4<0x122>(gm);
                    f32x4 p1 = fr >= 1 ? a1 : b1, p2 = fr >= 2 ? a2 : b2;
                    if (t < 1) p1 = (f32x4){0.f, 0.f, 0.f, 0.f};
                    if (t < 2) p2 = (f32x4){0.f, 0.f, 0.f, 0.f};
                    const f32x4 x = bb[n] + w0[n] * p2 + w1[n] * p1 + w2[n] * g0; const f32x4 uu = acc[ai][0][m][n];
                    pk[2 * n] = cvt_pk_bf16(gelu_t(x[0]) * uu[0], gelu_t(x[1]) * uu[1]); pk[2 * n + 1] = cvt_pk_bf16(gelu_t(x[2]) * uu[2], gelu_t(x[3]) * uu[3]);
                }
                if (trow >= 2 && t < 16384) { u32x4 w; w.x = pk[0]; w.y = pk[1]; w.z = pk[2]; w.w = pk[3]; *(u32x4*)(O + ((size_t)seq * 16384 + t) * ldc + c0) = w; }
            }
        }
        asm volatile("s_waitcnt lgkmcnt(0)" ::: "memory"); __builtin_amdgcn_s_barrier(); asm volatile("" ::: "memory");
    }
};
template <class Epi, class Sched, bool ALIGN_EPI = false, bool SP2 = false>
__device__ __forceinline__ void gemm_phase(PG8_LAS unsigned char* lds, const Gemm g, const Sched& S, const Epi& E) {
    int tid_ = threadIdx.x; asm volatile("" : "+v"(tid_));
    const int tid = tid_, wid = __builtin_amdgcn_readfirstlane(tid >> 6), lane = tid & 63, wr = wid >> 2, wc = wid & 3, fr = lane & 15, fq = lane >> 4;
    const int K = g.K, nt = K / BK;
    unsigned voffA[2], voffB[2];
#pragma unroll
    for (int i = 0; i < 2; ++i) { int R, C; stage_rc(tid * 16 + i * 8192, R, C); const int Rb = Epi::PERM ? ((R & ~31) + perm32(R & 31)) : R;
        voffA[i] = (unsigned)(R * K + C) * 2u; voffB[i] = (unsigned)(Rb * K + C) * 2u; }
    const size_t kstep = (size_t)(BK * 2);
    const size_t hstep = (size_t)HALF * K * 2;
    const size_t tstep = 2 * hstep;
    const unsigned ldsw = (unsigned)wid * 1024u;
    const int aoff = lds_byte(wr * 64 + fr, fq * 8), boff = lds_byte(wc * 32 + fr, fq * 8);
#define PG8_SA(b, h) (((b) * 2 + (h)) * HTB)
#define PG8_SB(b, h) ((4 + (b) * 2 + (h)) * HTB)
#define PG8_STAGE(bufoff, gbase, voff) do { _Pragma("unroll") for (int _i = 0; _i < 2; ++_i) \
        __builtin_amdgcn_global_load_lds((const unsigned*)((const char*)(gbase) + (voff)[_i]), (PG8_LAS unsigned*)(lds + (bufoff) + ldsw + _i * 8192), 16, 0, 0); } while (0)
#define PG8_LDA(dst, b, h) do { _Pragma("unroll") for (int m = 0; m < 4; ++m) _Pragma("unroll") for (int k = 0; k < 2; ++k) dst[m][k] = *(const PG8_LAS bf16x8*)(lds + PG8_SA(b, h) + aoff + m * 2048 + k * 1024); } while (0)
#define PG8_LDB(dst, b, h) do { _Pragma("unroll") for (int n = 0; n < 2; ++n) _Pragma("unroll") for (int k = 0; k < 2; ++k) dst[n][k] = *(const PG8_LAS bf16x8*)(lds + PG8_SB(b, h) + boff + n * 2048 + k * 1024); } while (0)
#define PG8_MMA(ai, bj, At, Bt) do { __builtin_amdgcn_s_setprio(1); _Pragma("unroll") for (int m = 0; m < 4; ++m) _Pragma("unroll") for (int n = 0; n < 2; ++n) _Pragma("unroll") for (int k = 0; k < 2; ++k) \
        acc[ai][bj][m][n] = __builtin_amdgcn_mfma_f32_16x16x32_bf16(Bt[n][k], At[m][k], acc[ai][bj][m][n], 0, 0, 0); __builtin_amdgcn_s_setprio(0); } while (0)
#define PG8_WAIT_V(n) asm volatile("s_waitcnt vmcnt(" #n ")" ::: "memory")
#define PG8_WAIT_L(n) asm volatile("s_waitcnt lgkmcnt(" #n ")" ::: "memory")
#define PG8_BAR __builtin_amdgcn_s_barrier()
#define PG8_SCHED __builtin_amdgcn_sched_barrier(0)
    Unit cur, nxt; int ui = 0;
    if (!S.next(0, cur)) return;
    f32x4 acc[2][2][4][2];
#pragma unroll
    for (int a = 0; a < 2; ++a)
#pragma unroll
        for (int b = 0; b < 2; ++b)
#pragma unroll
            for (int m = 0; m < 4; ++m)
#pragma unroll
                for (int n = 0; n < 2; ++n) acc[a][b][m][n] = (f32x4){0.f, 0.f, 0.f, 0.f};
    bf16x8 At[4][2], B0[2][2], B1[2][2];
    const char* cA = (const char*)g.A + a_row0(g, cur.pm) * (long)(K * 2); const char* cB = (const char*)g.Bt + (size_t)cur.pn * tstep;
    S.a_ready(cur);
    if constexpr (SP2) {
        PG8_STAGE(PG8_SB(0, 0), cB, voffB); PG8_STAGE(PG8_SB(0, 1), cB + hstep, voffB); PG8_STAGE(PG8_SA(0, 0), cA, voffA); PG8_STAGE(PG8_SA(0, 1), cA + hstep, voffA);
        if (wr == 1) PG8_BAR;
        PG8_WAIT_V(2); PG8_BAR;
        PG8_STAGE(PG8_SB(1, 0), cB + kstep, voffB); PG8_STAGE(PG8_SA(1, 0), cA + kstep, voffA); PG8_STAGE(PG8_SB(1, 1), cB + hstep + kstep, voffB);
        PG8_WAIT_V(6); PG8_BAR;
    } else {
        PG8_STAGE(PG8_SB(0, 0), cB, voffB); PG8_STAGE(PG8_SA(0, 0), cA, voffA); PG8_STAGE(PG8_SB(0, 1), cB + hstep, voffB); PG8_STAGE(PG8_SA(0, 1), cA + hstep, voffA);
        if (wr == 1) PG8_BAR;
        PG8_WAIT_V(4); PG8_BAR;
        PG8_STAGE(PG8_SB(1, 0), cB + kstep, voffB); PG8_STAGE(PG8_SA(1, 0), cA + kstep, voffA); PG8_STAGE(PG8_SB(1, 1), cB + hstep + kstep, voffB);
        PG8_WAIT_V(6); PG8_BAR;
    }
    for (;;) {
        const bool has_next = S.next(ui + 1, nxt);
        const char* nA = has_next ? (const char*)g.A + a_row0(g, nxt.pm) * (long)(K * 2) : cA; const char* nB = has_next ? (const char*)g.Bt + (size_t)nxt.pn * tstep : cB;
        for (int t = 0; t < nt; t += 2) {
            const bool last = (t == nt - 2);
            const char* a1 = cA + (size_t)(t + 1) * kstep;
            const char* a2 = last ? nA : cA + (size_t)(t + 2) * kstep; const char* b2 = last ? nB : cB + (size_t)(t + 2) * kstep;
            const char* a3 = a2 + kstep; const char* b3 = b2 + kstep;
            if (last && has_next) S.a_ready(nxt);
            if constexpr (SP2) {
            PG8_LDB(B0, 0, 0); PG8_LDB(B1, 0, 1); PG8_SCHED; PG8_LDA(At, 0, 0); PG8_STAGE(PG8_SA(1, 1), a1 + hstep, voffA);
            PG8_WAIT_V(8); PG8_WAIT_L(0); PG8_BAR; PG8_MMA(0, 0, At, B0); PG8_MMA(0, 1, At, B1); PG8_BAR; PG8_SCHED;
            PG8_LDA(At, 0, 1); PG8_STAGE(PG8_SB(0, 0), b2, voffB); PG8_STAGE(PG8_SB(0, 1), b2 + hstep, voffB); PG8_STAGE(PG8_SA(0, 0), a2, voffA);
            PG8_WAIT_V(8); PG8_WAIT_L(0); PG8_BAR; PG8_MMA(1, 0, At, B0); PG8_MMA(1, 1, At, B1); PG8_BAR; PG8_SCHED;
            PG8_LDB(B0, 1, 0); PG8_LDB(B1, 1, 1); PG8_SCHED; PG8_LDA(At, 1, 0); PG8_STAGE(PG8_SA(0, 1), a2 + hstep, voffA);
            PG8_WAIT_V(8); PG8_WAIT_L(0); PG8_BAR; PG8_MMA(0, 0, At, B0); PG8_MMA(0, 1, At, B1); PG8_BAR; PG8_SCHED;
            PG8_LDA(At, 1, 1); PG8_STAGE(PG8_SB(1, 0), b3, voffB); PG8_STAGE(PG8_SB(1, 1), b3 + hstep, voffB); PG8_STAGE(PG8_SA(1, 0), a3, voffA);
            PG8_WAIT_V(8); PG8_WAIT_L(0); PG8_BAR; PG8_MMA(1, 0, At, B0); PG8_MMA(1, 1, At, B1); PG8_BAR; PG8_SCHED;
            } else {
            PG8_LDB(B0, 0, 0); PG8_SCHED; PG8_LDA(At, 0, 0); PG8_STAGE(PG8_SA(1, 1), a1 + hstep, voffA);
            PG8_WAIT_L(8); PG8_BAR; PG8_WAIT_L(0); PG8_MMA(0, 0, At, B0); PG8_BAR; PG8_SCHED;
            PG8_LDB(B1, 0, 1); PG8_STAGE(PG8_SB(0, 0), b2, voffB);
            PG8_BAR; PG8_WAIT_L(0); PG8_MMA(0, 1, At, B1); PG8_BAR;
            PG8_LDA(At, 0, 1); PG8_STAGE(PG8_SA(0, 0), a2, voffA);
            PG8_BAR; PG8_WAIT_L(0); PG8_MMA(1, 0, At, B0); PG8_BAR; PG8_SCHED;
            PG8_STAGE(PG8_SB(0, 1), b2 + hstep, voffB);
            PG8_WAIT_V(6); PG8_BAR; PG8_MMA(1, 1, At, B1); PG8_BAR;
            PG8_LDB(B0, 1, 0); PG8_SCHED; PG8_LDA(At, 1, 0); PG8_STAGE(PG8_SA(0, 1), a2 + hstep, voffA);
            PG8_WAIT_L(8); PG8_BAR; PG8_WAIT_L(0); PG8_MMA(0, 0, At, B0); PG8_BAR; PG8_SCHED;
            PG8_LDB(B1, 1, 1); PG8_STAGE(PG8_SB(1, 0), b3, voffB);
            PG8_BAR; PG8_WAIT_L(0); PG8_MMA(0, 1, At, B1); PG8_BAR;
            PG8_LDA(At, 1, 1); PG8_STAGE(PG8_SA(1, 0), a3, voffA);
            PG8_BAR; PG8_WAIT_L(0); PG8_MMA(1, 0, At, B0); PG8_BAR; PG8_SCHED;
            PG8_STAGE(PG8_SB(1, 1), b3 + hstep, voffB);
            PG8_WAIT_V(6); PG8_BAR; PG8_MMA(1, 1, At, B1); PG8_BAR;
            }
        }
        if constexpr (ALIGN_EPI) { if (wr == 0) PG8_BAR; }
        if constexpr (!Epi::AFTER_DRAIN) { E(acc, cur, wr, wc, fr, fq); S.done(cur); }
        if (!has_next) break;
#pragma unroll
        for (int a = 0; a < 2; ++a)
#pragma unroll
            for (int b = 0; b < 2; ++b)
#pragma unroll
                for (int m = 0; m < 4; ++m)
#pragma unroll
                    for (int n = 0; n < 2; ++n) acc[a][b][m][n] = (f32x4){0.f, 0.f, 0.f, 0.f};
        cur = nxt; cA = nA; cB = nB; ++ui;
        if constexpr (ALIGN_EPI) { if (wr == 1) PG8_BAR; }
    }
    PG8_WAIT_V(0);
    if constexpr (!ALIGN_EPI) { if (wr == 0) PG8_BAR; }
    PG8_BAR;
    if constexpr (Epi::AFTER_DRAIN) { E.fused(acc, cur, wr, wc, fr, fq, lds, wid, lane); S.done(cur); }
#undef PG8_SA
#undef PG8_SB
#undef PG8_STAGE
#undef PG8_LDA
#undef PG8_LDB
#undef PG8_MMA
#undef PG8_WAIT_V
#undef PG8_WAIT_L
#undef PG8_BAR
#undef PG8_SCHED
}
}

#ifndef PG8_SP2
#define PG8_SP2 true
#endif
#ifndef PG8_ALIGN
#define PG8_ALIGN true
#endif
#ifndef MK_ONE_LAUNCH
#define MK_ONE_LAUNCH 1
#endif

constexpr int NWAVES = 8, NTHR = NWAVES * 64;
constexpr int NB = 2, S = 16384, D = 2048, M = NB * S, NLAYER = 2;
constexpr int NPROJ = 5632, NIN = 5412;
constexpr int DFF = 5632, NUP = 2 * DFF;
constexpr int MH = S;
constexpr int C_MQ = 0, C_MK = 512, C_MV = 1024, C_NQ = 1536, C_NKV = 2048, C_FQ = 2816, C_FK = 3584, C_FV = 4352, C_EQ = 5120, C_GATE = 5376, C_FF = 5400;
constexpr float LN_EPS = 1e-5f;
constexpr float ALPHA = 1.41421356237309515f;
constexpr float LOG2E = 1.4426950408889634f;
constexpr float C2 = 0.125f * LOG2E;
constexpr int NCMP = 1023, NCMP_PAD = 1024;

constexpr size_t MiB = 1u << 20;
constexpr size_t WS_CTL = 0, CTL_ZERO_BYTES = 1 * MiB;
constexpr size_t WS_WIN = 1 * MiB, WS_WOUT = 45 * MiB, WS_WUP = 61 * MiB, WS_WDN = 149 * MiB;
constexpr size_t WS_HB = 193 * MiB;
constexpr size_t WS_R = 321 * MiB;
constexpr size_t WS_PROJ = WS_R, WS_O = WS_R + 352 * MiB, WS_UG = WS_R, WS_ACT = WS_R;
constexpr size_t WS_KCMP = 849 * MiB;
constexpr size_t WS_MEMKV = 851 * MiB;
constexpr size_t WS_KMEAN = 853 * MiB;
constexpr size_t WS_FOXC = 854 * MiB;
constexpr size_t WS_MEMKVB = 857 * MiB;
constexpr size_t WS_KMEANB = 858 * MiB;
constexpr size_t WS_KCMPB = 859 * MiB;
constexpr size_t WS_PART = 864 * MiB;
constexpr size_t WS_LSE = 992 * MiB;
constexpr size_t WS_MSEL = 996 * MiB;
constexpr size_t WS_END = 1000 * MiB;
constexpr int CW_TMO = 0, CW_CODE = 1, CW_BAR = 4096, CW_Q = 8192;

constexpr int RING_OFF = 0, RING_BYTES = 131072;
constexpr int LDSCTL_OFF = 146432, MISC_OFF = LDSCTL_OFF + 320;
constexpr int SEL_OFF = RING_BYTES + 1024;
constexpr int XB_OFF = RING_BYTES;
constexpr int LDS_BYTES = 147456;

#define GAS __attribute__((address_space(1)))
#define LAS __attribute__((address_space(3)))
typedef unsigned short bf16;
typedef unsigned v4u __attribute__((ext_vector_type(4)));
typedef float f32x4 __attribute__((ext_vector_type(4)));
typedef GAS unsigned gu32;
#define RLX_AGENT __ATOMIC_RELAXED, __HIP_MEMORY_SCOPE_AGENT
#define LDS_WAIT() asm volatile("s_waitcnt lgkmcnt(0)" ::: "memory")
__device__ __forceinline__ unsigned f2bf(float f) { unsigned u = __builtin_bit_cast(unsigned, f); return (u + 0x7fffu + ((u >> 16) & 1u)) >> 16; }
__device__ __forceinline__ unsigned pk2(float lo, float hi) { return f2bf(lo) | (f2bf(hi) << 16); }
__device__ __forceinline__ float blo(unsigned u) { return __uint_as_float(u << 16); }
__device__ __forceinline__ float bhi(unsigned u) { return __uint_as_float(u & 0xffff0000u); }
__device__ __forceinline__ float bf2f(bf16 v) { return __uint_as_float((unsigned)v << 16); }
__device__ __forceinline__ float ex2(float x) { return __builtin_amdgcn_exp2f(x); }
__device__ __forceinline__ float gelu_tanh(float x) {
    const float y = 0.7978845608028654f * (x + 0.044715f * x * x * x);
    const float e = __expf(2.0f * y);
    const float th = 1.0f - 2.0f / (e + 1.0f);
    return 0.5f * x * (1.0f + th);
}
#define XB_TMO      128
#define XB_XCNT(j)  (256  + 64 * (j))
#define XB_XSUB(j)  (1280 + 64 * (j))
#define XB_XGEN(j)  (2304 + 64 * (j))
#define XB_TOP      3328
#define XB_TOPGEN   3392
#define XCD_BAR_WORDS 3456
#define XB_SPIN_CAP (1u << 18)

__device__ __forceinline__ unsigned xb_ld(unsigned* p)              { return __hip_atomic_load(p, __ATOMIC_RELAXED, __HIP_MEMORY_SCOPE_AGENT); }
__device__ __forceinline__ unsigned xb_add(unsigned* p, unsigned v) { return __hip_atomic_fetch_add(p, v, __ATOMIC_RELAXED, __HIP_MEMORY_SCOPE_AGENT); }
__device__ __forceinline__ unsigned xb_xcc_id() { return (unsigned)__builtin_amdgcn_s_getreg((3 << 11) | 20) & 0xFu; }
#define XB_SPIN(cond, bar) do { unsigned _sp = 0; while (cond) { __builtin_amdgcn_s_sleep(1); \
    if ((++_sp & 255u) == 0u) { if (xb_ld(&(bar)[XB_TMO])) break; if (_sp > XB_SPIN_CAP) { atomicAdd(&(bar)[XB_TMO], 1u); break; } } } } while (0)

struct XcdBarrier {
    unsigned* bar; unsigned x;
    volatile LAS unsigned* st;
};

__device__ __forceinline__ XcdBarrier xcd_barrier_post(unsigned* bar, volatile LAS unsigned* st) {
    XcdBarrier b; b.bar = bar; b.x = xb_xcc_id(); b.st = st;
    if (threadIdx.x == 0) (void)xb_add(&bar[XB_XCNT(b.x)], 1u);
    return b;
}
__device__ __forceinline__ void xcd_barrier_complete(unsigned* bar, unsigned x, unsigned& nloc, unsigned& nx) {
    const unsigned G = gridDim.x * gridDim.y * gridDim.z;
    unsigned sum, cnt, mine, sp = 0u;
    for (;;) {
        sum = 0u; cnt = 0u; mine = 0u;
#pragma unroll
        for (unsigned j = 0; j < 16; ++j) { const unsigned c = xb_ld(&bar[XB_XCNT(j)]); sum += c; cnt += (c > 0u) ? 1u : 0u; mine = (j == x) ? c : mine; }
        if (sum == G) break;
        __builtin_amdgcn_s_sleep(1);
        if ((++sp & 255u) == 0u) { if (xb_ld(&bar[XB_TMO])) break; if (sp > XB_SPIN_CAP) { atomicAdd(&bar[XB_TMO], 1u); break; } }
    }
    nloc = mine > 0u ? mine : 1u; nx = cnt > 0u ? cnt : 1u;
}

__device__ __forceinline__ void xcd_barrier(const XcdBarrier& b) {
    asm volatile("s_waitcnt vmcnt(0)" ::: "memory");
    __syncthreads();
    if (threadIdx.x == 0) {
        unsigned* bar = b.bar;
        __builtin_amdgcn_s_waitcnt(0);
        unsigned nloc = b.st[0], nx = b.st[1];
        if (nloc == 0u) { xcd_barrier_complete(bar, b.x, nloc, nx); b.st[0] = nloc; b.st[1] = nx; }
        const unsigned old = xb_add(&bar[XB_XSUB(b.x)], 1u);
        const unsigned gen = old / nloc;
        if (old + 1u == (gen + 1u) * nloc) {
            __builtin_amdgcn_fence(__ATOMIC_RELEASE, "agent");
            asm volatile("s_waitcnt vmcnt(0)" ::: "memory");
            const unsigned og = xb_add(&bar[XB_TOP], 1u);
            const unsigned tg = og / nx;
            if (og + 1u == (tg + 1u) * nx) xb_add(&bar[XB_TOPGEN], 1u);
            else XB_SPIN(xb_ld(&bar[XB_TOPGEN]) == tg, bar);
            __builtin_amdgcn_fence(__ATOMIC_ACQUIRE, "agent");
            xb_add(&bar[XB_XGEN(b.x)], 1u);
            asm volatile("s_waitcnt vmcnt(0)" ::: "memory");
        } else {
            XB_SPIN(xb_ld(&bar[XB_XGEN(b.x)]) == gen, bar);
            __builtin_amdgcn_fence(__ATOMIC_ACQUIRE, "agent");
            asm volatile("s_waitcnt vmcnt(0)" ::: "memory");
        }
    }
    __syncthreads();
}

struct Args { const float* in[19]; float* out; unsigned char* ws; int ph_lo, ph_hi; };
struct Frame {
    LAS unsigned char* lds;
    volatile LAS unsigned* MISC;
    gu32* ctl;
    int G;
    const Args* A;
};
#define PHASE_IDS int tid_ = threadIdx.x; asm volatile("" : "+v"(tid_)); const int tid = tid_, lane = tid & 63, wave = __builtin_amdgcn_readfirstlane(tid >> 6); (void)lane; (void)wave; unsigned char* ws_ = F.A->ws; asm volatile("" : "+s"(ws_))
#define F_IN(i) (F.A->in[i])
#define F_HR (F.A->out)
#define F_WIN ((bf16*)(ws_ + WS_WIN))
#define F_WOUT ((bf16*)(ws_ + WS_WOUT))
#define F_WUP ((bf16*)(ws_ + WS_WUP))
#define F_WDN ((bf16*)(ws_ + WS_WDN))
#define F_HB ((bf16*)(ws_ + WS_HB))
#define F_PROJ ((bf16*)(ws_ + WS_PROJ))
#define F_O ((bf16*)(ws_ + WS_O))
#define F_UG ((bf16*)(ws_ + WS_UG))
#define F_ACT ((bf16*)(ws_ + WS_ACT))
#define F_KCMP ((float*)(ws_ + WS_KCMP))
#define F_MEMKV ((float*)(ws_ + WS_MEMKV))
#define F_KMEAN ((float*)(ws_ + WS_KMEAN))
#define F_FOXC ((double*)(ws_ + WS_FOXC))
#define F_MEMKVB ((bf16*)(ws_ + WS_MEMKVB))
#define F_KMEANB ((bf16*)(ws_ + WS_KMEANB))
#define F_KCMPB ((bf16*)(ws_ + WS_KCMPB))
#define F_PART ((bf16*)(ws_ + WS_PART))
#define F_LSE ((float*)(ws_ + WS_LSE))
#define F_MSEL ((unsigned*)(ws_ + WS_MSEL))
__device__ __forceinline__ float wave_sum(float v) {
#pragma unroll
    for (int o = 1; o < 64; o <<= 1) v += __shfl_xor(v, o);
    return v;
}
template <bool UPMAP = false>
__device__ __forceinline__ void p0_transpose_item(const float* W, int K, int N, bf16* WT, LAS float* scr, int item, int lane) {
    const int nblk = N / 32, kb = item / nblk, nb = item % nblk, k0 = 64 * kb, n0 = 32 * nb;
    const int s0 = UPMAP ? ((n0 >> 7) & 1) * (N / 2) + (n0 >> 8) * 128 + (n0 & 127) : n0;
#pragma unroll 8
    for (int i = 0; i < 32; ++i) { const int kk = 2 * i + (lane >> 5); scr[kk * 33 + (lane & 31)] = W[(size_t)(k0 + kk) * N + s0 + (lane & 31)]; }
    LDS_WAIT(); asm volatile("" ::: "memory");
    const int c = lane & 7;
#pragma unroll
    for (int j = 0; j < 4; ++j) { const int n = (lane >> 3) + 8 * j; const LAS float* s = scr + (8 * c) * 33 + n;
        v4u o; o.x = pk2(s[0 * 33], s[1 * 33]); o.y = pk2(s[2 * 33], s[3 * 33]); o.z = pk2(s[4 * 33], s[5 * 33]); o.w = pk2(s[6 * 33], s[7 * 33]);
        *(GAS v4u*)(WT + (size_t)(n0 + n) * K + k0 + 8 * c) = o; }
    LDS_WAIT(); asm volatile("" ::: "memory");
}
__device__ __forceinline__ int in_src(int n) { return n < 2816 ? n : n < 5120 ? n + 24 : n < 5376 ? n + 36 : n < 5400 ? n - 5376 + 2816 : n < 5412 ? n - 5400 + 5144 : -1; }
__device__ __forceinline__ float in_scale(int n) { return (n < 512 || (n >= 1536 && n < 2048) || (n >= 2816 && n < 3584) || (n >= 5120 && n < 5376)) ? C2 : 1.0f; }
__device__ __forceinline__ void p0_transpose_in(const float* W, bf16* WT, LAS float* scr, int item, int lane) {
    constexpr int K = D, nblk = NPROJ / 32; const int kb = item / nblk, nb = item % nblk, k0 = 64 * kb, n0 = 32 * nb;
    const int sc = in_src(n0 + (lane & 31)); const float fs = in_scale(n0 + (lane & 31));
#pragma unroll 8
    for (int i = 0; i < 32; ++i) { const int kk = 2 * i + (lane >> 5); scr[kk * 33 + (lane & 31)] = sc >= 0 ? W[(size_t)(k0 + kk) * NIN + sc] * fs : 0.0f; }
    LDS_WAIT(); asm volatile("" ::: "memory");
    const int c = lane & 7;
#pragma unroll
    for (int j = 0; j < 4; ++j) { const int n = (lane >> 3) + 8 * j; const LAS float* s = scr + (8 * c) * 33 + n;
        v4u o; o.x = pk2(s[0 * 33], s[1 * 33]); o.y = pk2(s[2 * 33], s[3 * 33]); o.z = pk2(s[4 * 33], s[5 * 33]); o.w = pk2(s[6 * 33], s[7 * 33]);
        *(GAS v4u*)(WT + (size_t)(n0 + n) * K + k0 + 8 * c) = o; }
    LDS_WAIT(); asm volatile("" ::: "memory");
}
__device__ __forceinline__ void ln_row(const float* src, const float* g, const float* bt, float* dstf, bf16* dstb, int lane) {
    const f32x4* xr = (const f32x4*)src + lane;
    f32x4 v[8]; float s = 0.f;
#pragma unroll
    for (int j = 0; j < 8; ++j) { v[j] = xr[64 * j]; s += (v[j].x + v[j].y) + (v[j].z + v[j].w); }
    const float mean = wave_sum(s) * (1.f / D); float s2 = 0.f;
#pragma unroll
    for (int j = 0; j < 8; ++j) { v[j] = v[j] - mean; s2 += (v[j].x * v[j].x + v[j].y * v[j].y) + (v[j].z * v[j].z + v[j].w * v[j].w); }
    const float rstd = 1.f / sqrtf(wave_sum(s2) * (1.f / D) + LN_EPS);
    f32x4* of = (f32x4*)dstf + lane; uint2* ob = (uint2*)dstb + lane;
#pragma unroll
    for (int j = 0; j < 8; ++j) { const f32x4 gg = ((const f32x4*)g)[lane + 64 * j], bb = ((const f32x4*)bt)[lane + 64 * j]; const f32x4 y = v[j] * rstd * gg + bb;
        of[64 * j] = y; ob[64 * j] = make_uint2(pk2(y.x, y.y), pk2(y.z, y.w)); }
}
__device__ __forceinline__ void ln_phase(Frame& F, const float* src, const float* g, const float* bt) {
    PHASE_IDS;
    const int gw = blockIdx.x * NWAVES + wave, NGW = F.G * NWAVES;
    for (int m = gw; m < M; m += NGW) ln_row(src + (size_t)m * D, g, bt, F_HR + (size_t)m * D, F_HB + (size_t)m * D, lane);
}
__device__ __forceinline__ void p0_prologue(Frame& F) {
    PHASE_IDS;
    LAS float* scr = (LAS float*)(F.lds + RING_OFF + wave * 16384);
    const int gw = blockIdx.x * NWAVES + wave, NGW = F.G * NWAVES;
    constexpr int I_IN = (D / 64) * (NPROJ / 32), I_OUT = (D / 64) * (D / 32), I_UP = (D / 64) * (NUP / 32), I_DN = (DFF / 64) * (D / 32), I_L = I_IN + I_OUT + I_UP + I_DN;
    for (int it = gw; it < NLAYER * I_L; it += NGW) {
        const int l = it / I_L; int r = it % I_L;
        if (r < I_IN) { p0_transpose_in(F_IN(4) + (size_t)l * D * NIN, F_WIN + (size_t)l * NPROJ * D, scr, r, lane); continue; } r -= I_IN;
        if (r < I_OUT) { p0_transpose_item(F_IN(10) + (size_t)l * D * D, D, D, F_WOUT + (size_t)l * D * D, scr, r, lane); continue; } r -= I_OUT;
        if (r < I_UP) { p0_transpose_item<true>(F_IN(13) + (size_t)l * D * NUP, D, NUP, F_WUP + (size_t)l * NUP * D, scr, r, lane); continue; } r -= I_UP;
        p0_transpose_item(F_IN(16) + (size_t)l * DFF * D, DFF, D, F_WDN + (size_t)l * D * DFF, scr, r, lane);
    }
    ln_phase(F, F_IN(0), F_IN(2), F_IN(3));
    for (int o = blockIdx.x * NTHR + tid; o < NLAYER * 512 * 512; o += F.G * NTHR) {
        const int c = o & 511, r = (o >> 9) & 511, l = o >> 18;
        const float* mr = F_IN(1) + (size_t)r * D; const float* w = F_IN(6) + (size_t)l * D * 512 + c; float a = 0.f;
        for (int k = 0; k < D; ++k) a += mr[k] * w[(size_t)k * 512];
        F_MEMKV[o] = a; F_MEMKVB[o] = (bf16)f2bf(a);
    }
}

__device__ __forceinline__ void load_q64(unsigned (&q)[32], const bf16* p) {
    const uint4* p4 = (const uint4*)p;
#pragma unroll
    for (int c = 0; c < 8; ++c) { const uint4 w = p4[c]; q[4 * c] = w.x; q[4 * c + 1] = w.y; q[4 * c + 2] = w.z; q[4 * c + 3] = w.w; }
}
__device__ __forceinline__ float dot64(const unsigned (&q)[32], const bf16* kp) {
    const uint4* p = (const uint4*)kp; float s0 = 0.f, s1 = 0.f;
#pragma unroll
    for (int c = 0; c < 8; ++c) { const uint4 w = p[c];
        s0 += blo(q[4 * c]) * blo(w.x) + blo(q[4 * c + 1]) * blo(w.y) + blo(q[4 * c + 2]) * blo(w.z) + blo(q[4 * c + 3]) * blo(w.w);
        s1 += bhi(q[4 * c]) * bhi(w.x) + bhi(q[4 * c + 1]) * bhi(w.y) + bhi(q[4 * c + 2]) * bhi(w.z) + bhi(q[4 * c + 3]) * bhi(w.w); if ((c & 3) == 3) asm volatile("" ::: "memory"); }
    return s0 + s1;
}
__device__ __forceinline__ float dot64f(const unsigned (&q)[32], const float* kp) {
    const f32x4* p = (const f32x4*)kp; float s0 = 0.f, s1 = 0.f;
#pragma unroll
    for (int c = 0; c < 16; ++c) { const f32x4 w = p[c]; s0 += blo(q[2 * c]) * w.x + blo(q[2 * c + 1]) * w.z; s1 += bhi(q[2 * c]) * w.y + bhi(q[2 * c + 1]) * w.w; if ((c & 3) == 3) asm volatile("" ::: "memory"); }
    return s0 + s1;
}
__device__ __forceinline__ void axpy64(float (&o)[64], float f, float p, const bf16* vp) {
    const uint4* p4 = (const uint4*)vp;
#pragma unroll
    for (int c = 0; c < 8; ++c) { const uint4 w = p4[c];
        o[8 * c] = o[8 * c] * f + p * blo(w.x); o[8 * c + 1] = o[8 * c + 1] * f + p * bhi(w.x); o[8 * c + 2] = o[8 * c + 2] * f + p * blo(w.y); o[8 * c + 3] = o[8 * c + 3] * f + p * bhi(w.y);
        o[8 * c + 4] = o[8 * c + 4] * f + p * blo(w.z); o[8 * c + 5] = o[8 * c + 5] * f + p * bhi(w.z); o[8 * c + 6] = o[8 * c + 6] * f + p * blo(w.w); o[8 * c + 7] = o[8 * c + 7] * f + p * bhi(w.w); if ((c & 3) == 3) asm volatile("" ::: "memory"); }
}
__device__ __forceinline__ void axpy64f(float (&o)[64], float f, float p, const float* vp) {
    const f32x4* p4 = (const f32x4*)vp;
#pragma unroll
    for (int c = 0; c < 16; ++c) { const f32x4 w = p4[c]; o[4 * c] = o[4 * c] * f + p * w.x; o[4 * c + 1] = o[4 * c + 1] * f + p * w.y; o[4 * c + 2] = o[4 * c + 2] * f + p * w.z; o[4 * c + 3] = o[4 * c + 3] * f + p * w.w; if ((c & 3) == 3) asm volatile("" ::: "memory"); }
}
#define KEY_STEP(sv, vptr) do { const float mn_ = fmaxf(m, (sv)); const float f_ = ex2(m - mn_), p_ = ex2((sv) - mn_); l = l * f_ + p_; axpy64(o, f_, p_, (vptr)); m = mn_; } while (0)
#define KEY_STEPF(sv, vptr) do { const float mn_ = fmaxf(m, (sv)); const float f_ = ex2(m - mn_), p_ = ex2((sv) - mn_); l = l * f_ + p_; axpy64f(o, f_, p_, (vptr)); m = mn_; } while (0)
__device__ __forceinline__ void store_o64(bf16* op, const float (&o)[64], float sc) {
    uint4* p4 = (uint4*)op;
#pragma unroll
    for (int c = 0; c < 8; ++c) { uint4 w; w.x = pk2(o[8 * c] * sc, o[8 * c + 1] * sc); w.y = pk2(o[8 * c + 2] * sc, o[8 * c + 3] * sc); w.z = pk2(o[8 * c + 4] * sc, o[8 * c + 5] * sc); w.w = pk2(o[8 * c + 6] * sc, o[8 * c + 7] * sc); p4[c] = w; }
}
#define UNI(x) __builtin_amdgcn_readfirstlane(x)

__device__ __forceinline__ void fox_item_naive(Frame& F, int b, int h, int qblk) {
    PHASE_IDS;
    const int t = qblk * 512 + tid; const size_t row = (size_t)b * S + t;
    unsigned q[32]; load_q64(q, F_PROJ + row * NPROJ + C_FQ + h * 64);
    const double* cc = F_FOXC + (size_t)(b * 12 + h) * S; const double ci = cc[t];
    float m = -INFINITY, l = 0.f; float o[64];
#pragma unroll
    for (int d = 0; d < 64; ++d) o[d] = 0.f;
    const int jmax = UNI(qblk * 512 + wave * 64 + 63);
    const bf16* kb = F_PROJ + (size_t)b * S * NPROJ + C_FK + h * 64; const bf16* vb = F_PROJ + (size_t)b * S * NPROJ + C_FV + h * 64;
    for (int j = 0; j <= jmax; ++j) {
        const float bias = (float)(ci - cc[j]);
        if (j <= t) { const float s = dot64(q, kb + (size_t)j * NPROJ) + bias; KEY_STEP(s, vb + (size_t)j * NPROJ); }
    }
    store_o64(F_O + row * D + (16 + h) * 64, o, 1.0f / l);
}
__device__ __forceinline__ void mem_item_naive(Frame& F, int layer, int b, int h, int qblk) {
    PHASE_IDS;
    const int t = qblk * 512 + tid; const size_t row = (size_t)b * S + t;
    unsigned q[32]; load_q64(q, F_PROJ + row * NPROJ + C_EQ + h * 64);
    float m = -INFINITY, l = 0.f; float o[64];
#pragma unroll
    for (int d = 0; d < 64; ++d) o[d] = 0.f;
    const float* kv = F_MEMKV + (size_t)layer * 512 * 512 + (size_t)b * 256 * 512;
    for (int j = 0; j < 256; ++j) { const float s = dot64f(q, kv + (size_t)j * 512 + h * 64); KEY_STEPF(s, kv + (size_t)j * 512 + 256 + h * 64); }
    store_o64(F_O + row * D + (28 + h) * 64, o, 1.0f / l);
}
__device__ __forceinline__ void moba_item_naive(Frame& F, int b, int h, int qblk) {
    PHASE_IDS;
    const int t = qblk * 512 + tid; const size_t row = (size_t)b * S + t;
    unsigned q[32]; load_q64(q, F_PROJ + row * NPROJ + C_MQ + h * 64);
    const int own = UNI((qblk * 512 + wave * 64) >> 8);
    float g0 = -INFINITY, g1 = -INFINITY, g2 = -INFINITY; int i0 = -1, i1 = -1, i2 = -1;
    const float* km = F_KMEAN + (size_t)(b * 8 + h) * 64 * 64;
    for (int j = 0; j < own; ++j) {
        const float g = dot64f(q, km + j * 64);
        if (g > g0) { g2 = g1; i2 = i1; g1 = g0; i1 = i0; g0 = g; i0 = j; }
        else if (g > g1) { g2 = g1; i2 = i1; g1 = g; i1 = j; }
        else if (g > g2) { g2 = g; i2 = j; }
    }
    const float slope = exp2f(-(float)(h + 1)) * LOG2E;
    float m = -INFINITY, l = 0.f; float o[64];
#pragma unroll
    for (int d = 0; d < 64; ++d) o[d] = 0.f;
    const bf16* kb = F_PROJ + (size_t)b * S * NPROJ + C_MK + h * 64; const bf16* vb = F_PROJ + (size_t)b * S * NPROJ + C_MV + h * 64;
    const int jmax = UNI(qblk * 512 + wave * 64 + 63);
    for (int j = own * 256; j <= jmax; ++j) {
        if (j <= t) { const float s = dot64(q, kb + (size_t)j * NPROJ) - slope * (float)(t - j); KEY_STEP(s, vb + (size_t)j * NPROJ); }
    }
#pragma unroll
    for (int n = 0; n < 3; ++n) {
        const int sb = n == 0 ? i0 : n == 1 ? i1 : i2;
        for (int off = 0; off < 256; ++off) {
            if (sb >= 0) { const int j = sb * 256 + off; const float s = dot64(q, kb + (size_t)j * NPROJ) - slope * (float)(t - j); KEY_STEP(s, vb + (size_t)j * NPROJ); }
        }
    }
    store_o64(F_O + row * D + h * 64, o, 1.0f / l);
}
__device__ __forceinline__ void nsa_item_naive(Frame& F, int b, int g, int qblk) {
    PHASE_IDS;
    const int ql = tid >> 2, hh = tid & 3, h = g * 4 + hh; const int t = qblk * 128 + ql; const size_t row = (size_t)b * S + t;
    LAS float* imp = (LAS float*)(F.lds + RING_OFF) + ql * 256;
    LAS int* selL = (LAS int*)(F.lds + SEL_OFF) + ql * 16;
    LAS float* stash = (LAS float*)(F.lds + RING_OFF) + tid * 64;
    for (int i = tid; i < 128 * 256; i += NTHR) ((LAS float*)(F.lds + RING_OFF))[i] = 0.f;
    __syncthreads();
    unsigned q[32]; load_q64(q, F_PROJ + row * NPROJ + C_NQ + h * 64);
    const float slope = exp2f(-(float)(h + 1)) * LOG2E;
    const float* kc = F_KCMP + (size_t)((0 * 2 + b) * 2 + g) * NCMP_PAD * 64; const float* vc = F_KCMP + (size_t)((1 * 2 + b) * 2 + g) * NCMP_PAD * 64;
    const int tmax = UNI(qblk * 128 + wave * 16 + 15);
    const int ncw = tmax >= 31 ? ((tmax - 31) >> 4) + 1 : 0;
    float m = -INFINITY, l = 0.f;
    for (int n = 0; n < ncw; ++n) {
        const int ce = 16 * n + 31;
        if (ce <= t) { const float s = dot64f(q, kc + n * 64) - slope * (float)(t - ce); const float mn = fmaxf(m, s); l = l * ex2(m - mn) + ex2(s - mn); m = mn; }
    }
    float o[64];
#pragma unroll
    for (int d = 0; d < 64; ++d) o[d] = 0.f;
    const float rl = l > 0.f ? 1.0f / l : 0.f;
    for (int n = 0; n < ncw; ++n) {
        const int ce = 16 * n + 31; float p = 0.f;
        if (ce <= t) { const float s = dot64f(q, kc + n * 64) - slope * (float)(t - ce); p = ex2(s - m) * rl; axpy64f(o, 1.0f, p, vc + n * 64); }
        float p4 = p + __shfl_xor(p, 1); p4 = p4 + __shfl_xor(p4, 2);
        if (hh == 0) { imp[n >> 2] += p4; if ((n & 3) == 3) imp[(n >> 2) + 1] += p4; }
    }
    __syncthreads();
    const int jt = t >> 6;
    if (hh == 0) { imp[0] = 1.0e4f; imp[jt] = 1.0e4f; if (jt >= 1) imp[jt - 1] = 1.0e4f; }
    __syncthreads();
    int nsel = 0;
    for (int i = 0; i < 16; ++i) {
        float best = -1.0f; int bi = -1;
        for (int k = 0; k <= jt; ++k) { const float v = imp[k]; if (v > best) { best = v; bi = k; } }
        if (bi < 0) break;
        __builtin_amdgcn_wave_barrier();
        imp[bi] = -2.0f; selL[i] = bi; nsel = i + 1;
        __builtin_amdgcn_wave_barrier();
    }
    __syncthreads();
    const bf16* gp = F_PROJ + row * NPROJ + C_GATE + h * 3;
    const float ga = 1.0f / (1.0f + __expf(-bf2f(gp[0]))), gb = 1.0f / (1.0f + __expf(-bf2f(gp[1]))), gc = 1.0f / (1.0f + __expf(-bf2f(gp[2])));
#pragma unroll
    for (int d = 0; d < 64; ++d) stash[d] = ga * o[d];
    const bf16* pb = F_PROJ + (size_t)b * S * NPROJ;
    m = -INFINITY; l = 0.f;
#pragma unroll
    for (int d = 0; d < 64; ++d) o[d] = 0.f;
    for (int i = 0; i < 16; ++i) {
        const int blk = i < nsel ? selL[i] : -1;
        for (int off = 0; off < 64; ++off) {
            const int j = blk * 64 + off;
            if (blk >= 0 && j <= t) { const float s = dot64(q, pb + (size_t)j * NPROJ + C_NKV + 2 * 128 + g * 64) - slope * (float)(t - j); KEY_STEP(s, pb + (size_t)j * NPROJ + C_NKV + 3 * 128 + g * 64); }
        }
    }
    { const float sc = l > 0.f ? gb / l : 0.f;
#pragma unroll
      for (int d = 0; d < 64; ++d) stash[d] += sc * o[d]; }
    m = -INFINITY; l = 0.f;
#pragma unroll
    for (int d = 0; d < 64; ++d) o[d] = 0.f;
    const int tmin = UNI(qblk * 128 + wave * 16);
    for (int j = (tmin - 511 > 0 ? tmin - 511 : 0); j <= tmax; ++j) {
        if (j <= t && t - j < 512) { const float s = dot64(q, pb + (size_t)j * NPROJ + C_NKV + 4 * 128 + g * 64) - slope * (float)(t - j); KEY_STEP(s, pb + (size_t)j * NPROJ + C_NKV + 5 * 128 + g * 64); }
    }
    { const float sc = l > 0.f ? gc / l : 0.f;
#pragma unroll
      for (int d = 0; d < 64; ++d) o[d] = stash[d] + sc * o[d]; }
    store_o64(F_O + row * D + (8 + h) * 64, o, 1.0f);
    __syncthreads();
}
__device__ __forceinline__ void cmp_item_naive(Frame& F, int layer, int item) {
    PHASE_IDS;
    const int chunk = item & 127, g = (item >> 7) & 1, b = (item >> 8) & 1, kv = item >> 9; const int n0 = chunk * 8;
    LAS float* X = (LAS float*)(F.lds + RING_OFF);
    LAS float* H = X + 144 * 64;
    const bf16* src = F_PROJ + (size_t)b * S * NPROJ + C_NKV + kv * 128 + g * 64;
    for (int i = tid; i < 144 * 64; i += NTHR) { const int p = 16 * n0 + (i >> 6); X[i] = p < S ? bf2f(src[(size_t)p * NPROJ + (i & 63)]) : 0.f; }
    __syncthreads();
    const int e = tid & 127, sub = tid >> 7;
    const float* w1 = F_IN(8) + (size_t)(layer * 2 + kv) * 32 * 64 * 128; const float* pe = F_IN(7) + (size_t)(layer * 2 + kv) * 32 * 64;
    float a0 = 0.f, a1 = 0.f;
    for (int ld = 0; ld < 2048; ++ld) { const float w = w1[(size_t)ld * 128 + e]; const float pv = pe[ld]; a0 += (X[(2 * sub) * 16 * 64 + ld] + pv) * w; a1 += (X[(2 * sub + 1) * 16 * 64 + ld] + pv) * w; }
    H[(2 * sub) * 128 + e] = gelu_tanh(a0); H[(2 * sub + 1) * 128 + e] = gelu_tanh(a1);
    __syncthreads();
    const int tok = tid >> 6, dd = tid & 63; const float* w2 = F_IN(9) + (size_t)(layer * 2 + kv) * 128 * 64; float a = 0.f;
    for (int k = 0; k < 128; ++k) a += H[tok * 128 + k] * w2[k * 64 + dd];
    { const size_t oi = ((size_t)((kv * 2 + b) * 2 + g) * NCMP_PAD + n0 + tok) * 64 + dd; const float av = n0 + tok < NCMP ? a : 0.f; F_KCMP[oi] = av; F_KCMPB[oi] = (bf16)f2bf(av); }
    __syncthreads();
}
__device__ __forceinline__ void prep_phase(Frame& F, int layer) {
    PHASE_IDS;
    if (blockIdx.x < 24) {
        const int b = blockIdx.x / 12, h = blockIdx.x % 12; const float bf = F_IN(5)[layer * 12 + h];
        LAS double* part = (LAS double*)(F.lds + RING_OFF);
        const bf16* src = F_PROJ + (size_t)b * S * NPROJ + C_FF + h; float lf[32]; double s = 0.0;
#pragma unroll
        for (int i = 0; i < 32; ++i) { const float x = bf2f(src[(size_t)(tid * 32 + i) * NPROJ]) + bf; lf[i] = (fminf(x, 0.f) - log1pf(__expf(-fabsf(x)))) * LOG2E; s += (double)lf[i]; }
        part[tid] = s; __syncthreads();
        double pre = 0.0; for (int k = 0; k < tid; ++k) pre += part[k];
        double* dst = F_FOXC + (size_t)(b * 12 + h) * S + tid * 32;
#pragma unroll
        for (int i = 0; i < 32; ++i) { pre += (double)lf[i]; dst[i] = pre; }
        __syncthreads();
    }
    for (int it = blockIdx.x; it < 1024; it += F.G) cmp_item_naive(F, layer, it);
    for (int o = blockIdx.x * NTHR + tid; o < 2 * 8 * 64 * 64; o += F.G * NTHR) {
        const int d = o & 63, j = (o >> 6) & 63, h = (o >> 12) & 7, b = o >> 15;
        const bf16* src = F_PROJ + ((size_t)b * S + j * 256) * NPROJ + C_MK + h * 64 + d; float a = 0.f;
        for (int p = 0; p < 256; ++p) a += bf2f(src[(size_t)p * NPROJ]);
        const float km = a * (1.0f / 256.0f); F_KMEAN[o] = km;
        const unsigned kh = f2bf(km); F_KMEANB[o] = (bf16)kh; F_KMEANB[2 * 8 * 64 * 64 + o] = (bf16)f2bf(km - __uint_as_float(kh << 16));
    }
}
__device__ __forceinline__ void act_phase(Frame& F, int layer) {
    PHASE_IDS;
    const float* cw = F_IN(14) + (size_t)layer * 3 * DFF; const float* cb = F_IN(15) + (size_t)layer * DFF;
    constexpr int CG = DFF / 8;
    for (size_t i = (size_t)blockIdx.x * NTHR + tid; i < (size_t)MH * CG; i += (size_t)F.G * NTHR) {
        const int cg = (int)(i % CG), t = (int)(i / CG), c0 = cg * 8;
        const bf16* ur = F_UG + (size_t)t * NUP + c0; const bf16* gr = ur + DFF;
        const uint4 uu = *(const uint4*)ur, g2 = *(const uint4*)gr;
        uint4 g1 = make_uint4(0, 0, 0, 0), g0 = make_uint4(0, 0, 0, 0);
        if (t >= 1) g1 = *(const uint4*)(gr - NUP);
        if (t >= 2) g0 = *(const uint4*)(gr - 2 * NUP);
        const unsigned ua[4] = {uu.x, uu.y, uu.z, uu.w}, a2[4] = {g2.x, g2.y, g2.z, g2.w}, a1[4] = {g1.x, g1.y, g1.z, g1.w}, a0[4] = {g0.x, g0.y, g0.z, g0.w};
        unsigned r[4];
#pragma unroll
        for (int k = 0; k < 4; ++k) {
            const int c = c0 + 2 * k;
            const float x0 = cb[c] + cw[c] * blo(a0[k]) + cw[DFF + c] * blo(a1[k]) + cw[2 * DFF + c] * blo(a2[k]);
            const float x1 = cb[c + 1] + cw[c + 1] * bhi(a0[k]) + cw[DFF + c + 1] * bhi(a1[k]) + cw[2 * DFF + c + 1] * bhi(a2[k]);
            r[k] = pk2(gelu_tanh(x0) * blo(ua[k]), gelu_tanh(x1) * bhi(ua[k]));
        }
        *(uint4*)(F_ACT + (size_t)t * DFF + c0) = make_uint4(r[0], r[1], r[2], r[3]);
    }
}

namespace ga {
typedef short bf16x8 __attribute__((ext_vector_type(8)));
typedef short s16x4 __attribute__((ext_vector_type(4)));
typedef float f32x16 __attribute__((ext_vector_type(16)));
typedef unsigned u32x4 __attribute__((ext_vector_type(4)));
typedef LAS const char* lds_cptr;
typedef short v4i16_t __attribute__((ext_vector_type(4)));
constexpr int SLOTB = 8192, NSLOT = 4, L_K = 0, L_V = NSLOT * SLOTB, L_WSF = 2 * NSLOT * SLOTB, L_OST = 0, L_VAR = L_WSF + 2048;
__device__ __forceinline__ int crow(int r, int hi) { return (r & 3) + 8 * (r >> 2) + 4 * hi; }
__device__ __forceinline__ void glds16(const void* gsrc, unsigned lds_dst) { unsigned keep;
    asm volatile("s_mov_b32 %0, m0\n\ts_mov_b32 m0, %2\n\ts_nop 0\n\tglobal_load_lds_dwordx4 %1, off\n\ts_mov_b32 m0, %0" : "=&s"(keep) : "v"(gsrc), "s"(lds_dst) : "memory"); }
typedef float f32x2_t __attribute__((ext_vector_type(2))); typedef __bf16 bf16x2_t __attribute__((ext_vector_type(2)));
__device__ __forceinline__ unsigned cvtpk(float lo, float hi) { f32x2_t v = {lo, hi}; bf16x2_t b = __builtin_convertvector(v, bf16x2_t); return __builtin_bit_cast(unsigned, b); }
__device__ __forceinline__ s16x4 vtr(lds_cptr p) { return __builtin_bit_cast(s16x4, __builtin_amdgcn_ds_read_tr16_b64_v4i16((LAS v4i16_t*)p)); }
#define GA_WAIT_BAR(N) asm volatile("s_waitcnt vmcnt(" #N ") lgkmcnt(0)\n\ts_barrier" ::: "memory")

struct Core { bf16x8 qr[4]; float m, l, inited; f32x16 o0, o1; };
constexpr float THR = 8.0f;
__device__ __forceinline__ void core_reset(Core& c) { c.m = 0.f; c.l = 0.f; c.inited = 0.f; c.o0 = f32x16{}; c.o1 = f32x16{}; }
__device__ __forceinline__ void load_q(Core& c, const bf16* qrow, int hi) {
#pragma unroll
    for (int d0 = 0; d0 < 4; ++d0) c.qr[d0] = *(const bf16x8*)(qrow + d0 * 16 + hi * 8);
}
struct TileDma {
    const bf16* ksrc; const bf16* vsrc; unsigned kdst, vdst;
    __device__ __forceinline__ void init(const bf16* K, int kpitch, const bf16* V, int vpitch, LAS unsigned char* base, int wid, int lane) {
        ksrc = K + (size_t)lane * kpitch + wid * 8;
        vsrc = V + (size_t)(16 * (wid & 3) + (lane >> 2)) * vpitch + (wid >> 2) * 32 + (lane & 3) * 8;
        const unsigned b0 = (unsigned)(uintptr_t)base; kdst = b0 + L_K + wid * 1024; vdst = b0 + L_V + wid * 1024;
    }
    __device__ __forceinline__ void issue_k(size_t koff, int slot) const { glds16(ksrc + koff, (unsigned)__builtin_amdgcn_readfirstlane(kdst + slot * SLOTB)); }
    __device__ __forceinline__ void issue_v(size_t voff, int slot) const { glds16(vsrc + voff, (unsigned)__builtin_amdgcn_readfirstlane(vdst + slot * SLOTB)); }
};
__device__ __forceinline__ void dma_k_only(const TileDma& dma, size_t koff, int slot) { dma.issue_k(koff, slot); }
__device__ __forceinline__ void qk_tile(f32x16& p0, f32x16& p1, const Core& c, LAS unsigned char* base, int slot, int r32, int hi) {
    const lds_cptr kb = (lds_cptr)base + L_K + slot * SLOTB + hi * 1024 + r32 * 16;
#pragma unroll
    for (int d0 = 0; d0 < 4; ++d0) {
        const bf16x8 b0 = *(const LAS bf16x8*)(kb + d0 * 2048), b1 = *(const LAS bf16x8*)(kb + d0 * 2048 + 512);
        p0 = __builtin_amdgcn_mfma_f32_32x32x16_bf16(b0, c.qr[d0], d0 == 0 ? f32x16{} : p0, 0, 0, 0);
        p1 = __builtin_amdgcn_mfma_f32_32x32x16_bf16(b1, c.qr[d0], d0 == 0 ? f32x16{} : p1, 0, 0, 0);
    }
}
#define GA_MX3(a, b, c) __builtin_fmaxf(__builtin_fmaxf((a), (b)), (c))
__device__ __forceinline__ float rowmax32(const f32x16& p0, const f32x16& p1) {
    float a = GA_MX3(p0[0], p0[1], p1[0]), b = GA_MX3(p0[2], p0[3], p1[1]); a = GA_MX3(a, p1[2], p1[3]);
#pragma unroll
    for (int r = 4; r < 16; r += 4) { a = GA_MX3(a, p0[r], p0[r + 1]); b = GA_MX3(b, p0[r + 2], p0[r + 3]); a = GA_MX3(a, p1[r], p1[r + 1]); b = GA_MX3(b, p1[r + 2], p1[r + 3]); }
    a = __builtin_fmaxf(a, b);
    const auto rr = __builtin_amdgcn_permlane32_swap(__float_as_uint(a), __float_as_uint(a), false, false);
    return __builtin_fmaxf(__uint_as_float(rr[0]), __uint_as_float(rr[1]));
}
__device__ __forceinline__ void softmax_h2(Core& c, f32x16& p0, f32x16& p1, u32x4 (&pw)[4], LAS unsigned char* base, int wid, int r32, int hi) {
    const float rm = rowmax32(p0, p1) - c.m;
    const bool first = (c.inited == 0.f) && (rm > -INFINITY);
    const bool need = first || rm > THR;
    if (__any(need)) {
        const float dl = need ? rm : 0.f;
        const float alpha = first ? 0.f : ex2(-dl);
        c.m += dl; c.l *= alpha; if (first) c.inited = 1.f;
        LAS float* wsf = (LAS float*)(base + L_WSF) + wid * 64;
        if (hi == 0) wsf[r32] = alpha;
        __builtin_amdgcn_fence(__ATOMIC_RELEASE, "wavefront"); asm volatile("s_waitcnt lgkmcnt(0)" ::: "memory");
#pragma unroll
        for (int r = 0; r < 16; ++r) { const float f = wsf[crow(r, hi)]; c.o0[r] *= f; c.o1[r] *= f; }
        asm volatile("s_waitcnt lgkmcnt(0)" ::: "memory");
    }
    float ps0 = 0.f, ps1 = 0.f;
#pragma unroll
    for (int r = 0; r < 16; r += 2) { f32x2_t a = {p0[r], p0[r + 1]}, b = {p1[r], p1[r + 1]}; const f32x2_t mm = {c.m, c.m}; a = a - mm; b = b - mm;
        p0[r] = ex2(a.x); p0[r + 1] = ex2(a.y); p1[r] = ex2(b.x); p1[r + 1] = ex2(b.y); }
    f32x2_t sa = {0.f, 0.f}, sb = {0.f, 0.f};
#pragma unroll
    for (int r = 0; r < 16; r += 2) { sa += (f32x2_t){p0[r], p0[r + 1]}; sb += (f32x2_t){p1[r], p1[r + 1]}; }
    ps0 = sa.x + sa.y; ps1 = sb.x + sb.y;
    c.l += ps0 + ps1;
#pragma unroll
    for (int k = 0; k < 4; ++k) { pw[0][k] = cvtpk(p0[2 * k], p0[2 * k + 1]); pw[1][k] = cvtpk(p0[8 + 2 * k], p0[8 + 2 * k + 1]); pw[2][k] = cvtpk(p1[2 * k], p1[2 * k + 1]); pw[3][k] = cvtpk(p1[8 + 2 * k], p1[8 + 2 * k + 1]); }
}
__device__ __forceinline__ void pv_h1(Core& c, const u32x4 (&pw)[4], LAS unsigned char* base, int slot, int lane, int hi) {
    const lds_cptr vp = (lds_cptr)base + L_V + slot * SLOTB + ((lane >> 4) & 1) * 32 + (lane & 3) * 8 + (4 * hi + ((lane & 15) >> 2)) * 64;
#pragma unroll
    for (int ks = 0; ks < 4; ++ks) {
        const s16x4 lo0 = vtr(vp + ks * 1024), hi0 = vtr(vp + ks * 1024 + 512), lo1 = vtr(vp + 4096 + ks * 1024), hi1 = vtr(vp + 4096 + ks * 1024 + 512);
        const bf16x8 v0 = (bf16x8){lo0[0], lo0[1], lo0[2], lo0[3], hi0[0], hi0[1], hi0[2], hi0[3]}, v1 = (bf16x8){lo1[0], lo1[1], lo1[2], lo1[3], hi1[0], hi1[1], hi1[2], hi1[3]};
        const bf16x8 pa = __builtin_bit_cast(bf16x8, pw[ks]);
        c.o0 = __builtin_amdgcn_mfma_f32_32x32x16_bf16(pa, v0, c.o0, 0, 0, 0);
        c.o1 = __builtin_amdgcn_mfma_f32_32x32x16_bf16(pa, v1, c.o1, 0, 0, 0);
    }
}
__device__ __forceinline__ float row_l(const Core& c) { return c.l + __shfl_xor(c.l, 32); }
__device__ __forceinline__ void scale_o(f32x16& a0, f32x16& a1, const Core& c, float rowscale, bool accumulate, LAS unsigned char* base, int wid, int r32, int hi) {
    LAS float* wsf = (LAS float*)(base + L_WSF) + wid * 64;
    if (hi == 0) wsf[r32] = rowscale;
    __builtin_amdgcn_fence(__ATOMIC_RELEASE, "wavefront"); asm volatile("s_waitcnt lgkmcnt(0)" ::: "memory");
#pragma unroll
    for (int r = 0; r < 16; ++r) { const float f = wsf[crow(r, hi)]; if (accumulate) { a0[r] += f * c.o0[r]; a1[r] += f * c.o1[r]; } else { a0[r] = f * c.o0[r]; a1[r] = f * c.o1[r]; } }
    asm volatile("s_waitcnt lgkmcnt(0)" ::: "memory");
}
__device__ __forceinline__ void stash_o(LAS float* stash, const Core& c, float rowscale, bool accumulate, LAS unsigned char* base, int wid, int r32, int hi) {
    LAS float* wsf = (LAS float*)(base + L_WSF) + wid * 64;
    if (hi == 0) wsf[r32] = rowscale;
    __builtin_amdgcn_fence(__ATOMIC_RELEASE, "wavefront"); asm volatile("s_waitcnt lgkmcnt(0)" ::: "memory");
#pragma unroll
    for (int r = 0; r < 16; ++r) { const int orow = crow(r, hi); const float f = wsf[orow]; LAS float* p = stash + orow * 64 + r32;
        if (accumulate) { p[0] += f * c.o0[r]; p[32] += f * c.o1[r]; } else { p[0] = f * c.o0[r]; p[32] = f * c.o1[r]; } }
    asm volatile("s_waitcnt lgkmcnt(0)" ::: "memory");
}
template <class RowPtr>
__device__ __forceinline__ void store_stash(const LAS float* stash, int lane, const RowPtr& rowptr) {
    __builtin_amdgcn_fence(__ATOMIC_RELEASE, "wavefront"); asm volatile("s_waitcnt lgkmcnt(0)" ::: "memory");
#pragma unroll
    for (int i = 0; i < 4; ++i) { const int row = i * 8 + (lane >> 3), ch = lane & 7; const LAS f32x4* s = (const LAS f32x4*)(stash + row * 64 + ch * 8); const f32x4 x = s[0], y = s[1];
        u32x4 v; v.x = pk2(x.x, x.y); v.y = pk2(x.z, x.w); v.z = pk2(y.x, y.y); v.w = pk2(y.z, y.w); *(u32x4*)(rowptr(row) + ch * 8) = v; }
    asm volatile("s_waitcnt lgkmcnt(0)" ::: "memory");
}
template <class RowPtr>
__device__ __forceinline__ void store_rows(const f32x16& a0, const f32x16& a1, LAS unsigned char* base, int wid, int lane, int r32, int hi, const RowPtr& rowptr) {
    LAS bf16* stg = (LAS bf16*)(base + L_OST) + wid * 2048;
#pragma unroll
    for (int r = 0; r < 16; ++r) { const int orow = crow(r, hi); stg[orow * 64 + r32] = (bf16)f2bf(a0[r]); stg[orow * 64 + 32 + r32] = (bf16)f2bf(a1[r]); }
    __builtin_amdgcn_fence(__ATOMIC_RELEASE, "wavefront"); asm volatile("s_waitcnt lgkmcnt(0)" ::: "memory");
#pragma unroll
    for (int i = 0; i < 4; ++i) { const int row = i * 8 + (lane >> 3), ch = lane & 7; const u32x4 v = *(const LAS u32x4*)(stg + row * 64 + ch * 8); *(u32x4*)(rowptr(row) + ch * 8) = v; }
    asm volatile("s_waitcnt lgkmcnt(0)" ::: "memory");
}
template <bool HAS_V, class RowFn, class BiasMask>
__device__ __forceinline__ void run_tiles_t(Core& c, const TileDma& dma, int kpitch, int vpitch, int nt, const RowFn& rowfn, const BiasMask& bm, LAS unsigned char* base, int wid, int lane, int r32, int hi) {
    if (nt <= 0) return;
#define GA_REQ_K(i) do { const int i_ = (i) < nt ? (i) : nt - 1; dma.issue_k((size_t)rowfn(i_) * kpitch, (i) & 3); } while (0)
#define GA_REQ_V(i) do { if (HAS_V) { const int i_ = (i) < nt ? (i) : nt - 1; dma.issue_v((size_t)rowfn(i_) * vpitch, (i) & 3); } } while (0)
#define GA_REQ(s) do { GA_REQ_K((s) + 3); GA_REQ_V((s) + 2); } while (0)
#define GA_BAR() asm volatile("s_waitcnt lgkmcnt(0)\n\ts_barrier" ::: "memory")
#define GA_CBAR() do { if (HAS_V) { GA_WAIT_BAR(4); } else { GA_WAIT_BAR(2); } } while (0)
#define GA_H2(i) do { bm(p0, p1, (i)); if (HAS_V) softmax_h2(c, p0, p1, pw, base, wid, r32, hi); } while (0)
#define GA_PV(i) do { if (HAS_V) pv_h1(c, pw, base, (i) & 3, lane, hi); } while (0)
    GA_REQ_K(0); GA_REQ_V(0); GA_REQ_K(1); GA_REQ_V(1); GA_REQ_K(2);
    GA_CBAR();
    f32x16 p0, p1; u32x4 pw[4];
    if (wid < 4) {
        GA_REQ(0); qk_tile(p0, p1, c, base, 0, r32, hi); GA_BAR();
        GA_H2(0); GA_CBAR();
        for (int s = 1; s < nt; ++s) {
            GA_REQ(s); GA_PV(s - 1); qk_tile(p0, p1, c, base, s & 3, r32, hi); GA_BAR();
            GA_H2(s); GA_CBAR();
        }
        GA_REQ(nt); GA_PV(nt - 1); GA_BAR();
        GA_CBAR();
    } else {
        GA_REQ(0); GA_BAR();
        qk_tile(p0, p1, c, base, 0, r32, hi); GA_CBAR();
        for (int s = 1; s < nt; ++s) {
            GA_REQ(s); GA_H2(s - 1); GA_BAR();
            GA_PV(s - 1); qk_tile(p0, p1, c, base, s & 3, r32, hi); GA_CBAR();
        }
        GA_REQ(nt); GA_H2(nt - 1); GA_BAR();
        GA_PV(nt - 1); GA_CBAR();
    }
    GA_WAIT_BAR(0);
#undef GA_REQ_K
#undef GA_REQ_V
#undef GA_REQ
#undef GA_BAR
#undef GA_CBAR
#undef GA_H2
#undef GA_PV
}
template <class RowFn, class BiasMask>
__device__ __forceinline__ void run_tiles(Core& c, const TileDma& dma, int kpitch, int vpitch, int nt, const RowFn& rowfn, const BiasMask& bm, LAS unsigned char* base, int wid, int lane, int r32, int hi) {
    run_tiles_t<true>(c, dma, kpitch, vpitch, nt, rowfn, bm, base, wid, lane, r32, hi);
}

__device__ __forceinline__ void mem_unit(Frame& F, int layer, int b, int h, int qb) {
    PHASE_IDS; const int r32 = lane & 31, hi = lane >> 5;
    LAS unsigned char* base = F.lds + RING_OFF;
    const size_t row = (size_t)b * S + qb * 256 + wave * 32 + r32;
    Core c; core_reset(c); load_q(c, F_PROJ + row * NPROJ + C_EQ + h * 64, hi);
    const bf16* kv = F_MEMKVB + (size_t)layer * 512 * 512 + (size_t)b * 256 * 512;
    TileDma dma; dma.init(kv + h * 64, 512, kv + 256 + h * 64, 512, base, wave, lane);
    asm volatile("s_waitcnt vmcnt(0)" ::: "memory");
    run_tiles(c, dma, 512, 512, 4, [](int i) { return i * 64; }, [](f32x16&, f32x16&, int) {}, base, wave, lane, r32, hi);
    const float l = row_l(c);
    f32x16 a0, a1; scale_o(a0, a1, c, 1.0f / l, false, base, wave, r32, hi);
    bf16* ob = F_O + ((size_t)b * S + qb * 256 + wave * 32) * D + (28 + h) * 64;
    store_rows(a0, a1, base, wave, lane, r32, hi, [ob](int r) { return ob + (size_t)r * D; });
    GA_WAIT_BAR(0);
}
__device__ __forceinline__ void fox_unit(Frame& F, int b, int h, int qb) {
    PHASE_IDS; const int r32 = lane & 31, hi = lane >> 5;
    LAS unsigned char* base = F.lds + RING_OFF;
    LAS float* T = (LAS float*)(base + L_VAR);
    const int q0 = qb * 256, nk = q0 + 256;
    const double* cc = F_FOXC + (size_t)(b * 12 + h) * S;
    const double cref = q0 > 0 ? cc[q0 - 1] : 0.0;
#pragma unroll 8
    for (int j = tid; j < nk; j += NTHR) T[j] = (float)(cref - cc[j]);
    const size_t row = (size_t)b * S + q0 + wave * 32 + r32;
    Core c; core_reset(c); load_q(c, F_PROJ + row * NPROJ + C_FQ + h * 64, hi);
    const bf16* pb = F_PROJ + (size_t)b * S * NPROJ;
    TileDma dma; dma.init(pb + C_FK + h * 64, NPROJ, pb + C_FV + h * 64, NPROJ, base, wave, lane);
    GA_WAIT_BAR(0);
    const int nt = nk / 64, trow = wave * 32 + r32;
    run_tiles(c, dma, NPROJ, NPROJ, nt, [](int i) { return i * 64; },
        [=](f32x16& p0, f32x16& p1, int i) {
            const LAS f32x4* tp = (const LAS f32x4*)(T + i * 64 + 4 * hi);
#pragma unroll
            for (int g = 0; g < 4; ++g) { const f32x4 t0 = tp[2 * g], t1 = tp[8 + 2 * g];
                p0[4 * g] += t0.x; p0[4 * g + 1] += t0.y; p0[4 * g + 2] += t0.z; p0[4 * g + 3] += t0.w; p1[4 * g] += t1.x; p1[4 * g + 1] += t1.y; p1[4 * g + 2] += t1.z; p1[4 * g + 3] += t1.w; }
            if (i >= nt - 4) {
                const int kb = (i - (nt - 4)) * 64 + 4 * hi;
#pragma unroll
                for (int r = 0; r < 16; ++r) { const int kv = kb + (r & 3) + 8 * (r >> 2); if (kv > trow) p0[r] = -INFINITY; if (kv + 32 > trow) p1[r] = -INFINITY; }
            }
        }, base, wave, lane, r32, hi);
    const float l = row_l(c);
    f32x16 a0, a1; scale_o(a0, a1, c, 1.0f / l, false, base, wave, r32, hi);
    bf16* ob = F_O + ((size_t)b * S + q0 + wave * 32) * D + (16 + h) * 64;
    store_rows(a0, a1, base, wave, lane, r32, hi, [ob](int r) { return ob + (size_t)r * D; });
    GA_WAIT_BAR(0);
}

__device__ __forceinline__ bool gate_better(float vb, int ib, float va, int ia) { return vb > va || (vb == va && ib < ia); }
#define GATE_INS(v, i) do { const float v_ = (v); const int i_ = (i); \
    if (gate_better(v_, i_, g0, i0)) { g2 = g1; i2 = i1; g1 = g0; i1 = i0; g0 = v_; i0 = i_; } \
    else if (gate_better(v_, i_, g1, i1)) { g2 = g1; i2 = i1; g1 = v_; i1 = i_; } \
    else if (gate_better(v_, i_, g2, i2)) { g2 = v_; i2 = i_; } } while (0)
__device__ __forceinline__ void moba_gate_unit(Frame& F, int b, int h, int own) {
    PHASE_IDS; const int r32 = lane & 31, hi = lane >> 5;
    LAS unsigned char* base = F.lds + RING_OFF;
    const int q0 = own * 256, t = q0 + wave * 32 + r32;
    const size_t row = (size_t)b * S + t;
    Core c; core_reset(c); load_q(c, F_PROJ + row * NPROJ + C_MQ + h * 64, hi);
    float g0 = -INFINITY, g1 = -INFINITY, g2 = -INFINITY; int i0 = -1, i1 = -1, i2 = -1;
    if (own > 0) {
        TileDma gd; const bf16* kmh = F_KMEANB + (size_t)(b * 8 + h) * 64 * 64; gd.init(kmh, 64, kmh, 64, base, wave, lane);
        asm volatile("s_waitcnt vmcnt(0)" ::: "memory");
        dma_k_only(gd, 0, 0); dma_k_only(gd, (size_t)2 * 8 * 64 * 64, 1);
        GA_WAIT_BAR(0);
        f32x16 p0, p1, s0, s1; qk_tile(p0, p1, c, base, 0, r32, hi); qk_tile(s0, s1, c, base, 1, r32, hi);
#pragma unroll
        for (int r = 0; r < 16; ++r) { const int j = crow(r, hi); if (j < own) GATE_INS(p0[r] + s0[r], j); }
#pragma unroll
        for (int r = 0; r < 16; ++r) { const int j = 32 + crow(r, hi); if (j < own) GATE_INS(p1[r] + s1[r], j); }
        const float a0 = __shfl_xor(g0, 32), a1 = __shfl_xor(g1, 32), a2 = __shfl_xor(g2, 32); const int j0 = __shfl_xor(i0, 32), j1 = __shfl_xor(i1, 32), j2 = __shfl_xor(i2, 32);
        if (j0 >= 0) GATE_INS(a0, j0);
        if (j1 >= 0) GATE_INS(a1, j1);
        if (j2 >= 0) GATE_INS(a2, j2);
    }
    if (hi == 0) {
        const size_t ri = (size_t)(b * 8 + h) * S + t;
        F_MSEL[ri] = (unsigned)(i0 & 0xFF) | ((unsigned)(i1 & 0xFF) << 8) | ((unsigned)(i2 & 0xFF) << 16);
        *(f32x4*)(F_LSE + ri * 4) = (f32x4){-INFINITY, -INFINITY, -INFINITY, -INFINITY};
    }
    GA_WAIT_BAR(0);
}
template <class VRow, class PRow>
__device__ __forceinline__ void moba_store_partial(Core& c, LAS unsigned char* base, int wid, int lane, int r32, int hi, bool myvalid, float* mylse, const VRow& vrow, const PRow& prow) {
    const float l = row_l(c);
    if (hi == 0 && myvalid) *mylse = c.m + __log2f(l);
    f32x16 a0, a1; scale_o(a0, a1, c, 1.0f / l, false, base, wid, r32, hi);
    LAS bf16* stg = (LAS bf16*)(base + L_OST) + wid * 2048;
#pragma unroll
    for (int r = 0; r < 16; ++r) { const int orow = crow(r, hi); stg[orow * 64 + r32] = (bf16)f2bf(a0[r]); stg[orow * 64 + 32 + r32] = (bf16)f2bf(a1[r]); }
    __builtin_amdgcn_fence(__ATOMIC_RELEASE, "wavefront"); asm volatile("s_waitcnt lgkmcnt(0)" ::: "memory");
#pragma unroll
    for (int i = 0; i < 4; ++i) { const int rw = i * 8 + (lane >> 3), ch = lane & 7; const u32x4 v = *(const LAS u32x4*)(stg + rw * 64 + ch * 8); if (vrow(rw)) *(u32x4*)(prow(rw) + ch * 8) = v; }
    asm volatile("s_waitcnt lgkmcnt(0)" ::: "memory");
}
__device__ __forceinline__ void moba_own_unit(Frame& F, int b, int h, int own) {
    PHASE_IDS; const int r32 = lane & 31, hi = lane >> 5;
    LAS unsigned char* base = F.lds + RING_OFF;
    const int q0 = own * 256, t = q0 + wave * 32 + r32;
    const size_t row = (size_t)b * S + t;
    Core c; core_reset(c); load_q(c, F_PROJ + row * NPROJ + C_MQ + h * 64, hi);
    const bf16* pb = F_PROJ + (size_t)b * S * NPROJ;
    TileDma dma; dma.init(pb + C_MK + h * 64, NPROJ, pb + C_MV + h * 64, NPROJ, base, wave, lane);
    GA_WAIT_BAR(0);
    const float slope = exp2f(-(float)(h + 1)) * LOG2E;
    run_tiles(c, dma, NPROJ, NPROJ, 4, [=](int i) { return q0 + 64 * i; },
        [=](f32x16& p0, f32x16& p1, int i) {
            const int tr = q0 + 64 * i;
            float sl = slope, fb = (float)(tr + 4 * hi - t); asm volatile("" : "+v"(sl), "+v"(fb));
#pragma unroll
            for (int r = 0; r < 16; ++r) { const float kf = (float)((r & 3) + 8 * (r >> 2)); p0[r] = __builtin_fmaf(sl, fb + kf, p0[r]); p1[r] = __builtin_fmaf(sl, fb + (kf + 32.0f), p1[r]); }
            const int kb = tr + 4 * hi;
#pragma unroll
            for (int r = 0; r < 16; ++r) { const int kv = kb + (r & 3) + 8 * (r >> 2); if (kv > t) p0[r] = -INFINITY; if (kv + 32 > t) p1[r] = -INFINITY; }
        }, base, wave, lane, r32, hi);
    const size_t ri0 = (size_t)(b * 8 + h) * S + q0 + wave * 32;
    bf16* part = F_PART;
    moba_store_partial(c, base, wave, lane, r32, hi, true, F_LSE + (ri0 + r32) * 4 + 3, [](int) { return true; }, [=](int r) { return part + ((ri0 + r) * 4 + 3) * 64; });
    GA_WAIT_BAR(0);
}
__device__ __forceinline__ void moba_gather_unit(Frame& F, int b, int h, int J) {
    PHASE_IDS; const int r32 = lane & 31, hi = lane >> 5;
    LAS unsigned char* base = F.lds + RING_OFF;
    LAS unsigned* cntp = (LAS unsigned*)(base + L_VAR);
    LAS unsigned* list = (LAS unsigned*)(base + L_VAR + 64);
    const size_t rbase = (size_t)(b * 8 + h) * S;
    if (tid == 0) cntp[0] = 0u;
    GA_WAIT_BAR(0);
    for (int t0 = 256 * (J + 1) + tid; t0 < S; t0 += NTHR) {
        const unsigned w = F_MSEL[rbase + t0]; const unsigned uj = (unsigned)J;
        const int n = (w & 0xFFu) == uj ? 0 : ((w >> 8) & 0xFFu) == uj ? 1 : ((w >> 16) & 0xFFu) == uj ? 2 : -1;
        if (n >= 0) { const unsigned pos = __hip_atomic_fetch_add(cntp, 1u, __ATOMIC_RELAXED, __HIP_MEMORY_SCOPE_WORKGROUP); list[pos] = (unsigned)t0 | ((unsigned)n << 16); }
    }
    GA_WAIT_BAR(0);
    const int cnt = __builtin_amdgcn_readfirstlane((int)cntp[0]);
    const bf16* pb = F_PROJ + (size_t)b * S * NPROJ;
    const float slope = exp2f(-(float)(h + 1)) * LOG2E;
    bf16* part = F_PART; float* lsep = F_LSE;
    for (int c0 = 0; c0 < cnt; c0 += 256) {
        const int idx = c0 + wave * 32 + r32; const bool valid = idx < cnt;
        const unsigned e = list[valid ? idx : 0]; const int t = (int)(e & 0xFFFFu), n = (int)(e >> 16);
        Core c; core_reset(c); load_q(c, pb + (size_t)t * NPROJ + C_MQ + h * 64, hi);
        TileDma dma; dma.init(pb + C_MK + h * 64, NPROJ, pb + C_MV + h * 64, NPROJ, base, wave, lane);
        asm volatile("s_waitcnt vmcnt(0)" ::: "memory");
        run_tiles(c, dma, NPROJ, NPROJ, 4, [=](int i) { return J * 256 + 64 * i; },
            [=](f32x16& p0, f32x16& p1, int i) {
                float sl = slope, fb = (float)(J * 256 + 64 * i + 4 * hi - t); asm volatile("" : "+v"(sl), "+v"(fb));
#pragma unroll
                for (int r = 0; r < 16; ++r) { const float kf = (float)((r & 3) + 8 * (r >> 2)); p0[r] = __builtin_fmaf(sl, fb + kf, p0[r]); p1[r] = __builtin_fmaf(sl, fb + (kf + 32.0f), p1[r]); }
            }, base, wave, lane, r32, hi);
        const int wbase = c0 + wave * 32;
        moba_store_partial(c, base, wave, lane, r32, hi, valid, lsep + (rbase + t) * 4 + n,
            [=](int r) { return wbase + r < cnt; },
            [=](int r) { const unsigned er = list[wbase + r < cnt ? wbase + r : 0]; return part + ((rbase + (er & 0xFFFFu)) * 4 + (er >> 16)) * 64; });
        GA_WAIT_BAR(0);
    }
}
template <int CTRL> __device__ __forceinline__ float dpp_f(float x) { return __int_as_float(__builtin_amdgcn_update_dpp(0, __float_as_int(x), CTRL, 0xF, 0xF, true)); }
__device__ __forceinline__ unsigned long long wave_max_u64(unsigned long long k) {
#pragma unroll
    for (int o = 1; o < 64; o <<= 1) { const unsigned lo_ = __shfl_xor((unsigned)k, o), hi_ = __shfl_xor((unsigned)(k >> 32), o); const unsigned long long x = ((unsigned long long)hi_ << 32) | lo_; k = x > k ? x : k; }
    return k;
}
__device__ __forceinline__ void nsa_unit(Frame& F, int b, int g, int qblk) {
    PHASE_IDS; const int r32 = lane & 31, hi = lane >> 5;
    LAS unsigned char* base = F.lds + RING_OFF;
    LAS float* imp = (LAS float*)(base + L_VAR);
    LAS unsigned* selm = (LAS unsigned*)(base + L_VAR + 65536);
    LAS unsigned* um = (LAS unsigned*)(base + L_VAR + 65536 + 2048);
    LAS int* tl = (LAS int*)(base + L_VAR + 65536 + 2048 + 64);
    const int q0 = qblk * 64, ql = wave * 8 + (r32 >> 2), hh = r32 & 3, h = g * 4 + hh, t = q0 + ql, jt = qblk;
    const size_t row = (size_t)b * S + t;
    { f32x4* z = (f32x4*)0; (void)z; LAS f32x4* iz = (LAS f32x4*)imp; for (int i = tid; i < 64 * 256 / 4; i += NTHR) iz[i] = (f32x4){0.f, 0.f, 0.f, 0.f};
      for (int i = tid; i < 64 * 8 + 16; i += NTHR) selm[i] = 0u; }
    Core c; core_reset(c); load_q(c, F_PROJ + row * NPROJ + C_NQ + h * 64, hi);
    const bf16* gp = F_PROJ + row * NPROJ + C_GATE + h * 3;
    const float ga_ = 1.0f / (1.0f + __expf(-bf2f(gp[0]))), gb_ = 1.0f / (1.0f + __expf(-bf2f(gp[1]))), gc_ = 1.0f / (1.0f + __expf(-bf2f(gp[2])));
    const float slope = exp2f(-(float)(h + 1)) * LOG2E;
    const bf16* pb = F_PROJ + (size_t)b * S * NPROJ;
    float gc_rl = 0.f;
    const int ncu = min(NCMP, (q0 + 32) / 16 + 1), ntc = (ncu + 63) >> 6;
    { const bf16* kc = F_KCMPB + (size_t)((0 * 2 + b) * 2 + g) * NCMP_PAD * 64; const bf16* vc = F_KCMPB + (size_t)((1 * 2 + b) * 2 + g) * NCMP_PAD * 64;
      TileDma dma; dma.init(kc, 64, vc, 64, base, wave, lane);
      GA_WAIT_BAR(0);
      auto cmp_bias = [=](f32x16& p0, f32x16& p1, int i) {
          int ce0 = 16 * (i * 64 + 4 * hi) + 31 - t;
          float sl = slope; asm volatile("" : "+v"(sl), "+v"(ce0));
#pragma unroll
          for (int r = 0; r < 16; ++r) { const int d = ce0 + 16 * ((r & 3) + 8 * (r >> 2)); p0[r] = d <= 0 ? __builtin_fmaf(sl, (float)d, p0[r]) : -INFINITY; p1[r] = d + 512 <= 0 ? __builtin_fmaf(sl, (float)(d + 512), p1[r]) : -INFINITY; }
      };
      run_tiles(c, dma, 64, 64, ntc, [](int i) { return i * 64; }, cmp_bias, base, wave, lane, r32, hi);
      const float lc = row_l(c); const float rl = lc > 0.f ? 1.0f / lc : 0.f, mref = c.m; gc_rl = ga_ * rl;
      LAS float* impq = imp + ql * 256;
      run_tiles_t<false>(c, dma, 64, 64, ntc, [](int i) { return i * 64; },
          [=](f32x16& p0, f32x16& p1, int i) {
              cmp_bias(p0, p1, i);
#pragma unroll
              for (int r = 0; r < 16; ++r) { float x = ex2(p0[r] - mref) * rl; x += dpp_f<0xB1>(x); x += dpp_f<0x4E>(x); p0[r] = x; float y = ex2(p1[r] - mref) * rl; y += dpp_f<0xB1>(y); y += dpp_f<0x4E>(y); p1[r] = y; }
              if (hh == 0) {
#pragma unroll
                  for (int g4 = 0; g4 < 4; ++g4) {
                      const int j = i * 16 + 2 * g4 + hi;
                      __hip_atomic_fetch_add(impq + j, ((p0[4 * g4] + p0[4 * g4 + 1]) + p0[4 * g4 + 2]) + p0[4 * g4 + 3], __ATOMIC_RELAXED, __HIP_MEMORY_SCOPE_WORKGROUP);
                      __hip_atomic_fetch_add(impq + j + 1, p0[4 * g4 + 3], __ATOMIC_RELAXED, __HIP_MEMORY_SCOPE_WORKGROUP);
                      __hip_atomic_fetch_add(impq + j + 8, ((p1[4 * g4] + p1[4 * g4 + 1]) + p1[4 * g4 + 2]) + p1[4 * g4 + 3], __ATOMIC_RELAXED, __HIP_MEMORY_SCOPE_WORKGROUP);
                      if (j + 9 < 256) __hip_atomic_fetch_add(impq + j + 9, p1[4 * g4 + 3], __ATOMIC_RELAXED, __HIP_MEMORY_SCOPE_WORKGROUP);
                  }
              }
          }, base, wave, lane, r32, hi);
    }
    GA_WAIT_BAR(0);
    for (int qi = 0; qi < 8; ++qi) {
        const int qq = wave * 8 + qi; const LAS float* iq = imp + qq * 256;
        float v[4];
#pragma unroll
        for (int k = 0; k < 4; ++k) { const int j = lane + 64 * k; v[k] = j <= jt ? ((j == 0 || j == jt || j == jt - 1) ? 1.0e4f : iq[j]) : -1.0f; }
        for (int it = 0; it < 16; ++it) {
            float bv = -1.0f; int bj = 0;
#pragma unroll
            for (int k = 0; k < 4; ++k) if (v[k] > bv) { bv = v[k]; bj = lane + 64 * k; }
            const unsigned long long key = bv >= 0.f ? (((unsigned long long)__float_as_uint(bv) << 32) | (unsigned)(0xFFFFFFFFu - (unsigned)bj)) : 0ull;
            const unsigned long long best = wave_max_u64(key);
            if (best == 0ull) break;
            const int wj = (int)(0xFFFFFFFFu - (unsigned)best);
#pragma unroll
            for (int k = 0; k < 4; ++k) if (wj == lane + 64 * k) v[k] = -1.0f;
            if (lane == 0) { __hip_atomic_fetch_or(selm + qq * 8 + (wj >> 5), 1u << (wj & 31), __ATOMIC_RELAXED, __HIP_MEMORY_SCOPE_WORKGROUP); __hip_atomic_fetch_or(um + (wj >> 5), 1u << (wj & 31), __ATOMIC_RELAXED, __HIP_MEMORY_SCOPE_WORKGROUP); }
        }
    }
    GA_WAIT_BAR(0);
    int nts;
    { unsigned u[8]; int pre[8]; int tot = 0;
#pragma unroll
      for (int w = 0; w < 8; ++w) { u[w] = um[w]; pre[w] = tot; tot += __builtin_popcount(u[w]); }
      nts = __builtin_amdgcn_readfirstlane(tot);
      if (tid < 256) { const int w = tid >> 5, bit = tid & 31; unsigned uw = 0; int pw_ = 0;
#pragma unroll
          for (int k = 0; k < 8; ++k) if (k == w) { uw = u[k]; pw_ = pre[k]; }
          if ((uw >> bit) & 1u) tl[pw_ + __builtin_popcount(uw & ((1u << bit) - 1u))] = tid * 64; }
    }
    GA_WAIT_BAR(0);
    LAS float* stash = (LAS float*)(base + L_VAR) + wave * 2048;
    stash_o(stash, c, gc_rl, false, base, wave, r32, hi);
    { core_reset(c);
      TileDma dma; dma.init(pb + C_NKV + 2 * 128 + g * 64, NPROJ, pb + C_NKV + 3 * 128 + g * 64, NPROJ, base, wave, lane);
      const LAS unsigned* sq = selm + ql * 8;
      run_tiles(c, dma, NPROJ, NPROJ, nts, [=](int i) { return __builtin_amdgcn_readfirstlane(tl[i]); },
          [=](f32x16& p0, f32x16& p1, int i) {
              const int tr = __builtin_amdgcn_readfirstlane(tl[i]), J = tr >> 6;
              const bool sel = (sq[J >> 5] >> (J & 31)) & 1u;
              int d0 = sel ? tr + 4 * hi - t : 1 << 20; float sl = slope; asm volatile("" : "+v"(sl), "+v"(d0));
#pragma unroll
              for (int r = 0; r < 16; ++r) { const int d = d0 + (r & 3) + 8 * (r >> 2); p0[r] = d <= 0 ? __builtin_fmaf(sl, (float)d, p0[r]) : -INFINITY; p1[r] = d + 32 <= 0 ? __builtin_fmaf(sl, (float)(d + 32), p1[r]) : -INFINITY; }
          }, base, wave, lane, r32, hi);
      const float ls = row_l(c);
      stash_o(stash, c, ls > 0.f ? gb_ / ls : 0.f, true, base, wave, r32, hi);
    }
    { core_reset(c);
      TileDma dma; dma.init(pb + C_NKV + 4 * 128 + g * 64, NPROJ, pb + C_NKV + 5 * 128 + g * 64, NPROJ, base, wave, lane);
      const int first = q0 >= 512 ? q0 - 512 : 0, ntw = (q0 - first) / 64 + 1;
      run_tiles(c, dma, NPROJ, NPROJ, ntw, [=](int i) { return first + i * 64; },
          [=](f32x16& p0, f32x16& p1, int i) {
              int d0 = first + i * 64 + 4 * hi - t; float sl = slope; asm volatile("" : "+v"(sl), "+v"(d0));
#pragma unroll
              for (int r = 0; r < 16; ++r) { const int d = d0 + (r & 3) + 8 * (r >> 2); p0[r] = (d <= 0 && d > -512) ? __builtin_fmaf(sl, (float)d, p0[r]) : -INFINITY; p1[r] = (d + 32 <= 0 && d + 32 > -512) ? __builtin_fmaf(sl, (float)(d + 32), p1[r]) : -INFINITY; }
          }, base, wave, lane, r32, hi);
      const float lw = row_l(c);
      stash_o(stash, c, lw > 0.f ? gc_ / lw : 0.f, true, base, wave, r32, hi);
    }
    bf16* ob = F_O + ((size_t)b * S + q0 + wave * 8) * D + (8 + g * 4) * 64;
    store_stash(stash, lane, [ob](int r) { return ob + (size_t)(r >> 2) * D + (r & 3) * 64; });
    GA_WAIT_BAR(0);
}
}
#define ATTN_QUEUE(kind, n_units, ...) do { for (;;) { \
        if (tid == 0) F.MISC[0] = __hip_atomic_fetch_add(F.ctl + CW_Q + 64 * (layer + 2 * rep) + 8 * (kind), 1u, RLX_AGENT); \
        __syncthreads(); const int it = (int)F.MISC[0]; __syncthreads(); \
        if (it >= (n_units)) break; __VA_ARGS__; } } while (0)
__device__ __forceinline__ void moba_gate_phase(Frame& F) {
    for (int it = blockIdx.x; it < 2 * 8 * 64; it += F.G) { const int own = it / 16, bh = it % 16; ga::moba_gate_unit(F, bh >> 3, bh & 7, own); }
}
__device__ __forceinline__ void attn_phase(Frame& F, int layer, int rep) {
    PHASE_IDS;
    constexpr int N_FOX = 2 * 12 * 64, N_NSA = 2 * 2 * 256, N_MOBA = 2 * 8 * 64, N_MEM = 2 * 4 * 64;
    ATTN_QUEUE(0, N_FOX, { const int qb = 63 - it / 24, bh = it % 24; ga::fox_unit(F, bh / 12, bh % 12, qb); });
    ATTN_QUEUE(2, N_NSA, { const int qblk = 255 - it / 4, bg = it % 4; ga::nsa_unit(F, bg >> 1, bg & 1, qblk); });
    ATTN_QUEUE(1, N_MOBA - 16, { const int J = it / 16, bh = it % 16; ga::moba_gather_unit(F, bh >> 3, bh & 7, J); });
    ATTN_QUEUE(4, N_MOBA, { const int own = it / 16, bh = it % 16; ga::moba_own_unit(F, bh >> 3, bh & 7, own); });
    ATTN_QUEUE(3, N_MEM, { const int qb = it / 8, bh = it % 8; ga::mem_unit(F, layer, bh >> 2, bh & 3, qb); });
}
__device__ __forceinline__ void moba_merge_phase(Frame& F) {
    PHASE_IDS;
    for (int i = blockIdx.x * NTHR + tid; i < 2 * 8 * S * 8; i += F.G * NTHR) {
        const int ch = i & 7; const size_t ri = (size_t)(i >> 3);
        const int t = (int)(ri % S), bh = (int)(ri / S), b = bh >> 3, h = bh & 7;
        const f32x4 ls = *(const f32x4*)(F_LSE + ri * 4);
        const float mx = fmaxf(fmaxf(ls.x, ls.y), fmaxf(ls.z, ls.w));
        const float w0 = ex2(ls.x - mx), w1 = ex2(ls.y - mx), w2 = ex2(ls.z - mx), w3 = ex2(ls.w - mx); const float rs = 1.0f / (w0 + w1 + w2 + w3);
        const float wn[4] = {w0 * rs, w1 * rs, w2 * rs, w3 * rs}; const float lv[4] = {ls.x, ls.y, ls.z, ls.w};
        float acc[8];
#pragma unroll
        for (int k = 0; k < 8; ++k) acc[k] = 0.f;
#pragma unroll
        for (int n = 0; n < 4; ++n) if (lv[n] > -INFINITY) {
            const uint4 v = *(const uint4*)(F_PART + (ri * 4 + n) * 64 + ch * 8);
            acc[0] += wn[n] * blo(v.x); acc[1] += wn[n] * bhi(v.x); acc[2] += wn[n] * blo(v.y); acc[3] += wn[n] * bhi(v.y); acc[4] += wn[n] * blo(v.z); acc[5] += wn[n] * bhi(v.z); acc[6] += wn[n] * blo(v.w); acc[7] += wn[n] * bhi(v.w); }
        *(uint4*)(F_O + ((size_t)b * S + t) * D + h * 64 + ch * 8) = make_uint4(pk2(acc[0], acc[1]), pk2(acc[2], acc[3]), pk2(acc[4], acc[5]), pk2(acc[6], acc[7]));
    }
}

__device__ __forceinline__ bool in_range(int lo, int hi, int k) { asm volatile("" : "+s"(lo), "+s"(hi), "+s"(k)); return lo <= k && k < hi; }
constexpr int N_STEPS = 1 + NLAYER * 12;
template <int PH> __device__ __forceinline__ void run_phase(Frame& F, const Args& args, int l, int half) {
    unsigned char* ws_ = args.ws; asm volatile("" : "+s"(ws_));
    if constexpr (PH == 0) { p0_prologue(F); }
    if constexpr (PH == 1) {
        pg8::Gemm g{F_HB, F_WIN + (size_t)l * NPROJ * D, M, NPROJ, D, 0}; pg8::StaticOrder So; So.init(M, NPROJ, F.G, (int)blockIdx.x);
        pg8::EpiBf16<0> E{F_PROJ, NPROJ, nullptr, 0, 0, 1.f};
        pg8::gemm_phase<pg8::EpiBf16<0>, pg8::StaticOrder, PG8_ALIGN, PG8_SP2>(F.lds + RING_OFF, g, So, E);
    }
    if constexpr (PH == 2) { prep_phase(F, l); }
    if constexpr (PH == 3) { attn_phase(F, l, half); }
    if constexpr (PH == 4) {
        pg8::Gemm g{F_O, F_WOUT + (size_t)l * D * D, M, D, D, 0}; pg8::StaticOrder So; So.init(M, D, F.G, (int)blockIdx.x);
        pg8::EpiResF32 E{F_HR, D, ALPHA};
        pg8::gemm_phase<pg8::EpiResF32, pg8::StaticOrder, PG8_ALIGN, PG8_SP2>(F.lds + RING_OFF, g, So, E);
    }
    if constexpr (PH == 5) { ln_phase(F, F_HR, F_IN(11) + (size_t)l * D, F_IN(12) + (size_t)l * D); }
    if constexpr (PH == 6) {
        pg8::Gemm g{F_HB, F_WUP + (size_t)l * NUP * D, 130 * 256, NUP, D, 1}; pg8::StaticOrder So; So.init(130 * 256, NUP, F.G, (int)blockIdx.x);
        pg8::EpiConvAct E{F_ACT, DFF, F_IN(14) + (size_t)l * 3 * DFF, F_IN(15) + (size_t)l * DFF, DFF, (PG8_LAS float*)(F.lds + XB_OFF)};
        pg8::gemm_phase<pg8::EpiConvAct, pg8::StaticOrder, PG8_ALIGN, PG8_SP2>(F.lds + RING_OFF, g, So, E);
    }
    if constexpr (PH == 8) {
        pg8::Gemm g{F_ACT, F_WDN + (size_t)l * D * DFF, M, D, DFF, 0}; pg8::StaticOrder So; So.init(M, D, F.G, (int)blockIdx.x);
        pg8::EpiResF32 E{F_HR, D, ALPHA};
        pg8::gemm_phase<pg8::EpiResF32, pg8::StaticOrder, PG8_ALIGN, PG8_SP2>(F.lds + RING_OFF, g, So, E);
    }
    if constexpr (PH == 9) { ln_phase(F, F_HR, F_IN(17) + (size_t)l * D, F_IN(18) + (size_t)l * D); }
    if constexpr (PH == 10) { moba_gate_phase(F); }
    if constexpr (PH == 11) { moba_merge_phase(F); }
}
template <int PH> __global__ void __launch_bounds__(NTHR, 2) k_phase(Args args, int l, int half) {
    extern __shared__ __attribute__((aligned(16))) unsigned char lds[];
    Frame F;
    F.lds = (LAS unsigned char*)lds;
    F.MISC = (volatile LAS unsigned*)(F.lds + MISC_OFF);
    F.G = gridDim.x;
    F.A = &args;
    F.ctl = (gu32*)(args.ws + WS_CTL);
    for (int u = threadIdx.x; u < (LDS_BYTES - LDSCTL_OFF) / 4; u += NTHR) ((LAS unsigned*)(F.lds + LDSCTL_OFF))[u] = 0u;
    __syncthreads();
    run_phase<PH>(F, args, l, half);
}

__global__ void __launch_bounds__(NTHR, 2) hybrid_fwd(Args args) {
    extern __shared__ __attribute__((aligned(16))) unsigned char lds[];
    Frame F;
    F.lds = (LAS unsigned char*)lds;
    F.MISC = (volatile LAS unsigned*)(F.lds + MISC_OFF);
    F.G = gridDim.x;
    F.A = &args;
    F.ctl = (gu32*)(args.ws + WS_CTL);
    for (int u = threadIdx.x; u < (LDS_BYTES - LDSCTL_OFF) / 4; u += NTHR) ((LAS unsigned*)(F.lds + LDSCTL_OFF))[u] = 0u;
    __syncthreads();
    XcdBarrier bar = xcd_barrier_post((unsigned*)(F.ctl + CW_BAR), F.MISC + 8);
#define PHASE(PH, l, h) do { run_phase<PH>(F, args, (l), (h)); xcd_barrier(bar); } while (0)
#define LAYER(l) do { PHASE(1, l, 0); PHASE(2, l, 0); PHASE(10, l, 0); PHASE(3, l, 0); PHASE(11, l, 0); PHASE(4, l, 0); PHASE(5, l, 0); \
        PHASE(6, l, 0); PHASE(8, l, 0); } while (0)
    PHASE(0, 0, 0);
    LAYER(0); PHASE(9, 0, 0);
    LAYER(1); run_phase<9>(F, args, 1, 0);
#undef PHASE
#undef LAYER
}

template <int PH> static bool set_lds_one() { return hipFuncSetAttribute((const void*)k_phase<PH>, hipFuncAttributeMaxDynamicSharedMemorySize, LDS_BYTES) == hipSuccess; }
static bool set_lds_all() { return hipFuncSetAttribute((const void*)hybrid_fwd, hipFuncAttributeMaxDynamicSharedMemorySize, LDS_BYTES) == hipSuccess && set_lds_one<0>() && set_lds_one<1>() && set_lds_one<2>() && set_lds_one<3>() && set_lds_one<4>() && set_lds_one<5>() && set_lds_one<6>() && set_lds_one<7>() && set_lds_one<8>() && set_lds_one<9>() && set_lds_one<10>() && set_lds_one<11>(); }
extern "C" void kernel_launch(void* const* d_in, const int* in_sizes, int n_in, void* d_out, int out_size, void* d_ws, size_t ws_size, hipStream_t stream) {
    static int grid = 0;
    if (grid == 0) {
        if (n_in != 19 || in_sizes[0] != M * D || out_size != M * D || ws_size < WS_END) { fprintf(stderr, "kernel_launch: unexpected shapes (n_in %d, in0 %d, out %d, ws %zu)\n", n_in, n_in > 0 ? in_sizes[0] : -1, out_size, ws_size); grid = -1; return; }
        int dev = 0, cus = 0;
        if (hipGetDevice(&dev) != hipSuccess || hipDeviceGetAttribute(&cus, hipDeviceAttributeMultiprocessorCount, dev) != hipSuccess) { grid = -1; return; }
        if (!set_lds_all()) { fprintf(stderr, "kernel_launch: hipFuncSetAttribute failed\n"); grid = -1; return; }
        (void)hipGetLastError();
        grid = cus;
    }
    if (grid < 0) return;
    if (hipMemsetAsync((char*)d_ws + WS_CTL, 0, CTL_ZERO_BYTES, stream) != hipSuccess) return;
    Args a{};
    for (int i = 0; i < 19; ++i) a.in[i] = (const float*)d_in[i];
    a.out = (float*)d_out; a.ws = (unsigned char*)d_ws;
#if MK_ONE_LAUNCH
    hipLaunchKernelGGL(hybrid_fwd, dim3(grid), dim3(NTHR), LDS_BYTES, stream, a);
#else
#define LAUNCH(PH, l, h) hipLaunchKernelGGL(k_phase<PH>, dim3(grid), dim3(NTHR), LDS_BYTES, stream, a, (int)(l), (int)(h))
    LAUNCH(0, 0, 0);
    for (int l = 0; l < NLAYER; ++l) {
        LAUNCH(1, l, 0); LAUNCH(2, l, 0); LAUNCH(10, l, 0); LAUNCH(3, l, 0); LAUNCH(11, l, 0); LAUNCH(4, l, 0); LAUNCH(5, l, 0);
        LAUNCH(6, l, 0); LAUNCH(8, l, 0);
        LAUNCH(9, l, 0);
    }
#undef LAUNCH
#endif
}
```

```cpp
#include <hip/hip_runtime.h>
#include <cstdio>
#include <cstdint>
namespace pg8 {
#define PG8_LAS __attribute__((address_space(3)))
typedef unsigned short bf16_t;
typedef short bf16x8 __attribute__((ext_vector_type(8)));
typedef float f32x4 __attribute__((ext_vector_type(4)));
typedef unsigned u32x4 __attribute__((ext_vector_type(4)));
constexpr int BM = 256, BK = 64, HALF = 128, HTB = HALF * BK * 2  , STAGE_BYTES = 8 * HTB, NXCD = 8, WGM = 8;

__host__ __device__ __forceinline__ int lds_byte(int r, int c) { const int st = (r >> 4) * 2 + (c >> 5), rr = r & 15, cc = c & 31, ob = rr * 64 + cc * 2; return st * 1024 + (ob ^ (((ob >> 9) & 1) << 5)); }
__host__ __device__ __forceinline__ void stage_rc(int b, int& R, int& C) { const int st = b / 1024, sb = b % 1024, swz = sb ^ (((sb >> 9) & 1) << 5); R = (st >> 1) * 16 + swz / 64; C = (st & 1) * 32 + (swz % 64) / 2; }
__host__ __device__ __forceinline__ int perm32(int rho) { const int n = rho >> 4, i = rho & 15; return 8 * (i >> 2) + 4 * n + (i & 3); }

struct Unit { int pm, pn; };
struct Gemm { const bf16_t* A; const bf16_t* Bt; int M, N, K; int amode; };
__device__ __forceinline__ long a_row0(const Gemm& g, int pm) { return g.amode == 0 ? (long)pm * BM : (long)(pm / 65) * 16384 + (long)(pm % 65) * 254 - 2; }

struct StaticOrder {
    int nM, nN, nwg, G, c;
    __host__ __device__ void init(int M, int N, int G_, int c_) { nM = M / BM; nN = N / BM; nwg = nM * nN; G = G_; c = c_; }
    __host__ __device__ bool next(int i, Unit& u) const {
        const long L = (long)i * G + c; if (L >= nwg) return false;
        int wgid = (int)L; { const int q = nwg / NXCD, r = nwg % NXCD, xcd = wgid % NXCD, off = wgid / NXCD; wgid = (xcd < r ? xcd * (q + 1) : r * (q + 1) + (xcd - r) * q) + off; }
        const int nig = WGM * nN, gid = wgid / nig, fm = gid * WGM, gsz = (nM - fm) < WGM ? (nM - fm) : WGM;
        u.pm = fm + ((wgid % nig) % gsz); u.pn = (wgid % nig) / gsz; return true;
    }
    __device__ __forceinline__ void a_ready(const Unit&) const {}
    __device__ __forceinline__ void done(const Unit&) const {}
};

__device__ __forceinline__ unsigned cvt_pk_bf16(float lo, float hi) { unsigned r; asm volatile("v_cvt_pk_bf16_f32 %0, %1, %2" : "=v"(r) : "v"(lo), "v"(hi)); return r; }
typedef float f32x2 __attribute__((ext_vector_type(2)));
__device__ __forceinline__ f32x2 gelu_pk(f32x2 v) {
    const f32x2 av = __builtin_elementwise_abs(v), d = av * 0.2316418882f + 1.0f;
    f32x2 t; t.x = __builtin_amdgcn_rcpf(d.x); t.y = __builtin_amdgcn_rcpf(d.y);
    f32x2 q = t * 0.5307027145f + (-0.7265760135f); q = q * t + 0.7107068705f; q = q * t + (-0.142248368f); q = q * t + 0.127414796f; q = q * t;
    const f32x2 s = (v * v) * (-0.72134752044f);
    f32x2 e; e.x = __builtin_amdgcn_exp2f(s.x); e.y = __builtin_amdgcn_exp2f(s.y);
    const f32x2 m = v * (q * e), r = v - m;
    f32x2 o; o.x = v.x < 0.f ? m.x : r.x; o.y = v.y < 0.f ? m.y : r.y; return o;
}

template <int ACT  > struct EpiBf16 {
    static constexpr bool PERM = true, AFTER_DRAIN = false; static_assert(ACT == 0 || ACT == 1, "EpiBf16: ACT is 0 (none) or 1 (gelu_pk)");
    bf16_t* O; int ldc; const float* bias; int split_cols; size_t split_stride; float scale0;
    __device__ __forceinline__ void operator()(const f32x4 (&acc)[2][2][4][2], const Unit& u, int wr, int wc, int fr, int fq) const {
        const int row0 = u.pm * BM + wr * 64 + fr; int colt = u.pn * BM; bf16_t* base = O;
        float sc = 1.f; if (split_cols) { const int t = colt / split_cols; base += (size_t)t * split_stride; colt -= t * split_cols; if (t == 0) sc = scale0; }
        const int col0 = colt + wc * 32 + 8 * fq, bcol0 = u.pn * BM + wc * 32 + 8 * fq;
        f32x4 bv[2][2];
#pragma unroll
        for (int bj = 0; bj < 2; ++bj)
#pragma unroll
            for (int n = 0; n < 2; ++n) bv[bj][n] = bias ? *(const f32x4*)(bias + bcol0 + bj * HALF + 4 * n) : (f32x4){0.f, 0.f, 0.f, 0.f};
#pragma unroll
        for (int ai = 0; ai < 2; ++ai)
#pragma unroll
            for (int m = 0; m < 4; ++m) { bf16_t* rowp = base + (size_t)(row0 + ai * HALF + m * 16) * ldc + col0;
#pragma unroll
                for (int bj = 0; bj < 2; ++bj) { f32x4 v0 = acc[ai][bj][m][0] + bv[bj][0], v1 = acc[ai][bj][m][1] + bv[bj][1];
                    if (ACT == 1) { f32x2 a = gelu_pk((f32x2){v0[0], v0[1]}), b = gelu_pk((f32x2){v0[2], v0[3]}), c = gelu_pk((f32x2){v1[0], v1[1]}), d = gelu_pk((f32x2){v1[2], v1[3]});
                        v0 = (f32x4){a.x, a.y, b.x, b.y}; v1 = (f32x4){c.x, c.y, d.x, d.y}; }
                    v0 = v0 * sc; v1 = v1 * sc; u32x4 w; w.x = cvt_pk_bf16(v0[0], v0[1]); w.y = cvt_pk_bf16(v0[2], v0[3]); w.z = cvt_pk_bf16(v1[0], v1[1]); w.w = cvt_pk_bf16(v1[2], v1[3]);
                    *(u32x4*)(rowp + bj * HALF) = w; } }
    }
};


struct EpiResF32 {
    static constexpr bool PERM = false, AFTER_DRAIN = false;
    float* out; int ldc; float alpha;
    __device__ __forceinline__ void operator()(const f32x4 (&acc)[2][2][4][2], const Unit& u, int wr, int wc, int fr, int fq) const {
        const int col0 = u.pn * BM + wc * 32 + 4 * fq;
#pragma unroll
        for (int ai = 0; ai < 2; ++ai)
#pragma unroll
            for (int m = 0; m < 4; ++m) { float* rowp = out + (size_t)(u.pm * BM + ai * HALF + wr * 64 + m * 16 + fr) * ldc + col0;
#pragma unroll
                for (int bj = 0; bj < 2; ++bj)
#pragma unroll
                    for (int n = 0; n < 2; ++n) { f32x4* p = (f32x4*)(rowp + bj * HALF + n * 16); const f32x4 b = *p; *p = b * alpha + acc[ai][bj][m][n]; }
                asm volatile("" ::: "memory"); }
    }
};

template <int C> __device__ __forceinline__ f32x4 ror4(const f32x4 v) { f32x4 r;
#pragma unroll
    for (int i = 0; i < 4; ++i) r[i] = __int_as_float(__builtin_amdgcn_update_dpp(0, __float_as_int(v[i]), C, 0xF, 0xF, true));
    return r; }
struct EpiConvAct {
    static constexpr bool PERM = true, AFTER_DRAIN = false;
    bf16_t* O; int ldc; const float* cw; const float* cb; int dff; PG8_LAS float* xb;
    __device__ __forceinline__ static float gelu_t(float x) { const float y = 0.7978845608028654f * (x + 0.044715f * x * x * x); const float e = __builtin_amdgcn_exp2f(y * 2.885390081777927f); return 0.5f * x * (2.0f - 2.0f * __builtin_amdgcn_rcpf(e + 1.0f)); }
    __device__ __forceinline__ void operator()(const f32x4 (&acc)[2][2][4][2], const Unit& u, int wr, int wc, int fr_, int fq_) const {
        int fr = fr_, fq = fq_; asm volatile("" : "+v"(fr), "+v"(fq));
        if (fr >= 14) {
#pragma unroll
            for (int ai = 0; ai < 2; ++ai)
#pragma unroll
                for (int n = 0; n < 2; ++n) *(PG8_LAS f32x4*)(xb + ((((ai * 2 + wr) * 4 + wc) * 2 + (fr - 14)) * 4 + fq) * 8 + n * 4) = acc[ai][1][3][n];
        }
        asm volatile("s_waitcnt lgkmcnt(0)" ::: "memory"); __builtin_amdgcn_s_barrier(); asm volatile("" ::: "memory");
        const int seq = u.pm / 65, kt = u.pm % 65; const int tbase = kt * 254 - 2 + wr * 64 + fr;
        const int c0 = u.pn * 128 + wc * 32 + 8 * fq;
        f32x4 w0[2], w1[2], w2[2], bb[2];
#pragma unroll
        for (int n = 0; n < 2; ++n) { w0[n] = *(const f32x4*)(cw + c0 + 4 * n); w1[n] = *(const f32x4*)(cw + dff + c0 + 4 * n); w2[n] = *(const f32x4*)(cw + 2 * dff + c0 + 4 * n); bb[n] = *(const f32x4*)(cb + c0 + 4 * n); }
#pragma unroll
        for (int ai = 0; ai < 2; ++ai) {
            f32x4 gp[2];
            const int pai = wr == 1 ? ai : ai - 1, pwr = wr ^ 1;
#pragma unroll
            for (int n = 0; n < 2; ++n) gp[n] = (fr >= 14 && pai >= 0) ? *(const PG8_LAS f32x4*)(xb + ((((pai * 2 + pwr) * 4 + wc) * 2 + (fr - 14)) * 4 + fq) * 8 + n * 4) : (f32x4){0.f, 0.f, 0.f, 0.f};
#pragma unroll
            for (int m = 0; m < 4; ++m) {
                const int trow = ai * 128 + wr * 64 + m * 16 + fr, t = tbase + ai * 128 + m * 16;
                unsigned pk[4];
#pragma unroll
                for (int n = 0; n < 2; ++n) {
                    const f32x4 g0 = acc[ai][1][m][n], gm = m == 0 ? gp[n] : acc[ai][1][m - 1][n];
                    const f32x4 a1 = ror4<0x121>(g0), b1 = ror4<0x121>(gm), a2 = ror4<0x122>(g0), b2 = ror4<0x122>(gm);
                    f32x4 p1 = fr >= 1 ? a1 : b1, p2 = fr >= 2 ? a2 : b2;
                    if (t < 1) p1 = (f32x4){0.f, 0.f, 0.f, 0.f};
                    if (t < 2) p2 = (f32x4){0.f, 0.f, 0.f, 0.f};
                    const f32x4 x = bb[n] + w0[n] * p2 + w1[n] * p1 + w2[n] * g0; const f32x4 uu = acc[ai][0][m][n];
                    pk[2 * n] = cvt_pk_bf16(gelu_t(x[0]) * uu[0], gelu_t(x[1]) * uu[1]); pk[2 * n + 1] = cvt_pk_bf16(gelu_t(x[2]) * uu[2], gelu_t(x[3]) * uu[3]);
                }
                if (trow >= 2 && t < 16384) { u32x4 w; w.x = pk[0]; w.y = pk[1]; w.z = pk[2]; w.w = pk[3]; *(u32x4*)(O + ((size_t)seq * 16384 + t) * ldc + c0) = w; }
            }
        }
        asm volatile("s_waitcnt lgkmcnt(0)" ::: "memory"); __builtin_amdgcn_s_barrier(); asm volatile("" ::: "memory");
    }
};
template <class Epi, class Sched, bool ALIGN_EPI = false, bool SP2 = false>
__device__ __forceinline__ void gemm_phase(PG8_LAS unsigned char* lds, const Gemm g, const Sched& S, const Epi& E) {
    int tid_ = threadIdx.x; asm volatile("" : "+v"(tid_));
    const int tid = tid_, wid = __builtin_amdgcn_readfirstlane(tid >> 6), lane = tid & 63, wr = wid >> 2, wc = wid & 3, fr = lane & 15, fq = lane >> 4;
    const int K = g.K, nt = K / BK;
    unsigned voffA[2], voffB[2];
#pragma unroll
    for (int i = 0; i < 2; ++i) { int R, C; stage_rc(tid * 16 + i * 8192, R, C); const int Rb = Epi::PERM ? ((R & ~31) + perm32(R & 31)) : R;
        voffA[i] = (unsigned)(R * K + C) * 2u; voffB[i] = (unsigned)(Rb * K + C) * 2u; }
    const size_t kstep = (size_t)(BK * 2);
    const size_t hstep = (size_t)HALF * K * 2;
    const size_t tstep = 2 * hstep;
    const unsigned ldsw = (unsigned)wid * 1024u;
    const int aoff = lds_byte(wr * 64 + fr, fq * 8), boff = lds_byte(wc * 32 + fr, fq * 8);
#define PG8_SA(b, h) (((b) * 2 + (h)) * HTB)
#define PG8_SB(b, h) ((4 + (b) * 2 + (h)) * HTB)
#define PG8_STAGE(bufoff, gbase, voff) do { _Pragma("unroll") for (int _i = 0; _i < 2; ++_i) \
        __builtin_amdgcn_global_load_lds((const unsigned*)((const char*)(gbase) + (voff)[_i]), (PG8_LAS unsigned*)(lds + (bufoff) + ldsw + _i * 8192), 16, 0, 0); } while (0)
#define PG8_LDA(dst, b, h) do { _Pragma("unroll") for (int m = 0; m < 4; ++m) _Pragma("unroll") for (int k = 0; k < 2; ++k) dst[m][k] = *(const PG8_LAS bf16x8*)(lds + PG8_SA(b, h) + aoff + m * 2048 + k * 1024); } while (0)
#define PG8_LDB(dst, b, h) do { _Pragma("unroll") for (int n = 0; n < 2; ++n) _Pragma("unroll") for (int k = 0; k < 2; ++k) dst[n][k] = *(const PG8_LAS bf16x8*)(lds + PG8_SB(b, h) + boff + n * 2048 + k * 1024); } while (0)
#define PG8_MMA(ai, bj, At, Bt) do { __builtin_amdgcn_s_setprio(1); _Pragma("unroll") for (int m = 0; m < 4; ++m) _Pragma("unroll") for (int n = 0; n < 2; ++n) _Pragma("unroll") for (int k = 0; k < 2; ++k) \
        acc[ai][bj][m][n] = __builtin_amdgcn_mfma_f32_16x16x32_bf16(Bt[n][k], At[m][k], acc[ai][bj][m][n], 0, 0, 0); __builtin_amdgcn_s_setprio(0); } while (0)
#define PG8_WAIT_V(n) asm volatile("s_waitcnt vmcnt(" #n ")" ::: "memory")
#define PG8_WAIT_L(n) asm volatile("s_waitcnt lgkmcnt(" #n ")" ::: "memory")
#define PG8_BAR __builtin_amdgcn_s_barrier()
#define PG8_SCHED __builtin_amdgcn_sched_barrier(0)
    Unit cur, nxt; int ui = 0;
    if (!S.next(0, cur)) return;
    f32x4 acc[2][2][4][2];
#pragma unroll
    for (int a = 0; a < 2; ++a)
#pragma unroll
        for (int b = 0; b < 2; ++b)
#pragma unroll
            for (int m = 0; m < 4; ++m)
#pragma unroll
                for (int n = 0; n < 2; ++n) acc[a][b][m][n] = (f32x4){0.f, 0.f, 0.f, 0.f};
    bf16x8 At[4][2], B0[2][2], B1[2][2];
    const char* cA = (const char*)g.A + a_row0(g, cur.pm) * (long)(K * 2); const char* cB = (const char*)g.Bt + (size_t)cur.pn * tstep;
    S.a_ready(cur);
    if constexpr (SP2) {
        PG8_STAGE(PG8_SB(0, 0), cB, voffB); PG8_STAGE(PG8_SB(0, 1), cB + hstep, voffB); PG8_STAGE(PG8_SA(0, 0), cA, voffA); PG8_STAGE(PG8_SA(0, 1), cA + hstep, voffA);
        if (wr == 1) PG8_BAR;
        PG8_WAIT_V(2); PG8_BAR;
        PG8_STAGE(PG8_SB(1, 0), cB + kstep, voffB); PG8_STAGE(PG8_SA(1, 0), cA + kstep, voffA); PG8_STAGE(PG8_SB(1, 1), cB + hstep + kstep, voffB);
        PG8_WAIT_V(6); PG8_BAR;
    } else {
        PG8_STAGE(PG8_SB(0, 0), cB, voffB); PG8_STAGE(PG8_SA(0, 0), cA, voffA); PG8_STAGE(PG8_SB(0, 1), cB + hstep, voffB); PG8_STAGE(PG8_SA(0, 1), cA + hstep, voffA);
        if (wr == 1) PG8_BAR;
        PG8_WAIT_V(4); PG8_BAR;
        PG8_STAGE(PG8_SB(1, 0), cB + kstep, voffB); PG8_STAGE(PG8_SA(1, 0), cA + kstep, voffA); PG8_STAGE(PG8_SB(1, 1), cB + hstep + kstep, voffB);
        PG8_WAIT_V(6); PG8_BAR;
    }
    for (;;) {
        const bool has_next = S.next(ui + 1, nxt);
        const char* nA = has_next ? (const char*)g.A + a_row0(g, nxt.pm) * (long)(K * 2) : cA; const char* nB = has_next ? (const char*)g.Bt + (size_t)nxt.pn * tstep : cB;
        for (int t = 0; t < nt; t += 2) {
            const bool last = (t == nt - 2);
            const char* a1 = cA + (size_t)(t + 1) * kstep;
            const char* a2 = last ? nA : cA + (size_t)(t + 2) * kstep; const char* b2 = last ? nB : cB + (size_t)(t + 2) * kstep;
            const char* a3 = a2 + kstep; const char* b3 = b2 + kstep;
            if (last && has_next) S.a_ready(nxt);
            if constexpr (SP2) {
            PG8_LDB(B0, 0, 0); PG8_LDB(B1, 0, 1); PG8_SCHED; PG8_LDA(At, 0, 0); PG8_STAGE(PG8_SA(1, 1), a1 + hstep, voffA);
            PG8_WAIT_V(8); PG8_WAIT_L(0); PG8_BAR; PG8_MMA(0, 0, At, B0); PG8_MMA(0, 1, At, B1); PG8_BAR; PG8_SCHED;
            PG8_LDA(At, 0, 1); PG8_STAGE(PG8_SB(0, 0), b2, voffB); PG8_STAGE(PG8_SB(0, 1), b2 + hstep, voffB); PG8_STAGE(PG8_SA(0, 0), a2, voffA);
            PG8_WAIT_V(8); PG8_WAIT_L(0); PG8_BAR; PG8_MMA(1, 0, At, B0); PG8_MMA(1, 1, At, B1); PG8_BAR; PG8_SCHED;
            PG8_LDB(B0, 1, 0); PG8_LDB(B1, 1, 1); PG8_SCHED; PG8_LDA(At, 1, 0); PG8_STAGE(PG8_SA(0, 1), a2 + hstep, voffA);
            PG8_WAIT_V(8); PG8_WAIT_L(0); PG8_BAR; PG8_MMA(0, 0, At, B0); PG8_MMA(0, 1, At, B1); PG8_BAR; PG8_SCHED;
            PG8_LDA(At, 1, 1); PG8_STAGE(PG8_SB(1, 0), b3, voffB); PG8_STAGE(PG8_SB(1, 1), b3 + hstep, voffB); PG8_STAGE(PG8_SA(1, 0), a3, voffA);
            PG8_WAIT_V(8); PG8_WAIT_L(0); PG8_BAR; PG8_MMA(1, 0, At, B0); PG8_MMA(1, 1, At, B1); PG8_BAR; PG8_SCHED;
            } else {
            PG8_LDB(B0, 0, 0); PG8_SCHED; PG8_LDA(At, 0, 0); PG8_STAGE(PG8_SA(1, 1), a1 + hstep, voffA);
            PG8_WAIT_L(8); PG8_BAR; PG8_WAIT_L(0); PG8_MMA(0, 0, At, B0); PG8_BAR; PG8_SCHED;
            PG8_LDB(B1, 0, 1); PG8_STAGE(PG8_SB(0, 0), b2, voffB);
            PG8_BAR; PG8_WAIT_L(0); PG8_MMA(0, 1, At, B1); PG8_BAR;
            PG8_LDA(At, 0, 1); PG8_STAGE(PG8_SA(0, 0), a2, voffA);
            PG8_BAR; PG8_WAIT_L(0); PG8_MMA(1, 0, At, B0); PG8_BAR; PG8_SCHED;
            PG8_STAGE(PG8_SB(0, 1), b2 + hstep, voffB);
            PG8_WAIT_V(6); PG8_BAR; PG8_MMA(1, 1, At, B1); PG8_BAR;
            PG8_LDB(B0, 1, 0); PG8_SCHED; PG8_LDA(At, 1, 0); PG8_STAGE(PG8_SA(0, 1), a2 + hstep, voffA);
            PG8_WAIT_L(8); PG8_BAR; PG8_WAIT_L(0); PG8_MMA(0, 0, At, B0); PG8_BAR; PG8_SCHED;
            PG8_LDB(B1, 1, 1); PG8_STAGE(PG8_SB(1, 0), b3, voffB);
            PG8_BAR; PG8_WAIT_L(0); PG8_MMA(0, 1, At, B1); PG8_BAR;
            PG8_LDA(At, 1, 1); PG8_STAGE(PG8_SA(1, 0), a3, voffA);
            PG8_BAR; PG8_WAIT_L(0); PG8_MMA(1, 0, At, B0); PG8_BAR; PG8_SCHED;
            PG8_STAGE(PG8_SB(1, 1), b3 + hstep, voffB);
            PG8_WAIT_V(6); PG8_BAR; PG8_MMA(1, 1, At, B1); PG8_BAR;
            }
        }
        if constexpr (ALIGN_EPI) { if (wr == 0) PG8_BAR; }
        if constexpr (!Epi::AFTER_DRAIN) { E(acc, cur, wr, wc, fr, fq); S.done(cur); }
        if (!has_next) break;
#pragma unroll
        for (int a = 0; a < 2; ++a)
#pragma unroll
            for (int b = 0; b < 2; ++b)
#pragma unroll
                for (int m = 0; m < 4; ++m)
#pragma unroll
                    for (int n = 0; n < 2; ++n) acc[a][b][m][n] = (f32x4){0.f, 0.f, 0.f, 0.f};
        cur = nxt; cA = nA; cB = nB; ++ui;
        if constexpr (ALIGN_EPI) { if (wr == 1) PG8_BAR; }
    }
    PG8_WAIT_V(0);
    if constexpr (!ALIGN_EPI) { if (wr == 0) PG8_BAR; }
    PG8_BAR;
    if constexpr (Epi::AFTER_DRAIN) { E.fused(acc, cur, wr, wc, fr, fq, lds, wid, lane); S.done(cur); }
#undef PG8_SA
#undef PG8_SB
#undef PG8_STAGE
#undef PG8_LDA
#undef PG8_LDB
#undef PG8_MMA
#undef PG8_WAIT_V
#undef PG8_WAIT_L
#undef PG8_BAR
#undef PG8_SCHED
}
}

#ifndef PG8_SP2
#define PG8_SP2 true
#endif
#ifndef PG8_ALIGN
#define PG8_ALIGN true
#endif
#ifndef MK_ONE_LAUNCH
#define MK_ONE_LAUNCH 1
#endif

constexpr int NWAVES = 8, NTHR = NWAVES * 64;
constexpr int NB = 2, S = 16384, D = 2048, M = NB * S, NLAYER = 2;
constexpr int NPROJ = 5632, NIN = 5412;
constexpr int DFF = 5632, NUP = 2 * DFF;
constexpr int MH = S;
constexpr int C_MQ = 0, C_MK = 512, C_MV = 1024, C_NQ = 1536, C_NKV = 2048, C_FQ = 2816, C_FK = 3584, C_FV = 4352, C_EQ = 5120, C_GATE = 5376, C_FF = 5400;
constexpr float LN_EPS = 1e-5f;
constexpr float ALPHA = 1.41421356237309515f;
constexpr float LOG2E = 1.4426950408889634f;
constexpr float C2 = 0.125f * LOG2E;
constexpr int NCMP = 1023, NCMP_PAD = 1024;

constexpr size_t MiB = 1u << 20;
constexpr size_t WS_CTL = 0, CTL_ZERO_BYTES = 1 * MiB;
constexpr size_t WS_WIN = 1 * MiB, WS_WOUT = 45 * MiB, WS_WUP = 61 * MiB, WS_WDN = 149 * MiB;
constexpr size_t WS_HB = 193 * MiB;
constexpr size_t WS_R = 321 * MiB;
constexpr size_t WS_PROJ = WS_R, WS_O = WS_R + 352 * MiB, WS_UG = WS_R, WS_ACT = WS_R;
constexpr size_t WS_KCMP = 849 * MiB;
constexpr size_t WS_MEMKV = 851 * MiB;
constexpr size_t WS_KMEAN = 853 * MiB;
constexpr size_t WS_FOXC = 854 * MiB;
constexpr size_t WS_MEMKVB = 857 * MiB;
constexpr size_t WS_KMEANB = 858 * MiB;
constexpr size_t WS_KCMPB = 859 * MiB;
constexpr size_t WS_PART = 864 * MiB;
constexpr size_t WS_LSE = 992 * MiB;
constexpr size_t WS_MSEL = 996 * MiB;
constexpr size_t WS_FOXN = 997 * MiB;
constexpr size_t WS_W1T = 998 * MiB;
constexpr size_t WS_W2B = 997 * MiB + 65536;
constexpr size_t WS_HBIAS = 997 * MiB + 262144;
constexpr size_t WS_END = 1000 * MiB;
constexpr int CW_TMO = 0, CW_CODE = 1, CW_BAR = 4096, CW_Q = 8192, CW_FOXN = 12288;

constexpr int RING_OFF = 0, RING_BYTES = 131072;
constexpr int LDSCTL_OFF = 146432, MISC_OFF = LDSCTL_OFF + 320;
constexpr int SEL_OFF = RING_BYTES + 1024;
constexpr int XB_OFF = RING_BYTES;
constexpr int LDS_BYTES = 147456;

#define GAS __attribute__((address_space(1)))
#define LAS __attribute__((address_space(3)))
typedef unsigned short bf16;
typedef unsigned v4u __attribute__((ext_vector_type(4)));
typedef float f32x4 __attribute__((ext_vector_type(4)));
typedef GAS unsigned gu32;
#define RLX_AGENT __ATOMIC_RELAXED, __HIP_MEMORY_SCOPE_AGENT
#define LDS_WAIT() asm volatile("s_waitcnt lgkmcnt(0)" ::: "memory")
__device__ __forceinline__ unsigned f2bf(float f) { unsigned u = __builtin_bit_cast(unsigned, f); return (u + 0x7fffu + ((u >> 16) & 1u)) >> 16; }
__device__ __forceinline__ unsigned pk2(float lo, float hi) { return f2bf(lo) | (f2bf(hi) << 16); }
__device__ __forceinline__ float blo(unsigned u) { return __uint_as_float(u << 16); }
__device__ __forceinline__ float bhi(unsigned u) { return __uint_as_float(u & 0xffff0000u); }
__device__ __forceinline__ float bf2f(bf16 v) { return __uint_as_float((unsigned)v << 16); }
__device__ __forceinline__ float ex2(float x) { return __builtin_amdgcn_exp2f(x); }
__device__ __forceinline__ float gelu_tanh(float x) {
    const float y = 0.7978845608028654f * (x + 0.044715f * x * x * x);
    const float e = __expf(2.0f * y);
    const float th = 1.0f - 2.0f / (e + 1.0f);
    return 0.5f * x * (1.0f + th);
}
#define XB_TMO      128
#define XB_XCNT(j)  (256  + 64 * (j))
#define XB_XSUB(j)  (1280 + 64 * (j))
#define XB_XGEN(j)  (2304 + 64 * (j))
#define XB_TOP      3328
#define XB_TOPGEN   3392
#define XCD_BAR_WORDS 3456
#define XB_SPIN_CAP (1u << 18)

__device__ __forceinline__ unsigned xb_ld(unsigned* p)              { return __hip_atomic_load(p, __ATOMIC_RELAXED, __HIP_MEMORY_SCOPE_AGENT); }
__device__ __forceinline__ unsigned xb_add(unsigned* p, unsigned v) { return __hip_atomic_fetch_add(p, v, __ATOMIC_RELAXED, __HIP_MEMORY_SCOPE_AGENT); }
__device__ __forceinline__ unsigned xb_xcc_id() { return (unsigned)__builtin_amdgcn_s_getreg((3 << 11) | 20) & 0xFu; }
#define XB_SPIN(cond, bar) do { unsigned _sp = 0; while (cond) { __builtin_amdgcn_s_sleep(1); \
    if ((++_sp & 255u) == 0u) { if (xb_ld(&(bar)[XB_TMO])) break; if (_sp > XB_SPIN_CAP) { atomicAdd(&(bar)[XB_TMO], 1u); break; } } } } while (0)

struct XcdBarrier {
    unsigned* bar; unsigned x;
    volatile LAS unsigned* st;
};

__device__ __forceinline__ XcdBarrier xcd_barrier_post(unsigned* bar, volatile LAS unsigned* st) {
    XcdBarrier b; b.bar = bar; b.x = xb_xcc_id(); b.st = st;
    if (threadIdx.x == 0) (void)xb_add(&bar[XB_XCNT(b.x)], 1u);
    return b;
}
__device__ __forceinline__ void xcd_barrier_complete(unsigned* bar, unsigned x, unsigned& nloc, unsigned& nx) {
    const unsigned G = gridDim.x * gridDim.y * gridDim.z;
    unsigned sum, cnt, mine, sp = 0u;
    for (;;) {
        sum = 0u; cnt = 0u; mine = 0u;
#pragma unroll
        for (unsigned j = 0; j < 16; ++j) { const unsigned c = xb_ld(&bar[XB_XCNT(j)]); sum += c; cnt += (c > 0u) ? 1u : 0u; mine = (j == x) ? c : mine; }
        if (sum == G) break;
        __builtin_amdgcn_s_sleep(1);
        if ((++sp & 255u) == 0u) { if (xb_ld(&bar[XB_TMO])) break; if (sp > XB_SPIN_CAP) { atomicAdd(&bar[XB_TMO], 1u); break; } }
    }
    nloc = mine > 0u ? mine : 1u; nx = cnt > 0u ? cnt : 1u;
}

__device__ __forceinline__ void xcd_barrier(const XcdBarrier& b) {
    asm volatile("s_waitcnt vmcnt(0)" ::: "memory");
    __syncthreads();
    if (threadIdx.x == 0) {
        unsigned* bar = b.bar;
        __builtin_amdgcn_s_waitcnt(0);
        unsigned nloc = b.st[0], nx = b.st[1];
        if (nloc == 0u) { xcd_barrier_complete(bar, b.x, nloc, nx); b.st[0] = nloc; b.st[1] = nx; }
        const unsigned old = xb_add(&bar[XB_XSUB(b.x)], 1u);
        const unsigned gen = old / nloc;
        if (old + 1u == (gen + 1u) * nloc) {
            __builtin_amdgcn_fence(__ATOMIC_RELEASE, "agent");
            asm volatile("s_waitcnt vmcnt(0)" ::: "memory");
            const unsigned og = xb_add(&bar[XB_TOP], 1u);
            const unsigned tg = og / nx;
            if (og + 1u == (tg + 1u) * nx) xb_add(&bar[XB_TOPGEN], 1u);
            else XB_SPIN(xb_ld(&bar[XB_TOPGEN]) == tg, bar);
            __builtin_amdgcn_fence(__ATOMIC_ACQUIRE, "agent");
            xb_add(&bar[XB_XGEN(b.x)], 1u);
            asm volatile("s_waitcnt vmcnt(0)" ::: "memory");
        } else {
            XB_SPIN(xb_ld(&bar[XB_XGEN(b.x)]) == gen, bar);
            __builtin_amdgcn_fence(__ATOMIC_ACQUIRE, "agent");
            asm volatile("s_waitcnt vmcnt(0)" ::: "memory");
        }
    }
    __syncthreads();
}

struct Args { const float* in[19]; float* out; unsigned char* ws; int ph_lo, ph_hi; };
struct Frame {
    LAS unsigned char* lds;
    volatile LAS unsigned* MISC;
    gu32* ctl;
    int G;
    const Args* A;
};
#define PHASE_IDS int tid_ = threadIdx.x; asm volatile("" : "+v"(tid_)); const int tid = tid_, lane = tid & 63, wave = __builtin_amdgcn_readfirstlane(tid >> 6); (void)lane; (void)wave; unsigned char* ws_ = F.A->ws; asm volatile("" : "+s"(ws_))
#define F_IN(i) (F.A->in[i])
#define F_HR (F.A->out)
#define F_WIN ((bf16*)(ws_ + WS_WIN))
#define F_WOUT ((bf16*)(ws_ + WS_WOUT))
#define F_WUP ((bf16*)(ws_ + WS_WUP))
#define F_WDN ((bf16*)(ws_ + WS_WDN))
#define F_HB ((bf16*)(ws_ + WS_HB))
#define F_PROJ ((bf16*)(ws_ + WS_PROJ))
#define F_O ((bf16*)(ws_ + WS_O))
#define F_UG ((bf16*)(ws_ + WS_UG))
#define F_ACT ((bf16*)(ws_ + WS_ACT))
#define F_KCMP ((float*)(ws_ + WS_KCMP))
#define F_MEMKV ((float*)(ws_ + WS_MEMKV))
#define F_KMEAN ((float*)(ws_ + WS_KMEAN))
#define F_FOXC ((double*)(ws_ + WS_FOXC))
#define F_MEMKVB ((bf16*)(ws_ + WS_MEMKVB))
#define F_KMEANB ((bf16*)(ws_ + WS_KMEANB))
#define F_KCMPB ((bf16*)(ws_ + WS_KCMPB))
#define F_PART ((bf16*)(ws_ + WS_PART))
#define F_LSE ((float*)(ws_ + WS_LSE))
#define F_MSEL ((unsigned*)(ws_ + WS_MSEL))
#define F_W1T ((bf16*)(ws_ + WS_W1T))
#define F_W2B ((bf16*)(ws_ + WS_W2B))
#define F_HBIAS ((float*)(ws_ + WS_HBIAS))
__device__ __forceinline__ float wave_sum(float v) {
#pragma unroll
    for (int o = 1; o < 64; o <<= 1) v += __shfl_xor(v, o);
    return v;
}
template <bool UPMAP = false>
__device__ __forceinline__ void p0_transpose_item(const float* W, int K, int N, bf16* WT, LAS float* scr, int item, int lane) {
    const int nblk = N / 32, kb = item / nblk, nb = item % nblk, k0 = 64 * kb, n0 = 32 * nb;
    const int s0 = UPMAP ? ((n0 >> 7) & 1) * (N / 2) + (n0 >> 8) * 128 + (n0 & 127) : n0;
    float tv[32];
#pragma unroll
    for (int i = 0; i < 32; ++i) tv[i] = W[(size_t)(k0 + 2 * i + (lane >> 5)) * N + s0 + (lane & 31)];
#pragma unroll
    for (int i = 0; i < 32; ++i) scr[(2 * i + (lane >> 5)) * 33 + (lane & 31)] = tv[i];
    LDS_WAIT(); asm volatile("" ::: "memory");
    const int c = lane & 7;
#pragma unroll
    for (int j = 0; j < 4; ++j) { const int n = (lane >> 3) + 8 * j; const LAS float* s = scr + (8 * c) * 33 + n;
        v4u o; o.x = pk2(s[0 * 33], s[1 * 33]); o.y = pk2(s[2 * 33], s[3 * 33]); o.z = pk2(s[4 * 33], s[5 * 33]); o.w = pk2(s[6 * 33], s[7 * 33]);
        *(GAS v4u*)(WT + (size_t)(n0 + n) * K + k0 + 8 * c) = o; }
    LDS_WAIT(); asm volatile("" ::: "memory");
}
__device__ __forceinline__ int in_src(int n) { return n < 2816 ? n : n < 5120 ? n + 24 : n < 5376 ? n + 36 : n < 5400 ? n - 5376 + 2816 : n < 5412 ? n - 5400 + 5144 : -1; }
__device__ __forceinline__ float in_scale(int n) { return (n < 512 || (n >= 1536 && n < 2048) || (n >= 2816 && n < 3584) || (n >= 5120 && n < 5376)) ? C2 : 1.0f; }
__device__ __forceinline__ void p0_transpose_in(const float* W, bf16* WT, LAS float* scr, int item, int lane) {
    constexpr int K = D, nblk = NPROJ / 32; const int kb = item / nblk, nb = item % nblk, k0 = 64 * kb, n0 = 32 * nb;
    const int sc = in_src(n0 + (lane & 31)); const float fs = in_scale(n0 + (lane & 31));
    float tv[32];
#pragma unroll
    for (int i = 0; i < 32; ++i) tv[i] = sc >= 0 ? W[(size_t)(k0 + 2 * i + (lane >> 5)) * NIN + sc] : 0.0f;
#pragma unroll
    for (int i = 0; i < 32; ++i) scr[(2 * i + (lane >> 5)) * 33 + (lane & 31)] = tv[i] * fs;
    LDS_WAIT(); asm volatile("" ::: "memory");
    const int c = lane & 7;
#pragma unroll
    for (int j = 0; j < 4; ++j) { const int n = (lane >> 3) + 8 * j; const LAS float* s = scr + (8 * c) * 33 + n;
        v4u o; o.x = pk2(s[0 * 33], s[1 * 33]); o.y = pk2(s[2 * 33], s[3 * 33]); o.z = pk2(s[4 * 33], s[5 * 33]); o.w = pk2(s[6 * 33], s[7 * 33]);
        *(GAS v4u*)(WT + (size_t)(n0 + n) * K + k0 + 8 * c) = o; }
    LDS_WAIT(); asm volatile("" ::: "memory");
}
__device__ __forceinline__ void ln_row(const float* src, const float* g, const float* bt, float* dstf, bf16* dstb, int lane) {
    const f32x4* xr = (const f32x4*)src + lane;
    f32x4 v[8]; float s = 0.f;
#pragma unroll
    for (int j = 0; j < 8; ++j) { v[j] = xr[64 * j]; s += (v[j].x + v[j].y) + (v[j].z + v[j].w); }
    const float mean = wave_sum(s) * (1.f / D); float s2 = 0.f;
#pragma unroll
    for (int j = 0; j < 8; ++j) { v[j] = v[j] - mean; s2 += (v[j].x * v[j].x + v[j].y * v[j].y) + (v[j].z * v[j].z + v[j].w * v[j].w); }
    const float rstd = 1.f / sqrtf(wave_sum(s2) * (1.f / D) + LN_EPS);
    f32x4* of = (f32x4*)dstf + lane; uint2* ob = (uint2*)dstb + lane;
#pragma unroll
    for (int j = 0; j < 8; ++j) { const f32x4 gg = ((const f32x4*)g)[lane + 64 * j], bb = ((const f32x4*)bt)[lane + 64 * j]; const f32x4 y = v[j] * rstd * gg + bb;
        of[64 * j] = y; ob[64 * j] = make_uint2(pk2(y.x, y.y), pk2(y.z, y.w)); }
}
__device__ __forceinline__ void ln_phase(Frame& F, const float* src, const float* g, const float* bt) {
    PHASE_IDS;
    const int gw = blockIdx.x * NWAVES + wave, NGW = F.G * NWAVES;
    for (int m = gw; m < M; m += NGW) ln_row(src + (size_t)m * D, g, bt, F_HR + (size_t)m * D, F_HB + (size_t)m * D, lane);
}
__device__ __forceinline__ void p0_prologue(Frame& F) {
    PHASE_IDS;
    LAS float* scr = (LAS float*)(F.lds + RING_OFF + wave * 16384);
    const int gw = blockIdx.x * NWAVES + wave, NGW = F.G * NWAVES;
    constexpr int I_IN = (D / 64) * (NPROJ / 32), I_OUT = (D / 64) * (D / 32), I_UP = (D / 64) * (NUP / 32), I_DN = (DFF / 64) * (D / 32), I_L = I_IN + I_OUT + I_UP + I_DN;
    for (int it = gw; it < NLAYER * I_L; it += NGW) {
        const int l = it / I_L; int r = it % I_L;
        if (r < I_IN) { p0_transpose_in(F_IN(4) + (size_t)l * D * NIN, F_WIN + (size_t)l * NPROJ * D, scr, r, lane); continue; } r -= I_IN;
        if (r < I_OUT) { p0_transpose_item(F_IN(10) + (size_t)l * D * D, D, D, F_WOUT + (size_t)l * D * D, scr, r, lane); continue; } r -= I_OUT;
        if (r < I_UP) { p0_transpose_item<true>(F_IN(13) + (size_t)l * D * NUP, D, NUP, F_WUP + (size_t)l * NUP * D, scr, r, lane); continue; } r -= I_UP;
        p0_transpose_item(F_IN(16) + (size_t)l * DFF * D, DFF, D, F_WDN + (size_t)l * D * DFF, scr, r, lane);
    }
    ln_phase(F, F_IN(0), F_IN(2), F_IN(3));
    for (int it = gw; it < NLAYER * 2 * 32 * 4; it += NGW) { const int blk = it >> 2; p0_transpose_item(F_IN(8) + (size_t)blk * 64 * 128, 64, 128, F_W1T + (size_t)blk * 128 * 64, scr, it & 3, lane); }
    for (int o = blockIdx.x * NTHR + tid; o < NLAYER * 2 * 128 * 64; o += F.G * NTHR) F_W2B[o] = (bf16)f2bf(F_IN(9)[o]);
    for (int o = gw; o < NLAYER * 2 * 128; o += NGW) { const int e = o & 127, lk = o >> 7; const float* w1 = F_IN(8) + (size_t)lk * 2048 * 128 + e; const float* pe = F_IN(7) + (size_t)lk * 2048; float acc = 0.f;
#pragma unroll 8
        for (int k = lane; k < 2048; k += 64) acc += pe[k] * w1[(size_t)k * 128];
        acc = wave_sum(acc);
        if (lane == 0) F_HBIAS[o] = acc; }
    for (int it = gw; it < NLAYER * 128 * 8; it += NGW) {
        const int cb8 = it & 7, r4 = (it >> 3) & 127, l = it >> 10; const int c = cb8 * 64 + lane;
        const float* m0 = F_IN(1) + (size_t)(r4 * 4) * D; const float* w = F_IN(6) + (size_t)l * D * 512 + c; float a0 = 0.f, a1 = 0.f, a2 = 0.f, a3 = 0.f;
#pragma unroll 8
        for (int k = 0; k < D; ++k) { const float wv = w[(size_t)k * 512]; a0 += m0[k] * wv; a1 += m0[D + k] * wv; a2 += m0[2 * D + k] * wv; a3 += m0[3 * D + k] * wv; }
        const size_t o = ((size_t)l * 512 + r4 * 4) * 512 + c;
        F_MEMKVB[o] = (bf16)f2bf(a0); F_MEMKVB[o + 512] = (bf16)f2bf(a1); F_MEMKVB[o + 1024] = (bf16)f2bf(a2); F_MEMKVB[o + 1536] = (bf16)f2bf(a3);
    }
}

__device__ __forceinline__ void load_q64(unsigned (&q)[32], const bf16* p) {
    const uint4* p4 = (const uint4*)p;
#pragma unroll
    for (int c = 0; c < 8; ++c) { const uint4 w = p4[c]; q[4 * c] = w.x; q[4 * c + 1] = w.y; q[4 * c + 2] = w.z; q[4 * c + 3] = w.w; }
}
__device__ __forceinline__ float dot64(const unsigned (&q)[32], const bf16* kp) {
    const uint4* p = (const uint4*)kp; float s0 = 0.f, s1 = 0.f;
#pragma unroll
    for (int c = 0; c < 8; ++c) { const uint4 w = p[c];
        s0 += blo(q[4 * c]) * blo(w.x) + blo(q[4 * c + 1]) * blo(w.y) + blo(q[4 * c + 2]) * blo(w.z) + blo(q[4 * c + 3]) * blo(w.w);
        s1 += bhi(q[4 * c]) * bhi(w.x) + bhi(q[4 * c + 1]) * bhi(w.y) + bhi(q[4 * c + 2]) * bhi(w.z) + bhi(q[4 * c + 3]) * bhi(w.w); if ((c & 3) == 3) asm volatile("" ::: "memory"); }
    return s0 + s1;
}
__device__ __forceinline__ float dot64f(const unsigned (&q)[32], const float* kp) {
    const f32x4* p = (const f32x4*)kp; float s0 = 0.f, s1 = 0.f;
#pragma unroll
    for (int c = 0; c < 16; ++c) { const f32x4 w = p[c]; s0 += blo(q[2 * c]) * w.x + blo(q[2 * c + 1]) * w.z; s1 += bhi(q[2 * c]) * w.y + bhi(q[2 * c + 1]) * w.w; if ((c & 3) == 3) asm volatile("" ::: "memory"); }
    return s0 + s1;
}
__device__ __forceinline__ void axpy64(float (&o)[64], float f, float p, const bf16* vp) {
    const uint4* p4 = (const uint4*)vp;
#pragma unroll
    for (int c = 0; c < 8; ++c) { const uint4 w = p4[c];
        o[8 * c] = o[8 * c] * f + p * blo(w.x); o[8 * c + 1] = o[8 * c + 1] * f + p * bhi(w.x); o[8 * c + 2] = o[8 * c + 2] * f + p * blo(w.y); o[8 * c + 3] = o[8 * c + 3] * f + p * bhi(w.y);
        o[8 * c + 4] = o[8 * c + 4] * f + p * blo(w.z); o[8 * c + 5] = o[8 * c + 5] * f + p * bhi(w.z); o[8 * c + 6] = o[8 * c + 6] * f + p * blo(w.w); o[8 * c + 7] = o[8 * c + 7] * f + p * bhi(w.w); if ((c & 3) == 3) asm volatile("" ::: "memory"); }
}
__device__ __forceinline__ void axpy64f(float (&o)[64], float f, float p, const float* vp) {
    const f32x4* p4 = (const f32x4*)vp;
#pragma unroll
    for (int c = 0; c < 16; ++c) { const f32x4 w = p4[c]; o[4 * c] = o[4 * c] * f + p * w.x; o[4 * c + 1] = o[4 * c + 1] * f + p * w.y; o[4 * c + 2] = o[4 * c + 2] * f + p * w.z; o[4 * c + 3] = o[4 * c + 3] * f + p * w.w; if ((c & 3) == 3) asm volatile("" ::: "memory"); }
}
#define KEY_STEP(sv, vptr) do { const float mn_ = fmaxf(m, (sv)); const float f_ = ex2(m - mn_), p_ = ex2((sv) - mn_); l = l * f_ + p_; axpy64(o, f_, p_, (vptr)); m = mn_; } while (0)
#define KEY_STEPF(sv, vptr) do { const float mn_ = fmaxf(m, (sv)); const float f_ = ex2(m - mn_), p_ = ex2((sv) - mn_); l = l * f_ + p_; axpy64f(o, f_, p_, (vptr)); m = mn_; } while (0)
__device__ __forceinline__ void store_o64(bf16* op, const float (&o)[64], float sc) {
    uint4* p4 = (uint4*)op;
#pragma unroll
    for (int c = 0; c < 8; ++c) { uint4 w; w.x = pk2(o[8 * c] * sc, o[8 * c + 1] * sc); w.y = pk2(o[8 * c + 2] * sc, o[8 * c + 3] * sc); w.z = pk2(o[8 * c + 4] * sc, o[8 * c + 5] * sc); w.w = pk2(o[8 * c + 6] * sc, o[8 * c + 7] * sc); p4[c] = w; }
}
#define UNI(x) __builtin_amdgcn_readfirstlane(x)

__device__ __forceinline__ void fox_item_naive(Frame& F, int b, int h, int qblk) {
    PHASE_IDS;
    const int t = qblk * 512 + tid; const size_t row = (size_t)b * S + t;
    unsigned q[32]; load_q64(q, F_PROJ + row * NPROJ + C_FQ + h * 64);
    const double* cc = F_FOXC + (size_t)(b * 12 + h) * S; const double ci = cc[t];
    float m = -INFINITY, l = 0.f; float o[64];
#pragma unroll
    for (int d = 0; d < 64; ++d) o[d] = 0.f;
    const int jmax = UNI(qblk * 512 + wave * 64 + 63);
    const bf16* kb = F_PROJ + (size_t)b * S * NPROJ + C_FK + h * 64; const bf16* vb = F_PROJ + (size_t)b * S * NPROJ + C_FV + h * 64;
    for (int j = 0; j <= jmax; ++j) {
        const float bias = (float)(ci - cc[j]);
        if (j <= t) { const float s = dot64(q, kb + (size_t)j * NPROJ) + bias; KEY_STEP(s, vb + (size_t)j * NPROJ); }
    }
    store_o64(F_O + row * D + (16 + h) * 64, o, 1.0f / l);
}
__device__ __forceinline__ void mem_item_naive(Frame& F, int layer, int b, int h, int qblk) {
    PHASE_IDS;
    const int t = qblk * 512 + tid; const size_t row = (size_t)b * S + t;
    unsigned q[32]; load_q64(q, F_PROJ + row * NPROJ + C_EQ + h * 64);
    float m = -INFINITY, l = 0.f; float o[64];
#pragma unroll
    for (int d = 0; d < 64; ++d) o[d] = 0.f;
    const float* kv = F_MEMKV + (size_t)layer * 512 * 512 + (size_t)b * 256 * 512;
    for (int j = 0; j < 256; ++j) { const float s = dot64f(q, kv + (size_t)j * 512 + h * 64); KEY_STEPF(s, kv + (size_t)j * 512 + 256 + h * 64); }
    store_o64(F_O + row * D + (28 + h) * 64, o, 1.0f / l);
}
__device__ __forceinline__ void moba_item_naive(Frame& F, int b, int h, int qblk) {
    PHASE_IDS;
    const int t = qblk * 512 + tid; const size_t row = (size_t)b * S + t;
    unsigned q[32]; load_q64(q, F_PROJ + row * NPROJ + C_MQ + h * 64);
    const int own = UNI((qblk * 512 + wave * 64) >> 8);
    float g0 = -INFINITY, g1 = -INFINITY, g2 = -INFINITY; int i0 = -1, i1 = -1, i2 = -1;
    const float* km = F_KMEAN + (size_t)(b * 8 + h) * 64 * 64;
    for (int j = 0; j < own; ++j) {
        const float g = dot64f(q, km + j * 64);
        if (g > g0) { g2 = g1; i2 = i1; g1 = g0; i1 = i0; g0 = g; i0 = j; }
        else if (g > g1) { g2 = g1; i2 = i1; g1 = g; i1 = j; }
        else if (g > g2) { g2 = g; i2 = j; }
    }
    const float slope = exp2f(-(float)(h + 1)) * LOG2E;
    float m = -INFINITY, l = 0.f; float o[64];
#pragma unroll
    for (int d = 0; d < 64; ++d) o[d] = 0.f;
    const bf16* kb = F_PROJ + (size_t)b * S * NPROJ + C_MK + h * 64; const bf16* vb = F_PROJ + (size_t)b * S * NPROJ + C_MV + h * 64;
    const int jmax = UNI(qblk * 512 + wave * 64 + 63);
    for (int j = own * 256; j <= jmax; ++j) {
        if (j <= t) { const float s = dot64(q, kb + (size_t)j * NPROJ) - slope * (float)(t - j); KEY_STEP(s, vb + (size_t)j * NPROJ); }
    }
#pragma unroll
    for (int n = 0; n < 3; ++n) {
        const int sb = n == 0 ? i0 : n == 1 ? i1 : i2;
        for (int off = 0; off < 256; ++off) {
            if (sb >= 0) { const int j = sb * 256 + off; const float s = dot64(q, kb + (size_t)j * NPROJ) - slope * (float)(t - j); KEY_STEP(s, vb + (size_t)j * NPROJ); }
        }
    }
    store_o64(F_O + row * D + h * 64, o, 1.0f / l);
}
__device__ __forceinline__ void nsa_item_naive(Frame& F, int b, int g, int qblk) {
    PHASE_IDS;
    const int ql = tid >> 2, hh = tid & 3, h = g * 4 + hh; const int t = qblk * 128 + ql; const size_t row = (size_t)b * S + t;
    LAS float* imp = (LAS float*)(F.lds + RING_OFF) + ql * 256;
    LAS int* selL = (LAS int*)(F.lds + SEL_OFF) + ql * 16;
    LAS float* stash = (LAS float*)(F.lds + RING_OFF) + tid * 64;
    for (int i = tid; i < 128 * 256; i += NTHR) ((LAS float*)(F.lds + RING_OFF))[i] = 0.f;
    __syncthreads();
    unsigned q[32]; load_q64(q, F_PROJ + row * NPROJ + C_NQ + h * 64);
    const float slope = exp2f(-(float)(h + 1)) * LOG2E;
    const float* kc = F_KCMP + (size_t)((0 * 2 + b) * 2 + g) * NCMP_PAD * 64; const float* vc = F_KCMP + (size_t)((1 * 2 + b) * 2 + g) * NCMP_PAD * 64;
    const int tmax = UNI(qblk * 128 + wave * 16 + 15);
    const int ncw = tmax >= 31 ? ((tmax - 31) >> 4) + 1 : 0;
    float m = -INFINITY, l = 0.f;
    for (int n = 0; n < ncw; ++n) {
        const int ce = 16 * n + 31;
        if (ce <= t) { const float s = dot64f(q, kc + n * 64) - slope * (float)(t - ce); const float mn = fmaxf(m, s); l = l * ex2(m - mn) + ex2(s - mn); m = mn; }
    }
    float o[64];
#pragma unroll
    for (int d = 0; d < 64; ++d) o[d] = 0.f;
    const float rl = l > 0.f ? 1.0f / l : 0.f;
    for (int n = 0; n < ncw; ++n) {
        const int ce = 16 * n + 31; float p = 0.f;
        if (ce <= t) { const float s = dot64f(q, kc + n * 64) - slope * (float)(t - ce); p = ex2(s - m) * rl; axpy64f(o, 1.0f, p, vc + n * 64); }
        float p4 = p + __shfl_xor(p, 1); p4 = p4 + __shfl_xor(p4, 2);
        if (hh == 0) { imp[n >> 2] += p4; if ((n & 3) == 3) imp[(n >> 2) + 1] += p4; }
    }
    __syncthreads();
    const int jt = t >> 6;
    if (hh == 0) { imp[0] = 1.0e4f; imp[jt] = 1.0e4f; if (jt >= 1) imp[jt - 1] = 1.0e4f; }
    __syncthreads();
    int nsel = 0;
    for (int i = 0; i < 16; ++i) {
        float best = -1.0f; int bi = -1;
        for (int k = 0; k <= jt; ++k) { const float v = imp[k]; if (v > best) { best = v; bi = k; } }
        if (bi < 0) break;
        __builtin_amdgcn_wave_barrier();
        imp[bi] = -2.0f; selL[i] = bi; nsel = i + 1;
        __builtin_amdgcn_wave_barrier();
    }
    __syncthreads();
    const bf16* gp = F_PROJ + row * NPROJ + C_GATE + h * 3;
    const float ga = 1.0f / (1.0f + __expf(-bf2f(gp[0]))), gb = 1.0f / (1.0f + __expf(-bf2f(gp[1]))), gc = 1.0f / (1.0f + __expf(-bf2f(gp[2])));
#pragma unroll
    for (int d = 0; d < 64; ++d) stash[d] = ga * o[d];
    const bf16* pb = F_PROJ + (size_t)b * S * NPROJ;
    m = -INFINITY; l = 0.f;
#pragma unroll
    for (int d = 0; d < 64; ++d) o[d] = 0.f;
    for (int i = 0; i < 16; ++i) {
        const int blk = i < nsel ? selL[i] : -1;
        for (int off = 0; off < 64; ++off) {
            const int j = blk * 64 + off;
            if (blk >= 0 && j <= t) { const float s = dot64(q, pb + (size_t)j * NPROJ + C_NKV + 2 * 128 + g * 64) - slope * (float)(t - j); KEY_STEP(s, pb + (size_t)j * NPROJ + C_NKV + 3 * 128 + g * 64); }
        }
    }
    { const float sc = l > 0.f ? gb / l : 0.f;
#pragma unroll
      for (int d = 0; d < 64; ++d) stash[d] += sc * o[d]; }
    m = -INFINITY; l = 0.f;
#pragma unroll
    for (int d = 0; d < 64; ++d) o[d] = 0.f;
    const int tmin = UNI(qblk * 128 + wave * 16);
    for (int j = (tmin - 511 > 0 ? tmin - 511 : 0); j <= tmax; ++j) {
        if (j <= t && t - j < 512) { const float s = dot64(q, pb + (size_t)j * NPROJ + C_NKV + 4 * 128 + g * 64) - slope * (float)(t - j); KEY_STEP(s, pb + (size_t)j * NPROJ + C_NKV + 5 * 128 + g * 64); }
    }
    { const float sc = l > 0.f ? gc / l : 0.f;
#pragma unroll
      for (int d = 0; d < 64; ++d) o[d] = stash[d] + sc * o[d]; }
    store_o64(F_O + row * D + (8 + h) * 64, o, 1.0f);
    __syncthreads();
}
__device__ __forceinline__ void cmp_item_naive(Frame& F, int layer, int item) {
    PHASE_IDS;
    const int chunk = item & 127, g = (item >> 7) & 1, b = (item >> 8) & 1, kv = item >> 9; const int n0 = chunk * 8;
    LAS float* X = (LAS float*)(F.lds + RING_OFF);
    LAS float* H = X + 144 * 64;
    const bf16* src = F_PROJ + (size_t)b * S * NPROJ + C_NKV + kv * 128 + g * 64;
    for (int i = tid; i < 144 * 64; i += NTHR) { const int p = 16 * n0 + (i >> 6); X[i] = p < S ? bf2f(src[(size_t)p * NPROJ + (i & 63)]) : 0.f; }
    __syncthreads();
    const int e = tid & 127, sub = tid >> 7;
    const float* w1 = F_IN(8) + (size_t)(layer * 2 + kv) * 32 * 64 * 128; const float* pe = F_IN(7) + (size_t)(layer * 2 + kv) * 32 * 64;
    float a0 = 0.f, a1 = 0.f;
    for (int ld = 0; ld < 2048; ++ld) { const float w = w1[(size_t)ld * 128 + e]; const float pv = pe[ld]; a0 += (X[(2 * sub) * 16 * 64 + ld] + pv) * w; a1 += (X[(2 * sub + 1) * 16 * 64 + ld] + pv) * w; }
    H[(2 * sub) * 128 + e] = gelu_tanh(a0); H[(2 * sub + 1) * 128 + e] = gelu_tanh(a1);
    __syncthreads();
    const int tok = tid >> 6, dd = tid & 63; const float* w2 = F_IN(9) + (size_t)(layer * 2 + kv) * 128 * 64; float a = 0.f;
    for (int k = 0; k < 128; ++k) a += H[tok * 128 + k] * w2[k * 64 + dd];
    { const size_t oi = ((size_t)((kv * 2 + b) * 2 + g) * NCMP_PAD + n0 + tok) * 64 + dd; const float av = n0 + tok < NCMP ? a : 0.f; F_KCMP[oi] = av; F_KCMPB[oi] = (bf16)f2bf(av); }
    __syncthreads();
}
__device__ __forceinline__ void prep_phase(Frame& F, int layer) {
    PHASE_IDS;
    if (blockIdx.x < 24) {
        const int b = blockIdx.x / 12, h = blockIdx.x % 12; const float bf = F_IN(5)[layer * 12 + h];
        LAS double* part = (LAS double*)(F.lds + RING_OFF);
        const bf16* src = F_PROJ + (size_t)b * S * NPROJ + C_FF + h; float lf[32]; double s = 0.0;
#pragma unroll
        for (int i = 0; i < 32; ++i) { const float x = bf2f(src[(size_t)(tid * 32 + i) * NPROJ]) + bf; lf[i] = (fminf(x, 0.f) - log1pf(__expf(-fabsf(x)))) * LOG2E; s += (double)lf[i]; }
        part[tid] = s; __syncthreads();
        double pre = 0.0; for (int k = 0; k < tid; ++k) pre += part[k];
        double* dst = F_FOXC + (size_t)(b * 12 + h) * S + tid * 32;
#pragma unroll
        for (int i = 0; i < 32; ++i) { pre += (double)lf[i]; dst[i] = pre; }
        __syncthreads();
    }
    for (int i = blockIdx.x * NTHR + tid; i < 24 * S; i += F.G * NTHR) {
        const int bh = i / S, t = i % S, b = bh / 12, h = bh % 12;
        const bf16* qs = F_PROJ + ((size_t)b * S + t) * NPROJ + C_FQ + h * 64; const bf16* ks = F_PROJ + ((size_t)b * S + t) * NPROJ + C_FK + h * 64; float sq = 0.f, sk = 0.f;
#pragma unroll
        for (int cix = 0; cix < 8; ++cix) { const uint4 a = *(const uint4*)(qs + cix * 8), k4 = *(const uint4*)(ks + cix * 8);
            sq += blo(a.x) * blo(a.x) + bhi(a.x) * bhi(a.x) + blo(a.y) * blo(a.y) + bhi(a.y) * bhi(a.y) + blo(a.z) * blo(a.z) + bhi(a.z) * bhi(a.z) + blo(a.w) * blo(a.w) + bhi(a.w) * bhi(a.w);
            sk += blo(k4.x) * blo(k4.x) + bhi(k4.x) * bhi(k4.x) + blo(k4.y) * blo(k4.y) + bhi(k4.y) * bhi(k4.y) + blo(k4.z) * blo(k4.z) + bhi(k4.z) * bhi(k4.z) + blo(k4.w) * blo(k4.w) + bhi(k4.w) * bhi(k4.w); }
#pragma unroll
        for (int o = 1; o < 64; o <<= 1) { sq = fmaxf(sq, __shfl_xor(sq, o)); sk = fmaxf(sk, __shfl_xor(sk, o)); }
        if (lane == 0) { __hip_atomic_fetch_max(F.ctl + CW_FOXN + 64 * layer + 2 * bh, __float_as_uint(sq), RLX_AGENT); __hip_atomic_fetch_max(F.ctl + CW_FOXN + 64 * layer + 2 * bh + 1, __float_as_uint(sk), RLX_AGENT); }
    }
    for (int it = blockIdx.x; it < 2 * 8 * 64; it += F.G) {
        const int j = it & 63, h = (it >> 6) & 7, b = it >> 9; const int dg = lane & 7, rs = lane >> 3;
        const bf16* src = F_PROJ + ((size_t)b * S + j * 256 + wave * 32 + rs) * NPROJ + C_MK + h * 64 + dg * 8; float a8[8];
#pragma unroll
        for (int k = 0; k < 8; ++k) a8[k] = 0.f;
#pragma unroll
        for (int i = 0; i < 4; ++i) { const uint4 v = *(const uint4*)(src + (size_t)(8 * i) * NPROJ); a8[0] += blo(v.x); a8[1] += bhi(v.x); a8[2] += blo(v.y); a8[3] += bhi(v.y); a8[4] += blo(v.z); a8[5] += bhi(v.z); a8[6] += blo(v.w); a8[7] += bhi(v.w); }
#pragma unroll
        for (int k = 0; k < 8; ++k) { a8[k] += __shfl_xor(a8[k], 8); a8[k] += __shfl_xor(a8[k], 16); a8[k] += __shfl_xor(a8[k], 32); }
        LAS float* pm = (LAS float*)(F.lds + RING_OFF);
        if (lane < 8) {
#pragma unroll
            for (int k = 0; k < 8; ++k) pm[wave * 64 + lane * 8 + k] = a8[k]; }
        __syncthreads();
        if (tid < 64) { float a = 0.f;
#pragma unroll
            for (int w = 0; w < 8; ++w) a += pm[w * 64 + tid];
            const float km = a * (1.0f / 256.0f); const int o = it * 64 + tid; F_KMEAN[o] = km;
            const unsigned kh = f2bf(km); F_KMEANB[o] = (bf16)kh; F_KMEANB[2 * 8 * 64 * 64 + o] = (bf16)f2bf(km - __uint_as_float(kh << 16)); }
        __syncthreads();
    }
}
__device__ __forceinline__ void act_phase(Frame& F, int layer) {
    PHASE_IDS;
    const float* cw = F_IN(14) + (size_t)layer * 3 * DFF; const float* cb = F_IN(15) + (size_t)layer * DFF;
    constexpr int CG = DFF / 8;
    for (size_t i = (size_t)blockIdx.x * NTHR + tid; i < (size_t)MH * CG; i += (size_t)F.G * NTHR) {
        const int cg = (int)(i % CG), t = (int)(i / CG), c0 = cg * 8;
        const bf16* ur = F_UG + (size_t)t * NUP + c0; const bf16* gr = ur + DFF;
        const uint4 uu = *(const uint4*)ur, g2 = *(const uint4*)gr;
        uint4 g1 = make_uint4(0, 0, 0, 0), g0 = make_uint4(0, 0, 0, 0);
        if (t >= 1) g1 = *(const uint4*)(gr - NUP);
        if (t >= 2) g0 = *(const uint4*)(gr - 2 * NUP);
        const unsigned ua[4] = {uu.x, uu.y, uu.z, uu.w}, a2[4] = {g2.x, g2.y, g2.z, g2.w}, a1[4] = {g1.x, g1.y, g1.z, g1.w}, a0[4] = {g0.x, g0.y, g0.z, g0.w};
        unsigned r[4];
#pragma unroll
        for (int k = 0; k < 4; ++k) {
            const int c = c0 + 2 * k;
            const float x0 = cb[c] + cw[c] * blo(a0[k]) + cw[DFF + c] * blo(a1[k]) + cw[2 * DFF + c] * blo(a2[k]);
            const float x1 = cb[c + 1] + cw[c + 1] * bhi(a0[k]) + cw[DFF + c + 1] * bhi(a1[k]) + cw[2 * DFF + c + 1] * bhi(a2[k]);
            r[k] = pk2(gelu_tanh(x0) * blo(ua[k]), gelu_tanh(x1) * bhi(ua[k]));
        }
        *(uint4*)(F_ACT + (size_t)t * DFF + c0) = make_uint4(r[0], r[1], r[2], r[3]);
    }
}
namespace fx {
using bf16=unsigned short;
using bf16x8=__attribute__((ext_vector_type(8)))short;
using s16x4=__attribute__((ext_vector_type(4)))short;
using f32x16=__attribute__((ext_vector_type(16)))float;
using u32x4=__attribute__((ext_vector_type(4)))unsigned;
constexpr int D=64,DM=5632,DO=2048;
constexpr int NW=8,QBLK=32,QB=QBLK*NW,KVBLK=64;
__device__ __forceinline__ int crow(int r,int hi){return (r&3)+8*(r>>2)+4*hi;}
#define SBAR() __builtin_amdgcn_sched_barrier(0)
__device__ __forceinline__ void cmask(f32x16&p0,f32x16&p1,int jb,int qrel,int hi){
  const float NEG=-INFINITY; int kb=64*jb+4*hi;
  #pragma unroll
  for(int r=0;r<16;++r){int kv=kb+(r&3)+8*(r>>2); if(kv>qrel)p0[r]=NEG; if(kv+32>qrel)p1[r]=NEG;}
}

typedef __attribute__((address_space(3))) const float* lds_cf;
__device__ __forceinline__ void kbias(f32x16&p0,f32x16&p1,lds_cf tp,float mref){
  typedef float f2v __attribute__((ext_vector_type(2))); const f2v mm={mref,mref};
  #pragma unroll
  for(int g=0;g<4;++g){ typedef float f4v __attribute__((ext_vector_type(4))); const f4v a=*(const __attribute__((address_space(3))) f4v*)(tp+8*g), c=*(const __attribute__((address_space(3))) f4v*)(tp+32+8*g);
    f2v x0={p0[4*g],p0[4*g+1]},x1={p0[4*g+2],p0[4*g+3]},y0={p1[4*g],p1[4*g+1]},y1={p1[4*g+2],p1[4*g+3]};
    x0=x0+((f2v){a.x,a.y}-mm); x1=x1+((f2v){a.z,a.w}-mm); y0=y0+((f2v){c.x,c.y}-mm); y1=y1+((f2v){c.z,c.w}-mm);
    p0[4*g]=x0.x;p0[4*g+1]=x0.y;p0[4*g+2]=x1.x;p0[4*g+3]=x1.y; p1[4*g]=y0.x;p1[4*g+1]=y0.y;p1[4*g+2]=y1.x;p1[4*g+3]=y1.y; }
}
constexpr int NSLOT=3, SLOTB=8192;
constexpr int LDS_K=0, LDS_V=NSLOT*SLOTB, LDS_WS=2*NSLOT*SLOTB, LDS_T=LDS_WS+NW*64*4, LDS_OST=LDS_T, LDS_BYTES=LDS_T+65536+64;
constexpr float C2=0.125f*1.4426950408889634f;
__device__ __forceinline__ void glds16(const void*gsrc,unsigned lds_dst){unsigned keep;
  asm volatile("s_mov_b32 %0, m0\n\ts_mov_b32 m0, %2\n\ts_nop 0\n\tglobal_load_lds_dwordx4 %1, off\n\ts_mov_b32 m0, %0":"=&s"(keep):"v"(gsrc),"s"(lds_dst):"memory");}
__device__ __forceinline__ float max3f(float a,float b,float c){float r;asm("v_max3_f32 %0, %1, %2, %3":"=v"(r):"v"(a),"v"(b),"v"(c));return r;}
__device__ __forceinline__ float max2f(float a,float b){float r;asm("v_max_f32_e32 %0, %1, %2":"=v"(r):"v"(a),"v"(b));return r;}
__device__ __forceinline__ float fadd_s(float a,float b){float r;asm("v_add_f32_e32 %0, %1, %2":"=v"(r):"v"(a),"v"(b));return r;}
__device__ __forceinline__ float fsub_s(float a,float b){float r;asm("v_sub_f32_e32 %0, %1, %2":"=v"(r):"v"(a),"v"(b));return r;}
typedef float f32x2_t __attribute__((ext_vector_type(2))); typedef __bf16 bf16x2_t __attribute__((ext_vector_type(2)));
__device__ __forceinline__ unsigned cvtpk_s(float lo,float hi){f32x2_t v={lo,hi};bf16x2_t b=__builtin_convertvector(v,bf16x2_t);return __builtin_bit_cast(unsigned,b);}
#define WAIT_BAR(N) asm volatile("s_waitcnt vmcnt(" #N ") lgkmcnt(0)\n\ts_barrier":::"memory")

__device__ __forceinline__ void qkt(f32x16&p0,f32x16&p1,const char*Kslot,const bf16x8*qr,int r32,int hi){
  const char*kb=Kslot+hi*1024+r32*16;
  #pragma unroll
  for(int d0=0;d0<4;++d0){
    const bf16x8 b0=*reinterpret_cast<const bf16x8*>(kb+d0*2048);
    const bf16x8 b1=*reinterpret_cast<const bf16x8*>(kb+d0*2048+512);
    if(d0==0){p0=__builtin_amdgcn_mfma_f32_32x32x16_bf16(b0,qr[0],f32x16{},0,0,0);p1=__builtin_amdgcn_mfma_f32_32x32x16_bf16(b1,qr[0],f32x16{},0,0,0);}
    else{p0=__builtin_amdgcn_mfma_f32_32x32x16_bf16(b0,qr[d0],p0,0,0,0);p1=__builtin_amdgcn_mfma_f32_32x32x16_bf16(b1,qr[d0],p1,0,0,0);}}
}
typedef __attribute__((address_space(3))) const char* lds_cptr;
typedef short v4i16_t __attribute__((ext_vector_type(4)));
__device__ __forceinline__ void kload8(bf16x8*kf,lds_cptr kp){
  kf[0]=*(const __attribute__((address_space(3))) bf16x8*)(kp);      kf[1]=*(const __attribute__((address_space(3))) bf16x8*)(kp+512);
  kf[2]=*(const __attribute__((address_space(3))) bf16x8*)(kp+2048); kf[3]=*(const __attribute__((address_space(3))) bf16x8*)(kp+2560);
  kf[4]=*(const __attribute__((address_space(3))) bf16x8*)(kp+4096); kf[5]=*(const __attribute__((address_space(3))) bf16x8*)(kp+4608);
  kf[6]=*(const __attribute__((address_space(3))) bf16x8*)(kp+6144); kf[7]=*(const __attribute__((address_space(3))) bf16x8*)(kp+6656);
}
__device__ __forceinline__ void kload2(bf16x8*kf,lds_cptr kp,int j){ kf[2*j]=*(const __attribute__((address_space(3))) bf16x8*)(kp+j*2048); kf[2*j+1]=*(const __attribute__((address_space(3))) bf16x8*)(kp+j*2048+512); }
__device__ __forceinline__ s16x4 vtr(lds_cptr p){ return __builtin_bit_cast(s16x4,__builtin_amdgcn_ds_read_tr16_b64_v4i16((__attribute__((address_space(3))) v4i16_t*)p)); }
__device__ __forceinline__ float rowmax(const f32x16&p0,const f32x16&p1){
  float a=max3f(p0[0],p0[1],p1[0]),b=max3f(p0[2],p0[3],p1[1]);a=max3f(a,p1[2],p1[3]);
  #pragma unroll
  for(int r=4;r<16;r+=4){a=max3f(a,p0[r],p0[r+1]);b=max3f(b,p0[r+2],p0[r+3]);a=max3f(a,p1[r],p1[r+1]);b=max3f(b,p1[r+2],p1[r+3]);}
  const float m=max2f(a,b);
  auto rr=__builtin_amdgcn_permlane32_swap(__float_as_uint(m),__float_as_uint(m),false,false);
  return max2f(__uint_as_float(rr[0]),__uint_as_float(rr[1]));
}
__device__ __forceinline__ void pv(f32x16*o,int vb,bf16x8 pa0,bf16x8 pa1,bf16x8 pa2,bf16x8 pa3){
  #pragma unroll
  for(int d0=0;d0<2;++d0){s16x4 lo[4],hi[4];
    #pragma unroll
    for(int ks=0;ks<4;++ks){
      asm volatile("ds_read_b64_tr_b16 %0,%1 offset:%c2":"=&v"(lo[ks]):"v"(vb),"i"(d0*4096+ks*1024):"memory");
      asm volatile("ds_read_b64_tr_b16 %0,%1 offset:%c2":"=&v"(hi[ks]):"v"(vb),"i"(d0*4096+ks*1024+512):"memory");}
    asm volatile("s_waitcnt lgkmcnt(0)":::"memory");SBAR();
    #define PK(k) (bf16x8){lo[k][0],lo[k][1],lo[k][2],lo[k][3],hi[k][0],hi[k][1],hi[k][2],hi[k][3]}
    o[d0]=__builtin_amdgcn_mfma_f32_32x32x16_bf16(pa0,PK(0),o[d0],0,0,0);
    o[d0]=__builtin_amdgcn_mfma_f32_32x32x16_bf16(pa1,PK(1),o[d0],0,0,0);
    o[d0]=__builtin_amdgcn_mfma_f32_32x32x16_bf16(pa2,PK(2),o[d0],0,0,0);
    o[d0]=__builtin_amdgcn_mfma_f32_32x32x16_bf16(pa3,PK(3),o[d0],0,0,0);
    #undef PK
  }
}

#ifndef ATTN_STORE16
#define ATTN_STORE16(p,v) (*(u32x4*)(p)=(v))
#endif
template<int THRL> __device__ __forceinline__ void attn_unit(int qb,int t0,const bf16*Q,const bf16*__restrict__ K,const bf16*__restrict__ V,bf16*O,char*shm){
  int tid_=threadIdx.x; asm volatile("":"+v"(tid_));
  const int tid=tid_,lane=tid&63,r32=lane&31,hi=lane>>5; const int wid=__builtin_amdgcn_readfirstlane(tid>>6);
  const int q0=qb*QB;
  const bf16*Qw=Q+(long)(q0+wid*QBLK)*DM;
  const bf16*Kh=K+(long)t0*KVBLK*DM,*Vh=V+(long)t0*KVBLK*DM;
  const unsigned lds0=(unsigned)(uintptr_t)shm;
  float*wsf=(float*)(shm+LDS_WS)+wid*64;
  const bf16*ksrc=Kh+(long)lane*DM+wid*8;
  const bf16*vsrc=Vh+(long)(16*(wid&3)+(lane>>2))*DM+(wid>>2)*32+(lane&3)*8;
  const unsigned kdst=lds0+LDS_K+wid*1024, vdst=lds0+LDS_V+wid*1024;
  #define DMA_K(t,slot) glds16(ksrc+(long)(t)*KVBLK*DM,(unsigned)__builtin_amdgcn_readfirstlane(kdst+(slot)))
  #define DMA_V(t,slot) glds16(vsrc+(long)(t)*KVBLK*DM,(unsigned)__builtin_amdgcn_readfirstlane(vdst+(slot)))
  const int vb0=(int)(lds0+LDS_V)+((lane>>4)&1)*32+(lane&3)*8+(4*hi+((lane&15)>>2))*64;
  const char*Kbase=shm+LDS_K; bf16x8 kf[8];
  const lds_cptr shm3=(lds_cptr)shm; const lds_cptr kp0=shm3+LDS_K+hi*1024+r32*16; const lds_cptr vp0=shm3+LDS_V+((lane>>4)&1)*32+(lane&3)*8+(4*hi+((lane&15)>>2))*64;
  const int NT=(q0+QB)/KVBLK-t0;
  const lds_cf Tb=(lds_cf)((__attribute__((address_space(3))) const char*)shm+LDS_T)+4*hi;
  DMA_K(0,0);DMA_V(0,0);DMA_K(1,SLOTB);
  bf16x8 qr[4];
  #pragma unroll
  for(int d0=0;d0<4;++d0)qr[d0]=*reinterpret_cast<const bf16x8*>(&Qw[(long)r32*DM+d0*16+hi*8]);
  float mhat=0.f,l_reg=0.f;f32x16 o[2];o[0]=f32x16{};o[1]=f32x16{};
  const int qrel=wid*QBLK+r32;
  #define CMASK(P0,P1,t) do{int jb_=(t)-(NT-4); if(jb_>=0)cmask(P0,P1,jb_,qrel,hi);}while(0)
  bool resc=false;
  #define START(P0,P1) do{ const float rm=rowmax(P0,P1); resc=false; \
    { const float dl=rm; mhat=fadd_s(mhat,dl); \
      _Pragma("unroll") for(int r=0;r<16;++r){P0[r]=fsub_s(P0[r],dl);P1[r]=fsub_s(P1[r],dl);} \
      } \
    _Pragma("unroll") for(int r=0;r<16;++r)P0[r]=__builtin_amdgcn_exp2f(P0[r]); }while(0)
  #define RESC() do{ if(resc){ asm volatile("s_waitcnt lgkmcnt(0)":::"memory"); \
      _Pragma("unroll") for(int d_=0;d_<2;++d_) _Pragma("unroll") for(int r=0;r<16;++r)o[d_][r]*=wsf[crow(r,hi)]; } }while(0)
  f32x16 pA0,pA1,pB0,pB1;
  int sl_prev=0,sl_cur=0,sl_next=SLOTB;
  #define ROT() do{sl_prev=sl_cur;sl_cur=sl_next;sl_next=(sl_next==(NSLOT-1)*SLOTB)?0:sl_next+SLOTB;}while(0)
  DMA_K(2,2*SLOTB);
  WAIT_BAR(3);
  qkt(pA0,pA1,Kbase,qr,r32,hi);asm volatile("s_nop 15\n\ts_nop 7":"+v"(pA0),"+v"(pA1));kbias(pA0,pA1,Tb,0.f);CMASK(pA0,pA1,0);
  START(pA0,pA1);
  _Pragma("unroll") for(int r=0;r<16;++r)pA1[r]=__builtin_amdgcn_exp2f(pA1[r]);
  WAIT_BAR(0);
  DMA_K(3,0);DMA_V(1,SLOTB);
  ROT();
  kload8(kf,kp0+sl_cur);
  WAIT_BAR(2);
  s16x4 vlo[8],vhi[8]; u32x4 pw0,pw1,pw2,pw3;
  #define PKW(P,B) cvtpk_s(P[B],P[B+1])
  #define PAF(k) __builtin_bit_cast(bf16x8,pw##k)
  #define VFR(i) (bf16x8){vlo[i][0],vlo[i][1],vlo[i][2],vlo[i][3],vhi[i][0],vhi[i][1],vhi[i][2],vhi[i][3]}
  #define PIN(x) asm volatile("":"+v"(x))
  #define MX3(a,b,c) __builtin_fmaxf(__builtin_fmaxf((a),(b)),(c))
  #define GAPA(MF,A0,A1,A2,A3,W0,W1,PW) do{ MF; sacc+=A0; sacc+=A1; sacc+=A2; sacc+=A3; PIN(sacc); W0; W1; PIN(PW); SBAR(); }while(0)
  #define EX(v) __builtin_amdgcn_exp2f(v)
  #define GAPB(MF,X,B) do{ MF; X[B]=EX(X[B]); X[B+1]=EX(X[B+1]); X[B+2]=EX(X[B+2]); X[B+3]=EX(X[B+3]); PIN(X); SBAR(); }while(0)
  #define VRD(i) do{ vlo[i]=vtr(vp_+(((i)>>2)*4096+((i)&3)*1024)); vhi[i]=vtr(vp_+(((i)>>2)*4096+((i)&3)*1024+512)); }while(0)
  #define KRD(G,j) do{ if(G){ kload2(kf,kp0+sl_next,j); SBAR(); } }while(0)
  #define STEP(C0,C1,P0,P1,t,GK,GV,GL) do{ SBAR(); \
    const lds_cptr vp_=vp0+sl_prev; \
    VRD(0); SBAR(); float sacc=(P0[0]+P0[1]); \
    GAPA(C0=__builtin_amdgcn_mfma_f32_32x32x16_bf16(kf[0],qr[0],f32x16{},0,0,0), P0[2],P0[3],P0[4],P0[5],     pw0[0]=PKW(P0,0), pw0[1]=PKW(P0,2), pw0); \
    VRD(4); SBAR(); GAPA(C1=__builtin_amdgcn_mfma_f32_32x32x16_bf16(kf[1],qr[0],f32x16{},0,0,0), P0[6],P0[7],P0[8],P0[9],     pw0[2]=PKW(P0,4), pw0[3]=PKW(P0,6), pw0); \
    VRD(1); SBAR(); GAPA(C0=__builtin_amdgcn_mfma_f32_32x32x16_bf16(kf[2],qr[1],C0,0,0,0),   P0[10],P0[11],P0[12],P0[13], pw1[0]=PKW(P0,8), pw1[1]=PKW(P0,10), pw1); \
    VRD(5); SBAR(); GAPA(C1=__builtin_amdgcn_mfma_f32_32x32x16_bf16(kf[3],qr[1],C1,0,0,0),   P0[14],P0[15],P1[0],P1[1],   pw1[2]=PKW(P0,12),pw1[3]=PKW(P0,14), pw1); \
    VRD(2); SBAR(); GAPA(C0=__builtin_amdgcn_mfma_f32_32x32x16_bf16(kf[4],qr[2],C0,0,0,0),   P1[2],P1[3],P1[4],P1[5],     pw2[0]=PKW(P1,0), pw2[1]=PKW(P1,2), pw2); \
    VRD(6); SBAR(); GAPA(C1=__builtin_amdgcn_mfma_f32_32x32x16_bf16(kf[5],qr[2],C1,0,0,0),   P1[6],P1[7],P1[8],P1[9],     pw2[2]=PKW(P1,4), pw2[3]=PKW(P1,6), pw2); \
    VRD(3); SBAR(); GAPA(C0=__builtin_amdgcn_mfma_f32_32x32x16_bf16(kf[6],qr[3],C0,0,0,0),   P1[10],P1[11],P1[12],P1[13], pw3[0]=PKW(P1,8), pw3[1]=PKW(P1,10), pw3); \
    VRD(7); SBAR(); GAPA(C1=__builtin_amdgcn_mfma_f32_32x32x16_bf16(kf[7],qr[3],C1,0,0,0),   P1[14],P1[15],0.f,0.f,       pw3[2]=PKW(P1,12),pw3[3]=PKW(P1,14), pw3); \
    l_reg+=sacc; \
    if(GK){DMA_K((t)+3,sl_cur);} if(GV){DMA_V((t)+1,sl_next);} \
    kbias(C0,C1,Tb+64*(t),mhat); CMASK(C0,C1,t); \
    { float a=MX3(C0[0],C0[1],C1[0]),b=MX3(C0[2],C0[3],C1[1]); a=MX3(a,C1[2],C1[3]); \
      _Pragma("unroll") for(int r=4;r<16;r+=4){a=MX3(a,C0[r],C0[r+1]);b=MX3(b,C0[r+2],C0[r+3]);a=MX3(a,C1[r],C1[r+1]);b=MX3(b,C1[r+2],C1[r+3]);} \
      float rm=__builtin_fmaxf(a,b); { auto rr=__builtin_amdgcn_permlane32_swap(__float_as_uint(rm),__float_as_uint(rm),false,false); rm=__builtin_fmaxf(__uint_as_float(rr[0]),__uint_as_float(rr[1])); } \
      resc=false; \
      if(__builtin_expect(__any(rm>(float)THRL),0)){ const float dl=__builtin_fmaxf(rm,0.f); mhat+=dl; \
        _Pragma("unroll") for(int r=0;r<16;++r){C0[r]-=dl;C1[r]-=dl;} \
        const float f=__builtin_amdgcn_exp2f(-dl); l_reg*=f; if(hi==0)wsf[r32]=f; resc=true; } } \
    SBAR(); \
    GAPB(o[0]=__builtin_amdgcn_mfma_f32_32x32x16_bf16(PAF(0),VFR(0),o[0],0,0,0), C0,0); \
    GAPB(o[1]=__builtin_amdgcn_mfma_f32_32x32x16_bf16(PAF(0),VFR(4),o[1],0,0,0), C0,4); \
    KRD(GL,0); GAPB(o[0]=__builtin_amdgcn_mfma_f32_32x32x16_bf16(PAF(1),VFR(1),o[0],0,0,0), C0,8); \
    KRD(GL,1); GAPB(o[1]=__builtin_amdgcn_mfma_f32_32x32x16_bf16(PAF(1),VFR(5),o[1],0,0,0), C0,12); \
    KRD(GL,2); GAPB(o[0]=__builtin_amdgcn_mfma_f32_32x32x16_bf16(PAF(2),VFR(2),o[0],0,0,0), C1,0); \
    KRD(GL,3); GAPB(o[1]=__builtin_amdgcn_mfma_f32_32x32x16_bf16(PAF(2),VFR(6),o[1],0,0,0), C1,4); \
    GAPB(o[0]=__builtin_amdgcn_mfma_f32_32x32x16_bf16(PAF(3),VFR(3),o[0],0,0,0), C1,8); \
    GAPB(o[1]=__builtin_amdgcn_mfma_f32_32x32x16_bf16(PAF(3),VFR(7),o[1],0,0,0), C1,12); \
    }while(0)
  int t=1;
  #undef CMASK
  #define CMASK(P0,P1,t) do{}while(0)
  for(;t+5<NT;t+=2){
    STEP(pB0,pB1,pA0,pA1,t,true,true,true);     WAIT_BAR(2); RESC(); ROT();
    STEP(pA0,pA1,pB0,pB1,t+1,true,true,true);   WAIT_BAR(2); RESC(); ROT();
  }
  #undef CMASK
  #define CMASK(P0,P1,t) do{int jb_=(t)-(NT-4); if(jb_>=0)cmask(P0,P1,jb_,qrel,hi);}while(0)
  #define ENDW(tt) do{ if((tt)+3<NT){WAIT_BAR(2);} else if((tt)+2<NT){WAIT_BAR(1);} else {WAIT_BAR(0);} }while(0)
  for(;t+1<NT;t+=2){
    STEP(pB0,pB1,pA0,pA1,t,(t+3<NT),(t+1<NT),(t+1<NT));       ENDW(t);   RESC(); ROT();
    STEP(pA0,pA1,pB0,pB1,t+1,(t+4<NT),(t+2<NT),(t+2<NT));     ENDW(t+1); RESC(); ROT();
  }
  STEP(pB0,pB1,pA0,pA1,NT-1,false,false,false); RESC();
  { float sacc=pB0[0]+pB0[1]; _Pragma("unroll") for(int r=2;r<16;++r)sacc+=pB0[r]; _Pragma("unroll") for(int r=0;r<16;++r)sacc+=pB1[r]; l_reg+=sacc;
    pw0=(u32x4){PKW(pB0,0),PKW(pB0,2),PKW(pB0,4),PKW(pB0,6)};pw1=(u32x4){PKW(pB0,8),PKW(pB0,10),PKW(pB0,12),PKW(pB0,14)};pw2=(u32x4){PKW(pB1,0),PKW(pB1,2),PKW(pB1,4),PKW(pB1,6)};pw3=(u32x4){PKW(pB1,8),PKW(pB1,10),PKW(pB1,12),PKW(pB1,14)};
    SBAR(); pv(o,vb0+sl_cur,PAF(0),PAF(1),PAF(2),PAF(3)); }
  #undef PKW
  #undef PAF
  #undef VFR
  #undef PIN
  #undef MX3
  #undef GAPA
  #undef GAPB
  #undef EX
  #undef VRD
  #undef KRD
  #undef STEP
  #undef ENDW
  asm volatile("s_waitcnt lgkmcnt(0)\n\ts_barrier":::"memory");
  {auto rr=__builtin_amdgcn_permlane32_swap(__float_as_uint(l_reg),__float_as_uint(l_reg),false,false);l_reg=__uint_as_float(rr[0])+__uint_as_float(rr[1]);}
  if(hi==0)wsf[32+r32]=l_reg;asm volatile("s_waitcnt lgkmcnt(0)":::"memory");
  float rli[16];
  #pragma unroll
  for(int r=0;r<16;++r)rli[r]=__builtin_amdgcn_rcpf(wsf[32+crow(r,hi)]);
  bf16*Ow=O+(long)(q0+wid*QBLK)*DO;
  { bf16*stg=(bf16*)(shm+LDS_OST)+wid*2048;
    #pragma unroll
    for(int r=0;r<16;++r){const int orow=crow(r,hi);
      #pragma unroll
      for(int d0=0;d0<2;++d0)stg[orow*64+d0*32+r32]=(bf16)f2bf(o[d0][r]*rli[r]);}
    asm volatile("s_waitcnt lgkmcnt(0)":::"memory");
    #pragma unroll
    for(int i=0;i<4;++i){const int row=i*8+(lane>>3),ch=lane&7; const u32x4 v=*(const u32x4*)(stg+row*64+ch*8); ATTN_STORE16(Ow+(long)row*DO+ch*8,v);} }
  asm volatile("s_waitcnt lgkmcnt(0)\n\ts_barrier":::"memory");
  #undef DMA_K
  #undef DMA_V
  #undef CMASK
  #undef START
  #undef RESC
  #undef ROT
}
#undef SBAR
#undef WAIT_BAR
}

namespace ga {
typedef short bf16x8 __attribute__((ext_vector_type(8)));
typedef short s16x4 __attribute__((ext_vector_type(4)));
typedef float f32x16 __attribute__((ext_vector_type(16)));
typedef unsigned u32x4 __attribute__((ext_vector_type(4)));
typedef LAS const char* lds_cptr;
typedef short v4i16_t __attribute__((ext_vector_type(4)));
constexpr int SLOTB = 8192, NSLOT = 4, L_K = 0, L_V = NSLOT * SLOTB, L_WSF = 2 * NSLOT * SLOTB, L_OST = 0, L_VAR = L_WSF + 2048;
__device__ __forceinline__ int crow(int r, int hi) { return (r & 3) + 8 * (r >> 2) + 4 * hi; }
__device__ __forceinline__ void glds16(const void* gsrc, unsigned lds_dst) { unsigned keep;
    asm volatile("s_mov_b32 %0, m0\n\ts_mov_b32 m0, %2\n\ts_nop 0\n\tglobal_load_lds_dwordx4 %1, off\n\ts_mov_b32 m0, %0" : "=&s"(keep) : "v"(gsrc), "s"(lds_dst) : "memory"); }
typedef float f32x2_t __attribute__((ext_vector_type(2))); typedef __bf16 bf16x2_t __attribute__((ext_vector_type(2)));
__device__ __forceinline__ unsigned cvtpk(float lo, float hi) { f32x2_t v = {lo, hi}; bf16x2_t b = __builtin_convertvector(v, bf16x2_t); return __builtin_bit_cast(unsigned, b); }
__device__ __forceinline__ s16x4 vtr(lds_cptr p) { return __builtin_bit_cast(s16x4, __builtin_amdgcn_ds_read_tr16_b64_v4i16((LAS v4i16_t*)p)); }
#define GA_WAIT_BAR(N) asm volatile("s_waitcnt vmcnt(" #N ") lgkmcnt(0)\n\ts_barrier" ::: "memory")

struct Core { bf16x8 qr[4]; float m, l, inited; f32x16 o0, o1; };
constexpr float THR = 8.0f;
__device__ __forceinline__ void core_reset(Core& c) { c.m = 0.f; c.l = 0.f; c.inited = 0.f; c.o0 = f32x16{}; c.o1 = f32x16{}; }
__device__ __forceinline__ void load_q(Core& c, const bf16* qrow, int hi) {
#pragma unroll
    for (int d0 = 0; d0 < 4; ++d0) c.qr[d0] = *(const bf16x8*)(qrow + d0 * 16 + hi * 8);
}
struct TileDma {
    const bf16* ksrc; const bf16* vsrc; unsigned kdst, vdst;
    __device__ __forceinline__ void init(const bf16* K, int kpitch, const bf16* V, int vpitch, LAS unsigned char* base, int wid, int lane) {
        ksrc = K + (size_t)lane * kpitch + wid * 8;
        vsrc = V + (size_t)(16 * (wid & 3) + (lane >> 2)) * vpitch + (wid >> 2) * 32 + (lane & 3) * 8;
        const unsigned b0 = (unsigned)(uintptr_t)base; kdst = b0 + L_K + wid * 1024; vdst = b0 + L_V + wid * 1024;
    }
    __device__ __forceinline__ void issue_k(size_t koff, int slot) const { glds16(ksrc + koff, (unsigned)__builtin_amdgcn_readfirstlane(kdst + slot * SLOTB)); }
    __device__ __forceinline__ void issue_v(size_t voff, int slot) const { glds16(vsrc + voff, (unsigned)__builtin_amdgcn_readfirstlane(vdst + slot * SLOTB)); }
};
__device__ __forceinline__ void dma_k_only(const TileDma& dma, size_t koff, int slot) { dma.issue_k(koff, slot); }
__device__ __forceinline__ void qk_tile(f32x16& p0, f32x16& p1, const Core& c, LAS unsigned char* base, int slot, int r32, int hi) {
    const lds_cptr kb = (lds_cptr)base + L_K + slot * SLOTB + hi * 1024 + r32 * 16;
#pragma unroll
    for (int d0 = 0; d0 < 4; ++d0) {
        const bf16x8 b0 = *(const LAS bf16x8*)(kb + d0 * 2048), b1 = *(const LAS bf16x8*)(kb + d0 * 2048 + 512);
        p0 = __builtin_amdgcn_mfma_f32_32x32x16_bf16(b0, c.qr[d0], d0 == 0 ? f32x16{} : p0, 0, 0, 0);
        p1 = __builtin_amdgcn_mfma_f32_32x32x16_bf16(b1, c.qr[d0], d0 == 0 ? f32x16{} : p1, 0, 0, 0);
    }
}
#define GA_MX3(a, b, c) __builtin_fmaxf(__builtin_fmaxf((a), (b)), (c))
__device__ __forceinline__ float rowmax32(const f32x16& p0, const f32x16& p1) {
    float a = GA_MX3(p0[0], p0[1], p1[0]), b = GA_MX3(p0[2], p0[3], p1[1]); a = GA_MX3(a, p1[2], p1[3]);
#pragma unroll
    for (int r = 4; r < 16; r += 4) { a = GA_MX3(a, p0[r], p0[r + 1]); b = GA_MX3(b, p0[r + 2], p0[r + 3]); a = GA_MX3(a, p1[r], p1[r + 1]); b = GA_MX3(b, p1[r + 2], p1[r + 3]); }
    a = __builtin_fmaxf(a, b);
    const auto rr = __builtin_amdgcn_permlane32_swap(__float_as_uint(a), __float_as_uint(a), false, false);
    return __builtin_fmaxf(__uint_as_float(rr[0]), __uint_as_float(rr[1]));
}
__device__ __forceinline__ void softmax_h2(Core& c, f32x16& p0, f32x16& p1, u32x4 (&pw)[4], LAS unsigned char* base, int wid, int r32, int hi) {
    const float rm = rowmax32(p0, p1) - c.m;
    const bool first = (c.inited == 0.f) && (rm > -INFINITY);
    const bool need = first || rm > THR;
    if (__any(need)) {
        const float dl = need ? rm : 0.f;
        const float alpha = first ? 0.f : ex2(-dl);
        c.m += dl; c.l *= alpha; if (first) c.inited = 1.f;
        LAS float* wsf = (LAS float*)(base + L_WSF) + wid * 64;
        if (hi == 0) wsf[r32] = alpha;
        __builtin_amdgcn_fence(__ATOMIC_RELEASE, "wavefront"); asm volatile("s_waitcnt lgkmcnt(0)" ::: "memory");
#pragma unroll
        for (int r = 0; r < 16; ++r) { const float f = wsf[crow(r, hi)]; c.o0[r] *= f; c.o1[r] *= f; }
        asm volatile("s_waitcnt lgkmcnt(0)" ::: "memory");
    }
    float ps0 = 0.f, ps1 = 0.f;
#pragma unroll
    for (int r = 0; r < 16; r += 2) { f32x2_t a = {p0[r], p0[r + 1]}, b = {p1[r], p1[r + 1]}; const f32x2_t mm = {c.m, c.m}; a = a - mm; b = b - mm;
        p0[r] = ex2(a.x); p0[r + 1] = ex2(a.y); p1[r] = ex2(b.x); p1[r + 1] = ex2(b.y); }
    f32x2_t sa = {0.f, 0.f}, sb = {0.f, 0.f};
#pragma unroll
    for (int r = 0; r < 16; r += 2) { sa += (f32x2_t){p0[r], p0[r + 1]}; sb += (f32x2_t){p1[r], p1[r + 1]}; }
    ps0 = sa.x + sa.y; ps1 = sb.x + sb.y;
    c.l += ps0 + ps1;
#pragma unroll
    for (int k = 0; k < 4; ++k) { pw[0][k] = cvtpk(p0[2 * k], p0[2 * k + 1]); pw[1][k] = cvtpk(p0[8 + 2 * k], p0[8 + 2 * k + 1]); pw[2][k] = cvtpk(p1[2 * k], p1[2 * k + 1]); pw[3][k] = cvtpk(p1[8 + 2 * k], p1[8 + 2 * k + 1]); }
}
__device__ __forceinline__ void pv_h1(Core& c, const u32x4 (&pw)[4], LAS unsigned char* base, int slot, int lane, int hi) {
    const lds_cptr vp = (lds_cptr)base + L_V + slot * SLOTB + ((lane >> 4) & 1) * 32 + (lane & 3) * 8 + (4 * hi + ((lane & 15) >> 2)) * 64;
#pragma unroll
    for (int ks = 0; ks < 4; ++ks) {
        const s16x4 lo0 = vtr(vp + ks * 1024), hi0 = vtr(vp + ks * 1024 + 512), lo1 = vtr(vp + 4096 + ks * 1024), hi1 = vtr(vp + 4096 + ks * 1024 + 512);
        const bf16x8 v0 = (bf16x8){lo0[0], lo0[1], lo0[2], lo0[3], hi0[0], hi0[1], hi0[2], hi0[3]}, v1 = (bf16x8){lo1[0], lo1[1], lo1[2], lo1[3], hi1[0], hi1[1], hi1[2], hi1[3]};
        const bf16x8 pa = __builtin_bit_cast(bf16x8, pw[ks]);
        c.o0 = __builtin_amdgcn_mfma_f32_32x32x16_bf16(pa, v0, c.o0, 0, 0, 0);
        c.o1 = __builtin_amdgcn_mfma_f32_32x32x16_bf16(pa, v1, c.o1, 0, 0, 0);
    }
}
__device__ __forceinline__ float row_l(const Core& c) { return c.l + __shfl_xor(c.l, 32); }
__device__ __forceinline__ void scale_o(f32x16& a0, f32x16& a1, const Core& c, float rowscale, bool accumulate, LAS unsigned char* base, int wid, int r32, int hi) {
    LAS float* wsf = (LAS float*)(base + L_WSF) + wid * 64;
    if (hi == 0) wsf[r32] = rowscale;
    __builtin_amdgcn_fence(__ATOMIC_RELEASE, "wavefront"); asm volatile("s_waitcnt lgkmcnt(0)" ::: "memory");
#pragma unroll
    for (int r = 0; r < 16; ++r) { const float f = wsf[crow(r, hi)]; if (accumulate) { a0[r] += f * c.o0[r]; a1[r] += f * c.o1[r]; } else { a0[r] = f * c.o0[r]; a1[r] = f * c.o1[r]; } }
    asm volatile("s_waitcnt lgkmcnt(0)" ::: "memory");
}
__device__ __forceinline__ void stash_o(LAS float* stash, const Core& c, float rowscale, bool accumulate, LAS unsigned char* base, int wid, int r32, int hi) {
    LAS float* wsf = (LAS float*)(base + L_WSF) + wid * 64;
    if (hi == 0) wsf[r32] = rowscale;
    __builtin_amdgcn_fence(__ATOMIC_RELEASE, "wavefront"); asm volatile("s_waitcnt lgkmcnt(0)" ::: "memory");
#pragma unroll
    for (int r = 0; r < 16; ++r) { const int orow = crow(r, hi); const float f = wsf[orow]; LAS float* p = stash + orow * 64 + r32;
        if (accumulate) { p[0] += f * c.o0[r]; p[32] += f * c.o1[r]; } else { p[0] = f * c.o0[r]; p[32] = f * c.o1[r]; } }
    asm volatile("s_waitcnt lgkmcnt(0)" ::: "memory");
}
template <class RowPtr>
__device__ __forceinline__ void store_stash(const LAS float* stash, int lane, const RowPtr& rowptr) {
    __builtin_amdgcn_fence(__ATOMIC_RELEASE, "wavefront"); asm volatile("s_waitcnt lgkmcnt(0)" ::: "memory");
#pragma unroll
    for (int i = 0; i < 4; ++i) { const int row = i * 8 + (lane >> 3), ch = lane & 7; const LAS f32x4* s = (const LAS f32x4*)(stash + row * 64 + ch * 8); const f32x4 x = s[0], y = s[1];
        u32x4 v; v.x = pk2(x.x, x.y); v.y = pk2(x.z, x.w); v.z = pk2(y.x, y.y); v.w = pk2(y.z, y.w); *(u32x4*)(rowptr(row) + ch * 8) = v; }
    asm volatile("s_waitcnt lgkmcnt(0)" ::: "memory");
}
template <class RowPtr>
__device__ __forceinline__ void store_rows(const f32x16& a0, const f32x16& a1, LAS unsigned char* base, int wid, int lane, int r32, int hi, const RowPtr& rowptr) {
    LAS bf16* stg = (LAS bf16*)(base + L_OST) + wid * 2048;
#pragma unroll
    for (int r = 0; r < 16; ++r) { const int orow = crow(r, hi); stg[orow * 64 + r32] = (bf16)f2bf(a0[r]); stg[orow * 64 + 32 + r32] = (bf16)f2bf(a1[r]); }
    __builtin_amdgcn_fence(__ATOMIC_RELEASE, "wavefront"); asm volatile("s_waitcnt lgkmcnt(0)" ::: "memory");
#pragma unroll
    for (int i = 0; i < 4; ++i) { const int row = i * 8 + (lane >> 3), ch = lane & 7; const u32x4 v = *(const LAS u32x4*)(stg + row * 64 + ch * 8); *(u32x4*)(rowptr(row) + ch * 8) = v; }
    asm volatile("s_waitcnt lgkmcnt(0)" ::: "memory");
}
template <bool HAS_V, class RowFn, class BiasMask>
__device__ __forceinline__ void run_tiles_t(Core& c, const TileDma& dma, int kpitch, int vpitch, int nt, const RowFn& rowfn, const BiasMask& bm, LAS unsigned char* base, int wid, int lane, int r32, int hi) {
    if (nt <= 0) return;
#define GA_REQ_K(i) do { const int i_ = (i) < nt ? (i) : nt - 1; dma.issue_k((size_t)rowfn(i_) * kpitch, (i) & 3); } while (0)
#define GA_REQ_V(i) do { if (HAS_V) { const int i_ = (i) < nt ? (i) : nt - 1; dma.issue_v((size_t)rowfn(i_) * vpitch, (i) & 3); } } while (0)
#define GA_REQ(s) do { GA_REQ_K((s) + 3); GA_REQ_V((s) + 2); } while (0)
#define GA_BAR() asm volatile("s_waitcnt lgkmcnt(0)\n\ts_barrier" ::: "memory")
#define GA_CBAR() do { if (HAS_V) { GA_WAIT_BAR(4); } else { GA_WAIT_BAR(2); } } while (0)
#define GA_H2(i) do { bm(p0, p1, (i)); if (HAS_V) softmax_h2(c, p0, p1, pw, base, wid, r32, hi); } while (0)
#define GA_PV(i) do { if (HAS_V) pv_h1(c, pw, base, (i) & 3, lane, hi); } while (0)
    GA_REQ_K(0); GA_REQ_V(0); GA_REQ_K(1); GA_REQ_V(1); GA_REQ_K(2);
    GA_CBAR();
    f32x16 p0, p1; u32x4 pw[4];
    if (wid < 4) {
        GA_REQ(0); qk_tile(p0, p1, c, base, 0, r32, hi); GA_BAR();
        GA_H2(0); GA_CBAR();
        for (int s = 1; s < nt; ++s) {
            GA_REQ(s); GA_PV(s - 1); qk_tile(p0, p1, c, base, s & 3, r32, hi); GA_BAR();
            GA_H2(s); GA_CBAR();
        }
        GA_REQ(nt); GA_PV(nt - 1); GA_BAR();
        GA_CBAR();
    } else {
        GA_REQ(0); GA_BAR();
        qk_tile(p0, p1, c, base, 0, r32, hi); GA_CBAR();
        for (int s = 1; s < nt; ++s) {
            GA_REQ(s); GA_H2(s - 1); GA_BAR();
            GA_PV(s - 1); qk_tile(p0, p1, c, base, s & 3, r32, hi); GA_CBAR();
        }
        GA_REQ(nt); GA_H2(nt - 1); GA_BAR();
        GA_PV(nt - 1); GA_CBAR();
    }
    GA_WAIT_BAR(0);
#undef GA_REQ_K
#undef GA_REQ_V
#undef GA_REQ
#undef GA_BAR
#undef GA_CBAR
#undef GA_H2
#undef GA_PV
}
template <class RowFn, class BiasMask>
__device__ __forceinline__ void run_tiles(Core& c, const TileDma& dma, int kpitch, int vpitch, int nt, const RowFn& rowfn, const BiasMask& bm, LAS unsigned char* base, int wid, int lane, int r32, int hi) {
    run_tiles_t<true>(c, dma, kpitch, vpitch, nt, rowfn, bm, base, wid, lane, r32, hi);
}

__device__ __forceinline__ void mem_unit(Frame& F, int layer, int b, int h, int qb) {
    PHASE_IDS; const int r32 = lane & 31, hi = lane >> 5;
    LAS unsigned char* base = F.lds + RING_OFF;
    const size_t row = (size_t)b * S + qb * 256 + wave * 32 + r32;
    Core c; core_reset(c); load_q(c, F_PROJ + row * NPROJ + C_EQ + h * 64, hi);
    const bf16* kv = F_MEMKVB + (size_t)layer * 512 * 512 + (size_t)b * 256 * 512;
    TileDma dma; dma.init(kv + h * 64, 512, kv + 256 + h * 64, 512, base, wave, lane);
    asm volatile("s_waitcnt vmcnt(0)" ::: "memory");
    run_tiles(c, dma, 512, 512, 4, [](int i) { return i * 64; }, [](f32x16&, f32x16&, int) {}, base, wave, lane, r32, hi);
    const float l = row_l(c);
    f32x16 a0, a1; scale_o(a0, a1, c, 1.0f / l, false, base, wave, r32, hi);
    bf16* ob = F_O + ((size_t)b * S + qb * 256 + wave * 32) * D + (28 + h) * 64;
    store_rows(a0, a1, base, wave, lane, r32, hi, [ob](int r) { return ob + (size_t)r * D; });
    GA_WAIT_BAR(0);
}
__device__ __forceinline__ void fox_unit(Frame& F, int layer, int b, int h, int qb) {
    PHASE_IDS; const int r32 = lane & 31, hi = lane >> 5;
    LAS unsigned char* base = F.lds + RING_OFF;
    LAS float* T = (LAS float*)(base + L_VAR);
    const int q0 = qb * 256, nk = q0 + 256, ntall = nk / 64;
    const double* cc = F_FOXC + (size_t)(b * 12 + h) * S;
    const double cref = q0 > 0 ? cc[q0 - 1] : 0.0;
    LAS int* tfirst = (LAS int*)(base + L_VAR + 65536);
    if (tid == 0) tfirst[0] = ntall - 4;
    GA_WAIT_BAR(0);
    { const float qn2 = __uint_as_float(__hip_atomic_load(F.ctl + CW_FOXN + 64 * layer + 2 * (b * 12 + h), RLX_AGENT)), kn2 = __uint_as_float(__hip_atomic_load(F.ctl + CW_FOXN + 64 * layer + 2 * (b * 12 + h) + 1, RLX_AGENT));
      const float thr = -200.0f - 2.0f * 1.001f * sqrtf(qn2) * sqrtf(kn2);
      if (tid < ntall - 4 && (float)(cref - cc[tid * 64 + 63]) >= thr) __hip_atomic_fetch_min(tfirst, tid, __ATOMIC_RELAXED, __HIP_MEMORY_SCOPE_WORKGROUP); }
    GA_WAIT_BAR(0);
    const int t0 = __builtin_amdgcn_readfirstlane(tfirst[0]), k0 = t0 * 64;
#pragma unroll 8
    for (int j = k0 + tid; j < nk; j += NTHR) T[j - k0] = (float)(cref - cc[j]);
    const size_t row = (size_t)b * S + q0 + wave * 32 + r32;
    Core c; core_reset(c); load_q(c, F_PROJ + row * NPROJ + C_FQ + h * 64, hi);
    const bf16* pb = F_PROJ + (size_t)b * S * NPROJ;
    TileDma dma; dma.init(pb + C_FK + h * 64, NPROJ, pb + C_FV + h * 64, NPROJ, base, wave, lane);
    GA_WAIT_BAR(0);
    const int nt = ntall - t0, trow = wave * 32 + r32;
    run_tiles(c, dma, NPROJ, NPROJ, nt, [=](int i) { return k0 + i * 64; },
        [=](f32x16& p0, f32x16& p1, int i) {
            const LAS f32x4* tp = (const LAS f32x4*)(T + i * 64 + 4 * hi);
#pragma unroll
            for (int g = 0; g < 4; ++g) { const f32x4 t0_ = tp[2 * g], t1_ = tp[8 + 2 * g];
                p0[4 * g] += t0_.x; p0[4 * g + 1] += t0_.y; p0[4 * g + 2] += t0_.z; p0[4 * g + 3] += t0_.w; p1[4 * g] += t1_.x; p1[4 * g + 1] += t1_.y; p1[4 * g + 2] += t1_.z; p1[4 * g + 3] += t1_.w; }
            if (i >= nt - 4) {
                const int kb = (i - (nt - 4)) * 64 + 4 * hi;
#pragma unroll
                for (int r = 0; r < 16; ++r) { const int kv = kb + (r & 3) + 8 * (r >> 2); if (kv > trow) p0[r] = -INFINITY; if (kv + 32 > trow) p1[r] = -INFINITY; }
            }
        }, base, wave, lane, r32, hi);
    const float l = row_l(c);
    f32x16 a0, a1; scale_o(a0, a1, c, 1.0f / l, false, base, wave, r32, hi);
    bf16* ob = F_O + ((size_t)b * S + q0 + wave * 32) * D + (16 + h) * 64;
    store_rows(a0, a1, base, wave, lane, r32, hi, [ob](int r) { return ob + (size_t)r * D; });
    GA_WAIT_BAR(0);
}

__device__ __forceinline__ void fox_unit_fx(Frame& F, int layer, int b, int h, int qb) {
    PHASE_IDS;
    LAS unsigned char* base = F.lds + RING_OFF;
    LAS float* T = (LAS float*)(base + fx::LDS_T);
    LAS int* tfirst = (LAS int*)(base + fx::LDS_T + 65536);
    const int q0 = qb * 256, nk = q0 + 256, ntall = nk / 64;
    const double* cc = F_FOXC + (size_t)(b * 12 + h) * S;
    const double cref = q0 > 0 ? cc[q0 - 1] : 0.0;
    if (tid == 0) tfirst[0] = ntall - 4;
    GA_WAIT_BAR(0);
    { const float qn2 = __uint_as_float(__hip_atomic_load(F.ctl + CW_FOXN + 64 * layer + 2 * (b * 12 + h), RLX_AGENT)), kn2 = __uint_as_float(__hip_atomic_load(F.ctl + CW_FOXN + 64 * layer + 2 * (b * 12 + h) + 1, RLX_AGENT));
      const float thr = -200.0f - 2.0f * 1.001f * sqrtf(qn2) * sqrtf(kn2);
      if (tid < ntall - 4 && (float)(cref - cc[tid * 64 + 63]) >= thr) __hip_atomic_fetch_min(tfirst, tid, __ATOMIC_RELAXED, __HIP_MEMORY_SCOPE_WORKGROUP); }
    GA_WAIT_BAR(0);
    const int t0 = __builtin_amdgcn_readfirstlane(tfirst[0]) & ~1, k0 = t0 * 64;
#pragma unroll 8
    for (int j = k0 + tid; j < nk; j += NTHR) T[j - k0] = (float)(cref - cc[j]);
    GA_WAIT_BAR(0);
    const bf16* pb = F_PROJ + (size_t)b * S * NPROJ;
    fx::attn_unit<8>(qb, t0, pb + C_FQ + h * 64, pb + C_FK + h * 64, pb + C_FV + h * 64, F_O + (size_t)b * S * D + (16 + h) * 64, (char*)base);
}
__device__ __forceinline__ bool gate_better(float vb, int ib, float va, int ia) { return vb > va || (vb == va && ib < ia); }
#define GATE_INS(v, i) do { const float v_ = (v); const int i_ = (i); \
    if (gate_better(v_, i_, g0, i0)) { g2 = g1; i2 = i1; g1 = g0; i1 = i0; g0 = v_; i0 = i_; } \
    else if (gate_better(v_, i_, g1, i1)) { g2 = g1; i2 = i1; g1 = v_; i1 = i_; } \
    else if (gate_better(v_, i_, g2, i2)) { g2 = v_; i2 = i_; } } while (0)
__device__ __forceinline__ void moba_gate_unit(Frame& F, int b, int h, int own) {
    PHASE_IDS; const int r32 = lane & 31, hi = lane >> 5;
    LAS unsigned char* base = F.lds + RING_OFF;
    const int q0 = own * 256, t = q0 + wave * 32 + r32;
    const size_t row = (size_t)b * S + t;
    Core c; core_reset(c); load_q(c, F_PROJ + row * NPROJ + C_MQ + h * 64, hi);
    float g0 = -INFINITY, g1 = -INFINITY, g2 = -INFINITY; int i0 = -1, i1 = -1, i2 = -1;
    if (own > 0) {
        TileDma gd; const bf16* kmh = F_KMEANB + (size_t)(b * 8 + h) * 64 * 64; gd.init(kmh, 64, kmh, 64, base, wave, lane);
        asm volatile("s_waitcnt vmcnt(0)" ::: "memory");
        dma_k_only(gd, 0, 0); dma_k_only(gd, (size_t)2 * 8 * 64 * 64, 1);
        GA_WAIT_BAR(0);
        f32x16 p0, p1, s0, s1; qk_tile(p0, p1, c, base, 0, r32, hi); qk_tile(s0, s1, c, base, 1, r32, hi);
#pragma unroll
        for (int r = 0; r < 16; ++r) { const int j = crow(r, hi); if (j < own) GATE_INS(p0[r] + s0[r], j); }
#pragma unroll
        for (int r = 0; r < 16; ++r) { const int j = 32 + crow(r, hi); if (j < own) GATE_INS(p1[r] + s1[r], j); }
        const float a0 = __shfl_xor(g0, 32), a1 = __shfl_xor(g1, 32), a2 = __shfl_xor(g2, 32); const int j0 = __shfl_xor(i0, 32), j1 = __shfl_xor(i1, 32), j2 = __shfl_xor(i2, 32);
        if (j0 >= 0) GATE_INS(a0, j0);
        if (j1 >= 0) GATE_INS(a1, j1);
        if (j2 >= 0) GATE_INS(a2, j2);
    }
    if (hi == 0) {
        const size_t ri = (size_t)(b * 8 + h) * S + t;
        F_MSEL[ri] = (unsigned)(i0 & 0xFF) | ((unsigned)(i1 & 0xFF) << 8) | ((unsigned)(i2 & 0xFF) << 16);
        *(f32x4*)(F_LSE + ri * 4) = (f32x4){-INFINITY, -INFINITY, -INFINITY, -INFINITY};
    }
    GA_WAIT_BAR(0);
}
template <class VRow, class PRow>
__device__ __forceinline__ void moba_store_partial(Core& c, LAS unsigned char* base, int wid, int lane, int r32, int hi, bool myvalid, float* mylse, const VRow& vrow, const PRow& prow) {
    const float l = row_l(c);
    if (hi == 0 && myvalid) *mylse = c.m + __log2f(l);
    f32x16 a0, a1; scale_o(a0, a1, c, 1.0f / l, false, base, wid, r32, hi);
    LAS bf16* stg = (LAS bf16*)(base + L_OST) + wid * 2048;
#pragma unroll
    for (int r = 0; r < 16; ++r) { const int orow = crow(r, hi); stg[orow * 64 + r32] = (bf16)f2bf(a0[r]); stg[orow * 64 + 32 + r32] = (bf16)f2bf(a1[r]); }
    __builtin_amdgcn_fence(__ATOMIC_RELEASE, "wavefront"); asm volatile("s_waitcnt lgkmcnt(0)" ::: "memory");
#pragma unroll
    for (int i = 0; i < 4; ++i) { const int rw = i * 8 + (lane >> 3), ch = lane & 7; const u32x4 v = *(const LAS u32x4*)(stg + rw * 64 + ch * 8); if (vrow(rw)) *(u32x4*)(prow(rw) + ch * 8) = v; }
    asm volatile("s_waitcnt lgkmcnt(0)" ::: "memory");
}
__device__ __forceinline__ void moba_own_unit(Frame& F, int b, int h, int own) {
    PHASE_IDS; const int r32 = lane & 31, hi = lane >> 5;
    LAS unsigned char* base = F.lds + RING_OFF;
    const int q0 = own * 256, t = q0 + wave * 32 + r32;
    const size_t row = (size_t)b * S + t;
    Core c; core_reset(c); load_q(c, F_PROJ + row * NPROJ + C_MQ + h * 64, hi);
    const bf16* pb = F_PROJ + (size_t)b * S * NPROJ;
    TileDma dma; dma.init(pb + C_MK + h * 64, NPROJ, pb + C_MV + h * 64, NPROJ, base, wave, lane);
    GA_WAIT_BAR(0);
    const float slope = exp2f(-(float)(h + 1)) * LOG2E;
    run_tiles(c, dma, NPROJ, NPROJ, 4, [=](int i) { return q0 + 64 * i; },
        [=](f32x16& p0, f32x16& p1, int i) {
            const int tr = q0 + 64 * i;
            float sl = slope, fb = (float)(tr + 4 * hi - t); asm volatile("" : "+v"(sl), "+v"(fb));
#pragma unroll
            for (int r = 0; r < 16; ++r) { const float kf = (float)((r & 3) + 8 * (r >> 2)); p0[r] = __builtin_fmaf(sl, fb + kf, p0[r]); p1[r] = __builtin_fmaf(sl, fb + (kf + 32.0f), p1[r]); }
            const int kb = tr + 4 * hi;
#pragma unroll
            for (int r = 0; r < 16; ++r) { const int kv = kb + (r & 3) + 8 * (r >> 2); if (kv > t) p0[r] = -INFINITY; if (kv + 32 > t) p1[r] = -INFINITY; }
        }, base, wave, lane, r32, hi);
    const size_t ri0 = (size_t)(b * 8 + h) * S + q0 + wave * 32;
    bf16* part = F_PART;
    moba_store_partial(c, base, wave, lane, r32, hi, true, F_LSE + (ri0 + r32) * 4 + 3, [](int) { return true; }, [=](int r) { return part + ((ri0 + r) * 4 + 3) * 64; });
    GA_WAIT_BAR(0);
}
__device__ __forceinline__ void moba_gather_unit(Frame& F, int b, int h, int J) {
    PHASE_IDS; const int r32 = lane & 31, hi = lane >> 5;
    LAS unsigned char* base = F.lds + RING_OFF;
    LAS unsigned* cntp = (LAS unsigned*)(base + L_VAR);
    LAS unsigned* list = (LAS unsigned*)(base + L_VAR + 64);
    const size_t rbase = (size_t)(b * 8 + h) * S;
    if (tid == 0) cntp[0] = 0u;
    GA_WAIT_BAR(0);
    for (int t0 = 256 * (J + 1) + tid; t0 < S; t0 += NTHR) {
        const unsigned w = F_MSEL[rbase + t0]; const unsigned uj = (unsigned)J;
        const int n = (w & 0xFFu) == uj ? 0 : ((w >> 8) & 0xFFu) == uj ? 1 : ((w >> 16) & 0xFFu) == uj ? 2 : -1;
        if (n >= 0) { const unsigned pos = __hip_atomic_fetch_add(cntp, 1u, __ATOMIC_RELAXED, __HIP_MEMORY_SCOPE_WORKGROUP); list[pos] = (unsigned)t0 | ((unsigned)n << 16); }
    }
    GA_WAIT_BAR(0);
    const int cnt = __builtin_amdgcn_readfirstlane((int)cntp[0]);
    const bf16* pb = F_PROJ + (size_t)b * S * NPROJ;
    const float slope = exp2f(-(float)(h + 1)) * LOG2E;
    bf16* part = F_PART; float* lsep = F_LSE;
    for (int c0 = 0; c0 < cnt; c0 += 256) {
        const int idx = c0 + wave * 32 + r32; const bool valid = idx < cnt;
        const unsigned e = list[valid ? idx : 0]; const int t = (int)(e & 0xFFFFu), n = (int)(e >> 16);
        Core c; core_reset(c); load_q(c, pb + (size_t)t * NPROJ + C_MQ + h * 64, hi);
        TileDma dma; dma.init(pb + C_MK + h * 64, NPROJ, pb + C_MV + h * 64, NPROJ, base, wave, lane);
        asm volatile("s_waitcnt vmcnt(0)" ::: "memory");
        run_tiles(c, dma, NPROJ, NPROJ, 4, [=](int i) { return J * 256 + 64 * i; },
            [=](f32x16& p0, f32x16& p1, int i) {
                float sl = slope, fb = (float)(J * 256 + 64 * i + 4 * hi - t); asm volatile("" : "+v"(sl), "+v"(fb));
#pragma unroll
                for (int r = 0; r < 16; ++r) { const float kf = (float)((r & 3) + 8 * (r >> 2)); p0[r] = __builtin_fmaf(sl, fb + kf, p0[r]); p1[r] = __builtin_fmaf(sl, fb + (kf + 32.0f), p1[r]); }
            }, base, wave, lane, r32, hi);
        const int wbase = c0 + wave * 32;
        moba_store_partial(c, base, wave, lane, r32, hi, valid, lsep + (rbase + t) * 4 + n,
            [=](int r) { return wbase + r < cnt; },
            [=](int r) { const unsigned er = list[wbase + r < cnt ? wbase + r : 0]; return part + ((rbase + (er & 0xFFFFu)) * 4 + (er >> 16)) * 64; });
        GA_WAIT_BAR(0);
    }
}
template <int CTRL> __device__ __forceinline__ float dpp_f(float x) { return __int_as_float(__builtin_amdgcn_update_dpp(0, __float_as_int(x), CTRL, 0xF, 0xF, true)); }
__device__ __forceinline__ unsigned long long wave_max_u64(unsigned long long k) {
#pragma unroll
    for (int o = 1; o < 64; o <<= 1) { const unsigned lo_ = __shfl_xor((unsigned)k, o), hi_ = __shfl_xor((unsigned)(k >> 32), o); const unsigned long long x = ((unsigned long long)hi_ << 32) | lo_; k = x > k ? x : k; }
    return k;
}
__device__ __forceinline__ void nsa_unit(Frame& F, int b, int g, int qblk) {
    PHASE_IDS; const int r32 = lane & 31, hi = lane >> 5;
    LAS unsigned char* base = F.lds + RING_OFF;
    LAS float* imp = (LAS float*)(base + L_VAR);
    LAS unsigned* selm = (LAS unsigned*)(base + L_VAR + 65536);
    LAS unsigned* um = (LAS unsigned*)(base + L_VAR + 65536 + 2048);
    LAS int* tl = (LAS int*)(base + L_VAR + 65536 + 2048 + 64);
    const int q0 = qblk * 64, ql = wave * 8 + (r32 >> 2), hh = r32 & 3, h = g * 4 + hh, t = q0 + ql, jt = qblk;
    const size_t row = (size_t)b * S + t;
    { f32x4* z = (f32x4*)0; (void)z; LAS f32x4* iz = (LAS f32x4*)imp; for (int i = tid; i < 64 * 256 / 4; i += NTHR) iz[i] = (f32x4){0.f, 0.f, 0.f, 0.f};
      for (int i = tid; i < 64 * 8 + 16; i += NTHR) selm[i] = 0u; }
    Core c; core_reset(c); load_q(c, F_PROJ + row * NPROJ + C_NQ + h * 64, hi);
    const bf16* gp = F_PROJ + row * NPROJ + C_GATE + h * 3;
    const float ga_ = 1.0f / (1.0f + __expf(-bf2f(gp[0]))), gb_ = 1.0f / (1.0f + __expf(-bf2f(gp[1]))), gc_ = 1.0f / (1.0f + __expf(-bf2f(gp[2])));
    const float slope = exp2f(-(float)(h + 1)) * LOG2E;
    const bf16* pb = F_PROJ + (size_t)b * S * NPROJ;
    float gc_rl = 0.f;
    const int ncu = min(NCMP, (q0 + 32) / 16 + 1), ntc = (ncu + 63) >> 6;
    { const bf16* kc = F_KCMPB + (size_t)((0 * 2 + b) * 2 + g) * NCMP_PAD * 64; const bf16* vc = F_KCMPB + (size_t)((1 * 2 + b) * 2 + g) * NCMP_PAD * 64;
      TileDma dma; dma.init(kc, 64, vc, 64, base, wave, lane);
      GA_WAIT_BAR(0);
      auto cmp_bias = [=](f32x16& p0, f32x16& p1, int i) {
          int ce0 = 16 * (i * 64 + 4 * hi) + 31 - t;
          float sl = slope; asm volatile("" : "+v"(sl), "+v"(ce0));
#pragma unroll
          for (int r = 0; r < 16; ++r) { const int d = ce0 + 16 * ((r & 3) + 8 * (r >> 2)); p0[r] = d <= 0 ? __builtin_fmaf(sl, (float)d, p0[r]) : -INFINITY; p1[r] = d + 512 <= 0 ? __builtin_fmaf(sl, (float)(d + 512), p1[r]) : -INFINITY; }
      };
      run_tiles(c, dma, 64, 64, ntc, [](int i) { return i * 64; }, cmp_bias, base, wave, lane, r32, hi);
      const float lc = row_l(c); const float rl = lc > 0.f ? 1.0f / lc : 0.f, mref = c.m; gc_rl = ga_ * rl;
      LAS float* impq = imp + ql * 256;
      run_tiles_t<false>(c, dma, 64, 64, ntc, [](int i) { return i * 64; },
          [=](f32x16& p0, f32x16& p1, int i) {
              cmp_bias(p0, p1, i);
#pragma unroll
              for (int r = 0; r < 16; ++r) { float x = ex2(p0[r] - mref) * rl; x += dpp_f<0xB1>(x); x += dpp_f<0x4E>(x); p0[r] = x; float y = ex2(p1[r] - mref) * rl; y += dpp_f<0xB1>(y); y += dpp_f<0x4E>(y); p1[r] = y; }
              if (hh == 0) {
#pragma unroll
                  for (int g4 = 0; g4 < 4; ++g4) {
                      const int j = i * 16 + 2 * g4 + hi;
                      __hip_atomic_fetch_add(impq + j, ((p0[4 * g4] + p0[4 * g4 + 1]) + p0[4 * g4 + 2]) + p0[4 * g4 + 3], __ATOMIC_RELAXED, __HIP_MEMORY_SCOPE_WORKGROUP);
                      __hip_atomic_fetch_add(impq + j + 1, p0[4 * g4 + 3], __ATOMIC_RELAXED, __HIP_MEMORY_SCOPE_WORKGROUP);
                      __hip_atomic_fetch_add(impq + j + 8, ((p1[4 * g4] + p1[4 * g4 + 1]) + p1[4 * g4 + 2]) + p1[4 * g4 + 3], __ATOMIC_RELAXED, __HIP_MEMORY_SCOPE_WORKGROUP);
                      if (j + 9 < 256) __hip_atomic_fetch_add(impq + j + 9, p1[4 * g4 + 3], __ATOMIC_RELAXED, __HIP_MEMORY_SCOPE_WORKGROUP);
                  }
              }
          }, base, wave, lane, r32, hi);
    }
    GA_WAIT_BAR(0);
    for (int qi = 0; qi < 8; ++qi) {
        const int qq = wave * 8 + qi; const LAS float* iq = imp + qq * 256;
        float v[4];
#pragma unroll
        for (int k = 0; k < 4; ++k) { const int j = lane + 64 * k; v[k] = j <= jt ? ((j == 0 || j == jt || j == jt - 1) ? 1.0e4f : iq[j]) : -1.0f; }
        unsigned mw[8];
#pragma unroll
        for (int k = 0; k < 8; ++k) mw[k] = 0u;
        for (int it = 0; it < 16; ++it) {
            float bv = fmaxf(fmaxf(v[0], v[1]), fmaxf(v[2], v[3]));
            bv = fmaxf(bv, dpp_f<0xB1>(bv)); bv = fmaxf(bv, dpp_f<0x4E>(bv)); bv = fmaxf(bv, dpp_f<0x141>(bv)); bv = fmaxf(bv, dpp_f<0x140>(bv));
            const int b0 = __builtin_amdgcn_readlane(__float_as_int(bv), 0), b1 = __builtin_amdgcn_readlane(__float_as_int(bv), 16), b2 = __builtin_amdgcn_readlane(__float_as_int(bv), 32), b3 = __builtin_amdgcn_readlane(__float_as_int(bv), 48);
            const int mb = max(max(b0, b1), max(b2, b3));
            if (mb < 0) break;
            const float mv = __int_as_float(mb);
            int wj = -1;
#pragma unroll
            for (int k = 3; k >= 0; --k) { const unsigned long long bk = __ballot(v[k] == mv); if (bk) wj = 64 * k + (int)__builtin_ctzll(bk); }
#pragma unroll
            for (int k = 0; k < 4; ++k) if (wj == lane + 64 * k) v[k] = -1.0f;
#pragma unroll
            for (int k = 0; k < 8; ++k) if (k == (wj >> 5)) mw[k] |= 1u << (wj & 31);
        }
        if (lane == 0) {
#pragma unroll
            for (int k = 0; k < 8; ++k) { selm[qq * 8 + k] = mw[k]; if (mw[k]) __hip_atomic_fetch_or(um + k, mw[k], __ATOMIC_RELAXED, __HIP_MEMORY_SCOPE_WORKGROUP); }
        }
    }
    GA_WAIT_BAR(0);
    int nts;
    { unsigned u[8]; int pre[8]; int tot = 0;
#pragma unroll
      for (int w = 0; w < 8; ++w) { u[w] = um[w]; pre[w] = tot; tot += __builtin_popcount(u[w]); }
      nts = __builtin_amdgcn_readfirstlane(tot);
      if (tid < 256) { const int w = tid >> 5, bit = tid & 31; unsigned uw = 0; int pw_ = 0;
#pragma unroll
          for (int k = 0; k < 8; ++k) if (k == w) { uw = u[k]; pw_ = pre[k]; }
          if ((uw >> bit) & 1u) tl[pw_ + __builtin_popcount(uw & ((1u << bit) - 1u))] = tid * 64; }
    }
    GA_WAIT_BAR(0);
    LAS float* stash = (LAS float*)(base + L_VAR) + wave * 2048;
    stash_o(stash, c, gc_rl, false, base, wave, r32, hi);
    { core_reset(c);
      TileDma dma; dma.init(pb + C_NKV + 2 * 128 + g * 64, NPROJ, pb + C_NKV + 3 * 128 + g * 64, NPROJ, base, wave, lane);
      const LAS unsigned* sq = selm + ql * 8;
      run_tiles(c, dma, NPROJ, NPROJ, nts, [=](int i) { return __builtin_amdgcn_readfirstlane(tl[i]); },
          [=](f32x16& p0, f32x16& p1, int i) {
              const int tr = __builtin_amdgcn_readfirstlane(tl[i]), J = tr >> 6;
              const bool sel = (sq[J >> 5] >> (J & 31)) & 1u;
              int d0 = sel ? tr + 4 * hi - t : 1 << 20; float sl = slope; asm volatile("" : "+v"(sl), "+v"(d0));
#pragma unroll
              for (int r = 0; r < 16; ++r) { const int d = d0 + (r & 3) + 8 * (r >> 2); p0[r] = d <= 0 ? __builtin_fmaf(sl, (float)d, p0[r]) : -INFINITY; p1[r] = d + 32 <= 0 ? __builtin_fmaf(sl, (float)(d + 32), p1[r]) : -INFINITY; }
          }, base, wave, lane, r32, hi);
      const float ls = row_l(c);
      stash_o(stash, c, ls > 0.f ? gb_ / ls : 0.f, true, base, wave, r32, hi);
    }
    { core_reset(c);
      TileDma dma; dma.init(pb + C_NKV + 4 * 128 + g * 64, NPROJ, pb + C_NKV + 5 * 128 + g * 64, NPROJ, base, wave, lane);
      const int first = q0 >= 512 ? q0 - 512 : 0, ntw = (q0 - first) / 64 + 1;
      run_tiles(c, dma, NPROJ, NPROJ, ntw, [=](int i) { return first + i * 64; },
          [=](f32x16& p0, f32x16& p1, int i) {
              int d0 = first + i * 64 + 4 * hi - t; float sl = slope; asm volatile("" : "+v"(sl), "+v"(d0));
#pragma unroll
              for (int r = 0; r < 16; ++r) { const int d = d0 + (r & 3) + 8 * (r >> 2); p0[r] = (d <= 0 && d > -512) ? __builtin_fmaf(sl, (float)d, p0[r]) : -INFINITY; p1[r] = (d + 32 <= 0 && d + 32 > -512) ? __builtin_fmaf(sl, (float)(d + 32), p1[r]) : -INFINITY; }
          }, base, wave, lane, r32, hi);
      const float lw = row_l(c);
      stash_o(stash, c, lw > 0.f ? gc_ / lw : 0.f, true, base, wave, r32, hi);
    }
    bf16* ob = F_O + ((size_t)b * S + q0 + wave * 8) * D + (8 + g * 4) * 64;
    store_stash(stash, lane, [ob](int r) { return ob + (size_t)(r >> 2) * D + (r & 3) * 64; });
    GA_WAIT_BAR(0);
}
__device__ __forceinline__ void cmp_unit(Frame& F, int layer, int kv, int b, int g, int chunk) {
    PHASE_IDS; const int r32 = lane & 31, hi = lane >> 5;
    LAS unsigned char* base = F.lds + RING_OFF;
    const int n = chunk * 256 + wave * 32 + r32;
    const int nl = n < NCMP ? n : NCMP - 1;
    const bf16* xs = F_PROJ + ((size_t)b * S + 16 * nl) * NPROJ + C_NKV + kv * 128 + g * 64 + hi * 8;
    const bf16* w1t = F_W1T + (size_t)(layer * 2 + kv) * 32 * 128 * 64;
    TileDma dma; dma.init(w1t, 64, F_W2B + (size_t)(layer * 2 + kv) * 128 * 64, 64, base, wave, lane);
    asm volatile("s_waitcnt vmcnt(0)" ::: "memory");
    dma.issue_v(0, 0); dma.issue_v((size_t)64 * 64, 1);
    dma.issue_k(0, 0); dma.issue_k((size_t)64 * 64, 1);
    bf16x8 qc[4], qn[4];
#pragma unroll
    for (int d0 = 0; d0 < 4; ++d0) qc[d0] = *(const bf16x8*)(xs + d0 * 16);
    f32x16 ha0 = f32x16{}, ha1 = f32x16{}, hb0 = f32x16{}, hb1 = f32x16{};
    for (int l = 0; l < 32; ++l) {
        const int pr = (l & 1) * 2;
        if (l + 1 < 32) {
#pragma unroll
            for (int d0 = 0; d0 < 4; ++d0) qn[d0] = *(const bf16x8*)(xs + (size_t)(l + 1) * NPROJ + d0 * 16);
            dma.issue_k((size_t)(l + 1) * 128 * 64, pr ^ 2); dma.issue_k((size_t)(l + 1) * 128 * 64 + 64 * 64, (pr ^ 2) + 1);
            GA_WAIT_BAR(6);
        } else { GA_WAIT_BAR(0); }
        const lds_cptr ka = (lds_cptr)base + L_K + pr * SLOTB + hi * 1024 + r32 * 16, kb = ka + SLOTB;
#pragma unroll
        for (int d0 = 0; d0 < 4; ++d0) {
            ha0 = __builtin_amdgcn_mfma_f32_32x32x16_bf16(*(const LAS bf16x8*)(ka + d0 * 2048), qc[d0], ha0, 0, 0, 0);
            ha1 = __builtin_amdgcn_mfma_f32_32x32x16_bf16(*(const LAS bf16x8*)(ka + d0 * 2048 + 512), qc[d0], ha1, 0, 0, 0);
            hb0 = __builtin_amdgcn_mfma_f32_32x32x16_bf16(*(const LAS bf16x8*)(kb + d0 * 2048), qc[d0], hb0, 0, 0, 0);
            hb1 = __builtin_amdgcn_mfma_f32_32x32x16_bf16(*(const LAS bf16x8*)(kb + d0 * 2048 + 512), qc[d0], hb1, 0, 0, 0);
        }
#pragma unroll
        for (int d0 = 0; d0 < 4; ++d0) qc[d0] = qn[d0];
        asm volatile("s_waitcnt lgkmcnt(0)\n\ts_barrier" ::: "memory");
    }
    const float* hbias = F_HBIAS + (size_t)(layer * 2 + kv) * 128;
    u32x4 pa[4], pb_[4];
#pragma unroll
    for (int r = 0; r < 16; ++r) { const int e = crow(r, hi); ha0[r] = gelu_tanh(ha0[r] + hbias[e]); ha1[r] = gelu_tanh(ha1[r] + hbias[32 + e]); hb0[r] = gelu_tanh(hb0[r] + hbias[64 + e]); hb1[r] = gelu_tanh(hb1[r] + hbias[96 + e]); }
#pragma unroll
    for (int k = 0; k < 4; ++k) { pa[0][k] = cvtpk(ha0[2 * k], ha0[2 * k + 1]); pa[1][k] = cvtpk(ha0[8 + 2 * k], ha0[8 + 2 * k + 1]); pa[2][k] = cvtpk(ha1[2 * k], ha1[2 * k + 1]); pa[3][k] = cvtpk(ha1[8 + 2 * k], ha1[8 + 2 * k + 1]);
                                  pb_[0][k] = cvtpk(hb0[2 * k], hb0[2 * k + 1]); pb_[1][k] = cvtpk(hb0[8 + 2 * k], hb0[8 + 2 * k + 1]); pb_[2][k] = cvtpk(hb1[2 * k], hb1[2 * k + 1]); pb_[3][k] = cvtpk(hb1[8 + 2 * k], hb1[8 + 2 * k + 1]); }
    Core c; core_reset(c);
    pv_h1(c, pa, base, 0, lane, hi); pv_h1(c, pb_, base, 1, lane, hi);
    asm volatile("s_waitcnt lgkmcnt(0)\n\ts_barrier" ::: "memory");
    f32x16 a0, a1; scale_o(a0, a1, c, n < NCMP ? 1.0f : 0.0f, false, base, wave, r32, hi);
    bf16* ob = F_KCMPB + ((size_t)((kv * 2 + b) * 2 + g) * NCMP_PAD + chunk * 256 + wave * 32) * 64;
    store_rows(a0, a1, base, wave, lane, r32, hi, [ob](int r) { return ob + (size_t)r * 64; });
    GA_WAIT_BAR(0);
}
}
#define ATTN_QUEUE(kind, n_per_xcd, ...) do { for (int qd_ = 0; qd_ < 8; ++qd_) { const int xq = (int)((xcd + (unsigned)qd_) & 7u); for (;;) { \
        if (tid == 0) F.MISC[0] = __hip_atomic_fetch_add(F.ctl + CW_Q + 256 * (layer + 2 * rep) + 16 * (kind) + xq, 1u, RLX_AGENT); \
        __syncthreads(); const int it = (int)F.MISC[0]; __syncthreads(); \
        if (it >= (n_per_xcd)) break; __VA_ARGS__; } } } while (0)
__device__ __forceinline__ void moba_gate_phase(Frame& F, int layer) {
    for (int it = blockIdx.x; it < 32; it += F.G) ga::cmp_unit(F, layer, it >> 4, (it >> 3) & 1, (it >> 2) & 1, it & 3);
    for (int it = blockIdx.x; it < 2 * 8 * 64; it += F.G) { const int own = it / 16, bh = it % 16; ga::moba_gate_unit(F, bh >> 3, bh & 7, own); }
}
__device__ __forceinline__ void attn_phase(Frame& F, int layer, int rep) {
    PHASE_IDS;
    const unsigned xcd = xb_xcc_id() & 7u;
    ATTN_QUEUE(0, 3 * 64, { const int bh = xq + 8 * (it >> 6), qb = 63 - (it & 63); ga::fox_unit_fx(F, layer, bh / 12, bh % 12, qb); });
    ATTN_QUEUE(2, 128, { const int bg = xq >> 1, qblk = (xq & 1) * 128 + 127 - it; ga::nsa_unit(F, bg >> 1, bg & 1, qblk); });
    ATTN_QUEUE(1, 2 * 63, { const int bh = xq + 8 * (it / 63), J = it % 63; ga::moba_gather_unit(F, bh >> 3, bh & 7, J); });
    ATTN_QUEUE(4, 2 * 64, { const int bh = xq + 8 * (it >> 6), own = it & 63; ga::moba_own_unit(F, bh >> 3, bh & 7, own); });
    ATTN_QUEUE(3, 64, { const int bh = xq, qb = it; ga::mem_unit(F, layer, bh >> 2, bh & 3, qb); });
}
__device__ __forceinline__ void moba_merge_phase(Frame& F) {
    PHASE_IDS;
    for (int i = blockIdx.x * NTHR + tid; i < 2 * 8 * S * 8; i += F.G * NTHR) {
        const int ch = i & 7; const size_t ri = (size_t)(i >> 3);
        const int t = (int)(ri % S), bh = (int)(ri / S), b = bh >> 3, h = bh & 7;
        const f32x4 ls = *(const f32x4*)(F_LSE + ri * 4);
        const float mx = fmaxf(fmaxf(ls.x, ls.y), fmaxf(ls.z, ls.w));
        const float w0 = ex2(ls.x - mx), w1 = ex2(ls.y - mx), w2 = ex2(ls.z - mx), w3 = ex2(ls.w - mx); const float rs = 1.0f / (w0 + w1 + w2 + w3);
        const float wn[4] = {w0 * rs, w1 * rs, w2 * rs, w3 * rs}; const float lv[4] = {ls.x, ls.y, ls.z, ls.w};
        float acc[8];
#pragma unroll
        for (int k = 0; k < 8; ++k) acc[k] = 0.f;
#pragma unroll
        for (int n = 0; n < 4; ++n) if (lv[n] > -INFINITY) {
            const uint4 v = *(const uint4*)(F_PART + (ri * 4 + n) * 64 + ch * 8);
            acc[0] += wn[n] * blo(v.x); acc[1] += wn[n] * bhi(v.x); acc[2] += wn[n] * blo(v.y); acc[3] += wn[n] * bhi(v.y); acc[4] += wn[n] * blo(v.z); acc[5] += wn[n] * bhi(v.z); acc[6] += wn[n] * blo(v.w); acc[7] += wn[n] * bhi(v.w); }
        *(uint4*)(F_O + ((size_t)b * S + t) * D + h * 64 + ch * 8) = make_uint4(pk2(acc[0], acc[1]), pk2(acc[2], acc[3]), pk2(acc[4], acc[5]), pk2(acc[6], acc[7]));
    }
}

__device__ __forceinline__ bool in_range(int lo, int hi, int k) { asm volatile("" : "+s"(lo), "+s"(hi), "+s"(k)); return lo <= k && k < hi; }
constexpr int N_STEPS = 1 + NLAYER * 12;
template <int PH> __device__ __forceinline__ void run_phase(Frame& F, const Args& args, int l, int half) {
    unsigned char* ws_ = args.ws; asm volatile("" : "+s"(ws_));
    if constexpr (PH == 0) { p0_prologue(F); }
    if constexpr (PH == 1) {
        pg8::Gemm g{F_HB, F_WIN + (size_t)l * NPROJ * D, M, NPROJ, D, 0}; pg8::StaticOrder So; So.init(M, NPROJ, F.G, (int)blockIdx.x);
        pg8::EpiBf16<0> E{F_PROJ, NPROJ, nullptr, 0, 0, 1.f};
        pg8::gemm_phase<pg8::EpiBf16<0>, pg8::StaticOrder, PG8_ALIGN, PG8_SP2>(F.lds + RING_OFF, g, So, E);
    }
    if constexpr (PH == 2) { prep_phase(F, l); }
    if constexpr (PH == 3) { attn_phase(F, l, half); }
    if constexpr (PH == 4) {
        pg8::Gemm g{F_O, F_WOUT + (size_t)l * D * D, M, D, D, 0}; pg8::StaticOrder So; So.init(M, D, F.G, (int)blockIdx.x);
        pg8::EpiResF32 E{F_HR, D, ALPHA};
        pg8::gemm_phase<pg8::EpiResF32, pg8::StaticOrder, PG8_ALIGN, PG8_SP2>(F.lds + RING_OFF, g, So, E);
    }
    if constexpr (PH == 5) { ln_phase(F, F_HR, F_IN(11) + (size_t)l * D, F_IN(12) + (size_t)l * D); }
    if constexpr (PH == 6) {
        pg8::Gemm g{F_HB, F_WUP + (size_t)l * NUP * D, 130 * 256, NUP, D, 1}; pg8::StaticOrder So; So.init(130 * 256, NUP, F.G, (int)blockIdx.x);
        pg8::EpiConvAct E{F_ACT, DFF, F_IN(14) + (size_t)l * 3 * DFF, F_IN(15) + (size_t)l * DFF, DFF, (PG8_LAS float*)(F.lds + XB_OFF)};
        pg8::gemm_phase<pg8::EpiConvAct, pg8::StaticOrder, PG8_ALIGN, PG8_SP2>(F.lds + RING_OFF, g, So, E);
    }
    if constexpr (PH == 8) {
        pg8::Gemm g{F_ACT, F_WDN + (size_t)l * D * DFF, M, D, DFF, 0}; pg8::StaticOrder So; So.init(M, D, F.G, (int)blockIdx.x);
        pg8::EpiResF32 E{F_HR, D, ALPHA};
        pg8::gemm_phase<pg8::EpiResF32, pg8::StaticOrder, PG8_ALIGN, PG8_SP2>(F.lds + RING_OFF, g, So, E);
    }
    if constexpr (PH == 9) { ln_phase(F, F_HR, F_IN(17) + (size_t)l * D, F_IN(18) + (size_t)l * D); }
    if constexpr (PH == 10) { moba_gate_phase(F, l); }
    if constexpr (PH == 11) { moba_merge_phase(F); }
}
template <int PH> __global__ void __launch_bounds__(NTHR, 2) k_phase(Args args, int l, int half) {
    extern __shared__ __attribute__((aligned(16))) unsigned char lds[];
    Frame F;
    F.lds = (LAS unsigned char*)lds;
    F.MISC = (volatile LAS unsigned*)(F.lds + MISC_OFF);
    F.G = gridDim.x;
    F.A = &args;
    F.ctl = (gu32*)(args.ws + WS_CTL);
    for (int u = threadIdx.x; u < (LDS_BYTES - LDSCTL_OFF) / 4; u += NTHR) ((LAS unsigned*)(F.lds + LDSCTL_OFF))[u] = 0u;
    __syncthreads();
    run_phase<PH>(F, args, l, half);
}

__global__ void __launch_bounds__(NTHR, 2) hybrid_fwd(Args args) {
    extern __shared__ __attribute__((aligned(16))) unsigned char lds[];
    Frame F;
    F.lds = (LAS unsigned char*)lds;
    F.MISC = (volatile LAS unsigned*)(F.lds + MISC_OFF);
    F.G = gridDim.x;
    F.A = &args;
    F.ctl = (gu32*)(args.ws + WS_CTL);
    for (int u = threadIdx.x; u < (LDS_BYTES - LDSCTL_OFF) / 4; u += NTHR) ((LAS unsigned*)(F.lds + LDSCTL_OFF))[u] = 0u;
    __syncthreads();
    XcdBarrier bar = xcd_barrier_post((unsigned*)(F.ctl + CW_BAR), F.MISC + 8);
#define PHASE(PH, l, h) do { run_phase<PH>(F, args, (l), (h)); xcd_barrier(bar); } while (0)
#define LAYER(l) do { PHASE(1, l, 0); PHASE(2, l, 0); PHASE(10, l, 0); PHASE(3, l, 0); PHASE(11, l, 0); PHASE(4, l, 0); PHASE(5, l, 0); \
        PHASE(6, l, 0); PHASE(8, l, 0); } while (0)
    PHASE(0, 0, 0);
    LAYER(0); PHASE(9, 0, 0);
    LAYER(1); run_phase<9>(F, args, 1, 0);
#undef PHASE
#undef LAYER
}

template <int PH> static bool set_lds_one() { return hipFuncSetAttribute((const void*)k_phase<PH>, hipFuncAttributeMaxDynamicSharedMemorySize, LDS_BYTES) == hipSuccess; }
static bool set_lds_all() { return hipFuncSetAttribute((const void*)hybrid_fwd, hipFuncAttributeMaxDynamicSharedMemorySize, LDS_BYTES) == hipSuccess && set_lds_one<0>() && set_lds_one<1>() && set_lds_one<2>() && set_lds_one<3>() && set_lds_one<4>() && set_lds_one<5>() && set_lds_one<6>() && set_lds_one<7>() && set_lds_one<8>() && set_lds_one<9>() && set_lds_one<10>() && set_lds_one<11>(); }
extern "C" void kernel_launch(void* const* d_in, const int* in_sizes, int n_in, void* d_out, int out_size, void* d_ws, size_t ws_size, hipStream_t stream) {
    static int grid = 0;
    if (grid == 0) {
        if (n_in != 19 || in_sizes[0] != M * D || out_size != M * D || ws_size < WS_END) { fprintf(stderr, "kernel_launch: unexpected shapes (n_in %d, in0 %d, out %d, ws %zu)\n", n_in, n_in > 0 ? in_sizes[0] : -1, out_size, ws_size); grid = -1; return; }
        int dev = 0, cus = 0;
        if (hipGetDevice(&dev) != hipSuccess || hipDeviceGetAttribute(&cus, hipDeviceAttributeMultiprocessorCount, dev) != hipSuccess) { grid = -1; return; }
        if (!set_lds_all()) { fprintf(stderr, "kernel_launch: hipFuncSetAttribute failed\n"); grid = -1; return; }
        (void)hipGetLastError();
        grid = cus;
    }
    if (grid < 0) return;
    if (hipMemsetAsync((char*)d_ws + WS_CTL, 0, CTL_ZERO_BYTES, stream) != hipSuccess) return;
    Args a{};
    for (int i = 0; i < 19; ++i) a.in[i] = (const float*)d_in[i];
    a.out = (float*)d_out; a.ws = (unsigned char*)d_ws;
#if MK_ONE_LAUNCH
    hipLaunchKernelGGL(hybrid_fwd, dim3(grid), dim3(NTHR), LDS_BYTES, stream, a);
#else
#define LAUNCH(PH, l, h) hipLaunchKernelGGL(k_phase<PH>, dim3(grid), dim3(NTHR), LDS_BYTES, stream, a, (int)(l), (int)(h))
    LAUNCH(0, 0, 0);
    for (int l = 0; l < NLAYER; ++l) {
        LAUNCH(1, l, 0); LAUNCH(2, l, 0); LAUNCH(10, l, 0); LAUNCH(3, l, 0); LAUNCH(11, l, 0); LAUNCH(4, l, 0); LAUNCH(5, l, 0);
        LAUNCH(6, l, 0); LAUNCH(8, l, 0);
        LAUNCH(9, l, 0);
    }
#undef LAUNCH
#endif
}
```
